# Optimizing an MI355X kernel written in HIP

```python
import jax, jax.numpy as jnp
from jax import lax
import numpy as np

D_MODEL = 1024
BATCH = 4
SEQ = 8192
DEPTH = 2

HEAD_DIM = 64
ROT_DIM = HEAD_DIM // 4
ROPE_THETA = 500000.0
QBLK = 128

DILATED_GROUPS = ((128, 1), (512, 4), (2048, 16))
A_HEADS_PER_GROUP = 2
A_HEADS = A_HEADS_PER_GROUP * len(DILATED_GROUPS)
B_HEADS = 4
IDX_HEADS = 4
IDX_DIM = 64
DSA_TOPK = 256
C_HEADS = 4
D_HEADS = 4

N_BRANCH = 4
D_FF = 2816
LN_EPS = 1e-5
DEEPNORM_ALPHA = (2 * DEPTH) ** 0.25
DEEPNORM_BETA = (8 * DEPTH) ** -0.25

A_QKV_W = 3 * A_HEADS * HEAD_DIM
B_QKV_W = 3 * B_HEADS * HEAD_DIM
IDX_Q_W = IDX_HEADS * IDX_DIM
IDX_K_W = IDX_DIM
IDX_W_W = IDX_HEADS
C_QKV_W = 3 * C_HEADS * HEAD_DIM
D_QKV_W = 3 * D_HEADS * HEAD_DIM
FG_W = D_HEADS
GATE_W = N_BRANCH * D_MODEL
OFF_B = A_QKV_W
OFF_IQ = OFF_B + B_QKV_W
OFF_IK = OFF_IQ + IDX_Q_W
OFF_IW = OFF_IK + IDX_K_W
OFF_C = OFF_IW + IDX_W_W
OFF_D = OFF_C + C_QKV_W
OFF_FG = OFF_D + D_QKV_W
OFF_GATE = OFF_FG + FG_W
N_IN = OFF_GATE + GATE_W
SPLIT_POINTS = [OFF_B, OFF_IQ, OFF_IK, OFF_IW, OFF_C, OFF_D, OFF_FG, OFF_GATE]

BRANCH_WIDTHS = (A_HEADS_PER_GROUP * HEAD_DIM, B_HEADS * HEAD_DIM, C_HEADS * HEAD_DIM, D_HEADS * HEAD_DIM)
BRANCH_OFFSETS = (0, BRANCH_WIDTHS[0], BRANCH_WIDTHS[0] + BRANCH_WIDTHS[1],
                  BRANCH_WIDTHS[0] + BRANCH_WIDTHS[1] + BRANCH_WIDTHS[2],
                  BRANCH_WIDTHS[0] + BRANCH_WIDTHS[1] + BRANCH_WIDTHS[2] + BRANCH_WIDTHS[3])

kernel_name = 'hybrid_gated_dilated_dsa_stickbreak_fox_macaron_deepnorm'

F32 = jnp.float32


def _layer_norm(x, g, b):
    xf = x.astype(F32)
    mu = jnp.mean(xf, axis=-1, keepdims=True)
    var = jnp.mean(jnp.square(xf - mu), axis=-1, keepdims=True)
    return ((xf - mu) * lax.rsqrt(var + LN_EPS) * g.astype(F32) + b.astype(F32)).astype(x.dtype)


def _modulate(h, shift, scale):
    return h * (1 + scale[:, None, :]) + shift[:, None, :]


def _swiglu(u, w_in, w_out):
    g, up = jnp.split(u @ w_in, 2, axis=-1)
    return (jax.nn.silu(g) * up) @ w_out


def _rope_partial(x, pos):
    half = ROT_DIM // 2
    inv_freq = ROPE_THETA ** (-(jnp.arange(half, dtype=F32) * (2.0 / ROT_DIM)))
    ang = pos.astype(F32)[:, None] * inv_freq[None, :]
    cos = jnp.cos(ang)[:, None, :]
    sin = jnp.sin(ang)[:, None, :]
    xr = x[..., :ROT_DIM].astype(F32)
    x1, x2 = xr[..., :half], xr[..., half:]
    rot = jnp.concatenate([x1 * cos - x2 * sin, x2 * cos + x1 * sin], axis=-1)
    return jnp.concatenate([rot.astype(x.dtype), x[..., ROT_DIM:]], axis=-1)


def _to_blocks(a):
    b, t = a.shape[:2]
    return a.reshape(b, t // QBLK, QBLK, *a.shape[2:]).swapaxes(0, 1)


def _from_blocks(a):
    nb, b, q = a.shape[:3]
    return a.swapaxes(0, 1).reshape(b, nb * q, *a.shape[3:])


def _dilated_window_attention(q, k, v, window, dilation):
    bsz, t, h, dh = q.shape
    span = window // dilation
    unit = dilation * span
    t_pad = -(-t // unit) * unit
    nb = t_pad // unit

    def prep(a):
        a = jnp.pad(a, ((0, 0), (0, t_pad - t), (0, 0), (0, 0)))
        a = a.reshape(bsz, t_pad // dilation, dilation, h, dh).transpose(0, 2, 3, 1, 4)
        return a.reshape(bsz, dilation, h, nb, span, dh)

    def with_prev(a):
        prev = jnp.pad(a, ((0, 0), (0, 0), (0, 0), (1, 0), (0, 0), (0, 0)))[:, :, :, :-1]
        return jnp.concatenate([prev, a], axis=4)

    qb = prep(q)
    kk = with_prev(prep(k))
    vv = with_prev(prep(v))
    s = jnp.einsum('brhnqe,brhnke->brhnqk', qb, kk, preferred_element_type=F32) * (dh ** -0.5)
    qi = jnp.arange(span)[:, None]
    kj = jnp.arange(2 * span)[None, :]
    dist = span + qi - kj
    band = (dist >= 0) & (dist <= span)
    before_start = (jnp.arange(nb) == 0)[:, None, None] & (kj < span)[None]
    mask = band[None] & ~before_start
    s = jnp.where(mask, s, -jnp.inf)
    lse = jax.nn.logsumexp(s, axis=-1)
    p = jnp.exp(s - lse[..., None])
    o = jnp.einsum('brhnqk,brhnke->brhnqe', p.astype(v.dtype), vv)
    o = o.reshape(bsz, dilation, h, t_pad // dilation, dh).transpose(0, 3, 1, 2, 4).reshape(bsz, t_pad, h, dh)[:, :t]
    lse = lse.reshape(bsz, dilation, h, t_pad // dilation).transpose(0, 3, 1, 2).reshape(bsz, t_pad, h)[:, :t]
    return o, lse


def _dsa_attention(q, k, v, q_idx, k_idx, w_idx):
    bsz, t, h, dh = q.shape
    topk = min(DSA_TOPK, t // 4)
    key_pos = jnp.arange(t)
    gather = jax.vmap(lambda arr, idx: arr[idx])

    def one_block(args):
        qb, qib, wb, t0 = args
        qpos = t0 + jnp.arange(QBLK)
        rel = jnp.maximum(jnp.einsum('bqhe,bse->bqhs', qib, k_idx, preferred_element_type=F32), 0.0)
        score = jnp.einsum('bqh,bqhs->bqs', wb.astype(F32), rel)
        causal = key_pos[None, :] <= qpos[:, None]
        score = jnp.where(causal[None], score, -jnp.inf)
        _, sel = lax.top_k(score, topk)
        valid = sel <= qpos[None, :, None]
        k_sel = gather(k, sel)
        v_sel = gather(v, sel)
        s = jnp.einsum('bqhe,bqkhe->bhqk', qb, k_sel, preferred_element_type=F32) * (dh ** -0.5)
        s = jnp.where(valid[:, None], s, -jnp.inf)
        p = jax.nn.softmax(s, axis=-1)
        return jnp.einsum('bhqk,bqkhe->bqhe', p.astype(v.dtype), v_sel)

    t0s = jnp.arange(t // QBLK) * QBLK
    out = lax.map(one_block, (_to_blocks(q), _to_blocks(q_idx), _to_blocks(w_idx), t0s))
    return _from_blocks(out)


def _stick_breaking_attention(q, k, v):
    bsz, t, h, dh = q.shape
    key_pos = jnp.arange(t)

    def one_block(args):
        qb, t0 = args
        qpos = t0 + jnp.arange(QBLK)
        z = jnp.einsum('bqhe,bshe->bhqs', qb, k, preferred_element_type=F32) * (dh ** -0.5)
        before = key_pos[None, :] < qpos[:, None]
        log_beta = jax.nn.log_sigmoid(z)
        log_keep = jnp.where(before, jax.nn.log_sigmoid(-z), 0.0)
        later = lax.cumsum(log_keep, axis=3, reverse=True) - log_keep
        a = jnp.where(before, jnp.exp(log_beta + later), 0.0)
        return jnp.einsum('bhqs,bshe->bqhe', a.astype(v.dtype), v)

    t0s = jnp.arange(t // QBLK) * QBLK
    return _from_blocks(lax.map(one_block, (_to_blocks(q), t0s)))


def _forgetting_attention(q, k, v, log_f):
    bsz, t, h, dh = q.shape
    cum = lax.cumsum(log_f, axis=1)
    cum_keys = cum.transpose(0, 2, 1)
    key_pos = jnp.arange(t)

    def one_block(args):
        qb, cq, t0 = args
        qpos = t0 + jnp.arange(QBLK)
        s = jnp.einsum('bqhe,bshe->bhqs', qb, k, preferred_element_type=F32) * (dh ** -0.5)
        s = s + cq.transpose(0, 2, 1)[..., None] - cum_keys[:, :, None, :]
        causal = key_pos[None, :] <= qpos[:, None]
        s = jnp.where(causal, s, -jnp.inf)
        p = jax.nn.softmax(s, axis=-1)
        return jnp.einsum('bhqs,bshe->bqhe', p.astype(v.dtype), v)

    t0s = jnp.arange(t // QBLK) * QBLK
    return _from_blocks(lax.map(one_block, (_to_blocks(q), _to_blocks(cum), t0s)))


def _hybrid_mixer(u, w_in, b_gate, b_forget, w_branch, w_out):
    bsz, t, _ = u.shape
    pos = jnp.arange(t)
    proj = u @ w_in
    a_qkv, b_qkv, i_q, i_k, i_w, c_qkv, d_qkv, f_logit, g_logit = jnp.split(proj, SPLIT_POINTS, axis=-1)

    def qkv(a, h):
        a = a.reshape(bsz, t, 3, h, HEAD_DIM)
        return a[:, :, 0], a[:, :, 1], a[:, :, 2]

    qa, ka, va = qkv(a_qkv, A_HEADS)
    qa, ka = _rope_partial(qa, pos), _rope_partial(ka, pos)
    outs, lses = [], []
    for g, (window, dilation) in enumerate(DILATED_GROUPS):
        hs = slice(g * A_HEADS_PER_GROUP, (g + 1) * A_HEADS_PER_GROUP)
        o, l = _dilated_window_attention(qa[:, :, hs], ka[:, :, hs], va[:, :, hs], window, dilation)
        outs.append(o)
        lses.append(l)
    wts = jax.nn.softmax(jnp.stack(lses), axis=0)
    y_a = jnp.sum(wts[..., None].astype(va.dtype) * jnp.stack(outs), axis=0).reshape(bsz, t, -1)

    qb, kb, vb = qkv(b_qkv, B_HEADS)
    qb, kb = _rope_partial(qb, pos), _rope_partial(kb, pos)
    q_idx = _rope_partial(i_q.reshape(bsz, t, IDX_HEADS, IDX_DIM), pos)
    k_idx = _rope_partial(i_k[:, :, None, :], pos)[:, :, 0]
    y_b = _dsa_attention(qb, kb, vb, q_idx, k_idx, i_w).reshape(bsz, t, -1)

    qc, kc, vc = qkv(c_qkv, C_HEADS)
    y_c = _stick_breaking_attention(qc, kc, vc).reshape(bsz, t, -1)

    qd, kd, vd = qkv(d_qkv, D_HEADS)
    log_f = jax.nn.log_sigmoid((f_logit + b_forget).astype(F32))
    y_d = _forgetting_attention(qd, kd, vd, log_f).reshape(bsz, t, -1)

    gates = jax.nn.sigmoid((g_logit + b_gate).astype(F32)).astype(u.dtype).reshape(bsz, t, N_BRANCH, D_MODEL)
    branches = (y_a, y_b, y_c, y_d)
    merged = gates[:, :, 0] * (y_a @ w_branch[BRANCH_OFFSETS[0]:BRANCH_OFFSETS[1]])
    for i in range(1, N_BRANCH):
        merged = merged + gates[:, :, i] * (branches[i] @ w_branch[BRANCH_OFFSETS[i]:BRANCH_OFFSETS[i + 1]])
    return merged @ w_out


def setup_inputs(seed: int = 0) -> dict:
    key = jax.random.key(seed)
    ks = jax.random.split(key, 16)
    D = D_MODEL

    def normal(k, shape, std):
        return jax.random.normal(k, shape, F32) * std

    std = D ** -0.5
    x = normal(ks[0], (BATCH, SEQ, D), 1.0)
    c = normal(ks[1], (BATCH, D), 1.0)
    ada_w = normal(ks[2], (DEPTH, D, 9 * D), 0.1 * std)
    ada_b = normal(ks[3], (DEPTH, 9 * D), 0.02)
    ln_g = 1.0 + normal(ks[4], (DEPTH, 3, D), 0.02)
    ln_b = normal(ks[5], (DEPTH, 3, D), 0.02)
    ffn_w_in = normal(ks[6], (DEPTH, 2, D, 2 * D_FF), std)
    ffn_w_out = normal(ks[7], (DEPTH, 2, D_FF, D), (D_FF ** -0.5) * DEEPNORM_BETA)

    pk = jax.random.split(ks[8], 13)

    def qkv_cols(k1, k2, h):
        return [normal(k1, (DEPTH, D, 2 * h * HEAD_DIM), std),
                normal(k2, (DEPTH, D, h * HEAD_DIM), std * DEEPNORM_BETA)]

    pieces = (qkv_cols(pk[0], pk[1], A_HEADS)
              + qkv_cols(pk[2], pk[3], B_HEADS)
              + [normal(pk[4], (DEPTH, D, IDX_Q_W), std),
                 normal(pk[5], (DEPTH, D, IDX_K_W), std),
                 normal(pk[6], (DEPTH, D, IDX_W_W), std)]
              + qkv_cols(pk[7], pk[8], C_HEADS)
              + qkv_cols(pk[9], pk[10], D_HEADS)
              + [normal(pk[11], (DEPTH, D, FG_W), std),
                 normal(pk[12], (DEPTH, D, GATE_W), std)])
    mix_w_in = jnp.concatenate(pieces, axis=-1)
    mix_b_gate = normal(ks[9], (DEPTH, GATE_W), 0.02)
    mix_b_forget = jax.random.uniform(ks[10], (DEPTH, D_HEADS), F32, 1.0, 4.0)
    bk = jax.random.split(ks[11], N_BRANCH)
    mix_w_branch = jnp.concatenate(
        [normal(bk[i], (DEPTH, BRANCH_WIDTHS[i], D), BRANCH_WIDTHS[i] ** -0.5) for i in range(N_BRANCH)], axis=1)
    mix_w_out = normal(ks[12], (DEPTH, D, D), std * DEEPNORM_BETA)
    return {'x': x, 'c': c, 'ada_w': ada_w, 'ada_b': ada_b, 'ln_g': ln_g, 'ln_b': ln_b,
            'ffn_w_in': ffn_w_in, 'ffn_w_out': ffn_w_out, 'mix_w_in': mix_w_in,
            'mix_b_gate': mix_b_gate, 'mix_b_forget': mix_b_forget,
            'mix_w_branch': mix_w_branch, 'mix_w_out': mix_w_out}


def reference(x, c, ada_w, ada_b, ln_g, ln_b, ffn_w_in, ffn_w_out, mix_w_in,
              mix_b_gate, mix_b_forget, mix_w_branch, mix_w_out):
    cond = jax.nn.silu(c)
    for l in range(DEPTH):
        mod = (cond @ ada_w[l] + ada_b[l]).reshape(-1, 3, 3, D_MODEL)

        h = 0.5 * _swiglu(_modulate(x, mod[:, 0, 0], mod[:, 0, 1]), ffn_w_in[l, 0], ffn_w_out[l, 0])
        x = _layer_norm(DEEPNORM_ALPHA * x + (1 + mod[:, 0, 2])[:, None, :] * h, ln_g[l, 0], ln_b[l, 0])

        h = _hybrid_mixer(_modulate(x, mod[:, 1, 0], mod[:, 1, 1]), mix_w_in[l], mix_b_gate[l],
                          mix_b_forget[l], mix_w_branch[l], mix_w_out[l])
        x = _layer_norm(DEEPNORM_ALPHA * x + (1 + mod[:, 1, 2])[:, None, :] * h, ln_g[l, 1], ln_b[l, 1])

        h = 0.5 * _swiglu(_modulate(x, mod[:, 2, 0], mod[:, 2, 1]), ffn_w_in[l, 1], ffn_w_out[l, 1])
        x = _layer_norm(DEEPNORM_ALPHA * x + (1 + mod[:, 2, 2])[:, None, :] * h, ln_g[l, 2], ln_b[l, 2])
    return x
```

```cpp
#include <hip/hip_runtime.h>
#include <hip/hip_cooperative_groups.h>
#include <cstdio>
#include <cstdint>
namespace cg = cooperative_groups;

#ifndef COOP
#define COOP 1
#endif

typedef unsigned short bf16_t;
typedef short bf16x8 __attribute__((ext_vector_type(8)));
typedef float f32x4 __attribute__((ext_vector_type(4)));

constexpr int DM = 1024, SEQ = 8192, NTOK = 4 * 8192, DFF = 2816;
constexpr int NPROJ = 3840;
constexpr int PA = 0, PB = 1152, PIQ = 1920, PIK = 2176, PC = 2240, PD = 3008, PIW = 3776;
constexpr float ALPHA = 1.41421356237f;
constexpr size_t W_FIN0 = 0, W_FIN1 = 5767168, W_FOUT0 = 11534336, W_FOUT1 = 11534336 + 2883584, W_IN = 17301504,
                 W_GATE = 21233664, W_BR = 25427968, W_OUT = 26345472, WL_ELEMS = 27394048;

struct Params {
    const float *x, *c, *ada_w, *ada_b, *ln_g, *ln_b, *ffn_w_in, *ffn_w_out, *mix_w_in, *mix_b_gate, *mix_b_forget, *mix_w_branch, *mix_w_out;
    float* out;
    bf16_t* wts; float* mod; float* rope; bf16_t* ubuf; bf16_t* act; bf16_t* proj; bf16_t* merged;
    float* iw; float* logf; float* cum; unsigned short* sel; bf16_t* ybuf;
};

__device__ __forceinline__ bf16_t f2bf(float f) { unsigned u = __float_as_uint(f); u += 0x7FFFu + ((u >> 16) & 1u); return (bf16_t)(u >> 16); }
__device__ __forceinline__ float bf2f(bf16_t h) { return __uint_as_float(((unsigned)h) << 16); }
__device__ __forceinline__ float blo(unsigned u) { return __uint_as_float(u << 16); }
__device__ __forceinline__ float bhi(unsigned u) { return __uint_as_float(u & 0xffff0000u); }
__device__ __forceinline__ float log_sigmoid(float x) { return fminf(x, 0.f) - log1pf(expf(-fabsf(x))); }

__device__ __forceinline__ int colmap(int mode, int n) {
    if (mode == 0) return n;
    if (mode == 1) { int q = n >> 5, r = n & 31; return r < 16 ? 16 * q + r : 2816 + 16 * q + (r - 16); }
    if (mode == 2) { if (n < 2240) return n; if (n < 3776) return n + 4; if (n < 3780) return 2240 + (n - 3776); if (n < 3784) return n; return -1; }
    return 3784 + n;
}
__device__ __forceinline__ void convert_job(const float* __restrict__ src, int K, int Nsrc, bf16_t* __restrict__ dst, int Ndst, int mode, char* smem) {
    float (*t)[33] = (float (*)[33])smem;
    const int tid = threadIdx.x, tx = tid & 31, ty = tid >> 5;
    const int kt_n = K / 32, ntiles = kt_n * (Ndst / 32);
    for (int tile = blockIdx.x; tile < ntiles; tile += gridDim.x) {
        const int k0 = (tile % kt_n) * 32, n0 = (tile / kt_n) * 32;
        const int sc = colmap(mode, n0 + tx);
        __syncthreads();
#pragma unroll
        for (int i = 0; i < 4; ++i) { const int k = k0 + ty + 8 * i; t[ty + 8 * i][tx] = sc >= 0 ? src[(size_t)k * Nsrc + sc] : 0.f; }
        __syncthreads();
#pragma unroll
        for (int i = 0; i < 4; ++i) { const int n = ty + 8 * i; dst[(size_t)(n0 + n) * K + k0 + tx] = f2bf(t[tx][n]); }
    }
}

__device__ __forceinline__ void phase_prologue(const Params& p, char* smem) {
    for (int l = 0; l < 2; ++l) {
        bf16_t* w = p.wts + (size_t)l * WL_ELEMS;
        convert_job(p.ffn_w_in + (size_t)(l * 2 + 0) * 1024 * 5632, 1024, 5632, w + W_FIN0, 5632, 1, smem);
        convert_job(p.ffn_w_in + (size_t)(l * 2 + 1) * 1024 * 5632, 1024, 5632, w + W_FIN1, 5632, 1, smem);
        convert_job(p.ffn_w_out + (size_t)(l * 2 + 0) * 2816 * 1024, 2816, 1024, w + W_FOUT0, 1024, 0, smem);
        convert_job(p.ffn_w_out + (size_t)(l * 2 + 1) * 2816 * 1024, 2816, 1024, w + W_FOUT1, 1024, 0, smem);
        convert_job(p.mix_w_in + (size_t)l * 1024 * 7880, 1024, 7880, w + W_IN, 3840, 2, smem);
        convert_job(p.mix_w_in + (size_t)l * 1024 * 7880, 1024, 7880, w + W_GATE, 4096, 3, smem);
        convert_job(p.mix_w_branch + (size_t)l * 896 * 1024, 896, 1024, w + W_BR, 1024, 0, smem);
        convert_job(p.mix_w_out + (size_t)l * 1024 * 1024, 1024, 1024, w + W_OUT, 1024, 0, smem);
    }
    for (int idx = blockIdx.x * 256 + threadIdx.x; idx < SEQ * 8; idx += gridDim.x * 256) {
        const int t = idx >> 3, i = idx & 7;
        const float invf = powf(500000.0f, -(float)i * 0.125f);
        const float ang = (float)t * invf;
        p.rope[idx * 2 + 0] = cosf(ang);
        p.rope[idx * 2 + 1] = sinf(ang);
    }
    __syncthreads();
    float* scs = (float*)smem;
    float* red = scs + 4096;
    for (int i = threadIdx.x; i < 4096; i += 256) { const float v = p.c[i]; scs[i] = v / (1.f + expf(-v)); }
    __syncthreads();
    const int tid = threadIdx.x, cl = tid & 63, kq = tid >> 6;
    for (int item = blockIdx.x; item < 288; item += gridDim.x) {
        const int l = item / 144, col = (item % 144) * 64 + cl;
        float a0 = 0.f, a1 = 0.f, a2 = 0.f, a3 = 0.f;
        const float* wp = p.ada_w + ((size_t)l * 1024 + kq * 256) * 9216 + col;
        for (int k = 0; k < 256; ++k) {
            const float w = wp[(size_t)k * 9216]; const int kk = kq * 256 + k;
            a0 = fmaf(scs[kk], w, a0); a1 = fmaf(scs[1024 + kk], w, a1); a2 = fmaf(scs[2048 + kk], w, a2); a3 = fmaf(scs[3072 + kk], w, a3);
        }
        red[(kq * 4 + 0) * 64 + cl] = a0; red[(kq * 4 + 1) * 64 + cl] = a1; red[(kq * 4 + 2) * 64 + cl] = a2; red[(kq * 4 + 3) * 64 + cl] = a3;
        __syncthreads();
        {
            const int b = kq;
            const float s = red[(0 * 4 + b) * 64 + cl] + red[(1 * 4 + b) * 64 + cl] + red[(2 * 4 + b) * 64 + cl] + red[(3 * 4 + b) * 64 + cl];
            p.mod[(size_t)(l * 4 + b) * 9216 + col] = s + p.ada_b[(size_t)l * 9216 + col];
        }
        __syncthreads();
    }
}

__device__ __forceinline__ void phase_u0(const Params& p) {
    const size_t n4 = (size_t)NTOK * 256;
    for (size_t i = (size_t)blockIdx.x * 256 + threadIdx.x; i < n4; i += (size_t)gridDim.x * 256) {
        const size_t row = i >> 8; const int c4 = (int)(i & 255) * 4; const int b = (int)(row >> 13);
        const float4 v = *(const float4*)(p.x + row * 1024 + c4);
        const float* md = p.mod + (size_t)(0 * 4 + b) * 9216;
        const float4 sh = *(const float4*)(md + c4), sc = *(const float4*)(md + 1024 + c4);
        ushort4 o; o.x = f2bf(v.x * (1.f + sc.x) + sh.x); o.y = f2bf(v.y * (1.f + sc.y) + sh.y); o.z = f2bf(v.z * (1.f + sc.z) + sh.z); o.w = f2bf(v.w * (1.f + sc.w) + sh.w);
        *(ushort4*)(p.ubuf + row * 1024 + c4) = o;
    }
}

__device__ __forceinline__ void gemm_mainloop(f32x4 (&acc)[4][4], const bf16_t* __restrict__ A, int lda, const bf16_t* __restrict__ Bt, int ldb, int K, char* smem) {
    bf16_t* As = (bf16_t*)smem; bf16_t* Bs = As + 128 * 40;
    const int tid = threadIdx.x, lane = tid & 63, wid = tid >> 6, wr = wid >> 1, wc = wid & 1;
    const int lr = tid >> 1, lk = (tid & 1) * 16;
    const uint4* ga = (const uint4*)(A + (size_t)lr * lda + lk);
    const uint4* gb = (const uint4*)(Bt + (size_t)lr * ldb + lk);
    uint4 ra0 = ga[0], ra1 = ga[1], rb0 = gb[0], rb1 = gb[1];
    const int fr = lane & 15, fq = lane >> 4;
    for (int k0 = 0; k0 < K; k0 += 32) {
        __syncthreads();
        *(uint4*)&As[lr * 40 + lk] = ra0; *(uint4*)&As[lr * 40 + lk + 8] = ra1;
        *(uint4*)&Bs[lr * 40 + lk] = rb0; *(uint4*)&Bs[lr * 40 + lk + 8] = rb1;
        __syncthreads();
        if (k0 + 32 < K) { ga += 4; gb += 4; ra0 = ga[0]; ra1 = ga[1]; rb0 = gb[0]; rb1 = gb[1]; }
        bf16x8 a[4], b[4];
#pragma unroll
        for (int m = 0; m < 4; ++m) a[m] = *(const bf16x8*)&As[(wr * 64 + m * 16 + fr) * 40 + fq * 8];
#pragma unroll
        for (int n = 0; n < 4; ++n) b[n] = *(const bf16x8*)&Bs[(wc * 64 + n * 16 + fr) * 40 + fq * 8];
#pragma unroll
        for (int m = 0; m < 4; ++m)
#pragma unroll
            for (int n = 0; n < 4; ++n) acc[m][n] = __builtin_amdgcn_mfma_f32_16x16x32_bf16(a[m], b[n], acc[m][n], 0, 0, 0);
    }
}
__device__ __forceinline__ void zero_acc(f32x4 (&acc)[4][4]) {
#pragma unroll
    for (int m = 0; m < 4; ++m)
#pragma unroll
        for (int n = 0; n < 4; ++n) acc[m][n] = (f32x4){0.f, 0.f, 0.f, 0.f};
}

__device__ __forceinline__ void phase_ffn_in(const Params& p, int l, int f, char* smem) {
    const bf16_t* W = p.wts + (size_t)l * WL_ELEMS + (f ? W_FIN1 : W_FIN0);
    const int tid = threadIdx.x, lane = tid & 63, wid = tid >> 6, wr = wid >> 1, wc = wid & 1, fr = lane & 15, fq = lane >> 4;
    for (int tile = blockIdx.x; tile < 256 * 44; tile += gridDim.x) {
        const int pm = tile / 44, pn = tile % 44;
        f32x4 acc[4][4]; zero_acc(acc);
        gemm_mainloop(acc, p.ubuf + (size_t)pm * 128 * 1024, 1024, W + (size_t)pn * 128 * 1024, 1024, 1024, smem);
#pragma unroll
        for (int m = 0; m < 4; ++m)
#pragma unroll
            for (int i = 0; i < 2; ++i) {
                const int q = pn * 4 + wc * 2 + i, col = 16 * q + fr;
#pragma unroll
                for (int j = 0; j < 4; ++j) {
                    const int row = pm * 128 + wr * 64 + m * 16 + fq * 4 + j;
                    const float g = acc[m][2 * i][j], up = acc[m][2 * i + 1][j];
                    p.act[(size_t)row * DFF + col] = f2bf(g / (1.f + expf(-g)) * up);
                }
            }
    }
}
__device__ __forceinline__ void phase_gemm_res(const Params& p, const bf16_t* A, int lda, const bf16_t* W, int K, const float* xres, int l, int s, float fac, char* smem) {
    const int tid = threadIdx.x, lane = tid & 63, wid = tid >> 6, wr = wid >> 1, wc = wid & 1, fr = lane & 15, fq = lane >> 4;
    for (int tile = blockIdx.x; tile < 256 * 8; tile += gridDim.x) {
        const int pm = tile / 8, pn = tile % 8;
        f32x4 acc[4][4]; zero_acc(acc);
        gemm_mainloop(acc, A + (size_t)pm * 128 * lda, lda, W + (size_t)pn * 128 * K, K, K, smem);
        const int b = (pm * 128) >> 13;
        const float* gate = p.mod + (size_t)(l * 4 + b) * 9216 + s * 3072 + 2048;
#pragma unroll
        for (int m = 0; m < 4; ++m)
#pragma unroll
            for (int n = 0; n < 4; ++n) {
                const int col = pn * 128 + wc * 64 + n * 16 + fr;
                const float gm = (1.f + gate[col]) * fac;
#pragma unroll
                for (int j = 0; j < 4; ++j) {
                    const size_t off = (size_t)(pm * 128 + wr * 64 + m * 16 + fq * 4 + j) * 1024 + col;
                    p.out[off] = ALPHA * xres[off] + gm * acc[m][n][j];
                }
            }
    }
}
__device__ __forceinline__ void phase_ln(const Params& p, int l, int s, bool has_next) {
    const int lane = threadIdx.x & 63, wid = threadIdx.x >> 6;
    const float* g = p.ln_g + (size_t)(l * 3 + s) * 1024; const float* bb = p.ln_b + (size_t)(l * 3 + s) * 1024;
    const int nl = s < 2 ? l : l + 1, ns = s < 2 ? s + 1 : 0;
    for (int row = blockIdx.x * 4 + wid; row < NTOK; row += gridDim.x * 4) {
        float* xr = p.out + (size_t)row * 1024;
        float4 v[4]; float sum = 0.f;
#pragma unroll
        for (int i = 0; i < 4; ++i) { v[i] = *(const float4*)(xr + lane * 4 + 256 * i); sum += (v[i].x + v[i].y) + (v[i].z + v[i].w); }
#pragma unroll
        for (int o = 32; o > 0; o >>= 1) sum += __shfl_xor(sum, o);
        const float mu = sum * (1.f / 1024.f); float q = 0.f;
#pragma unroll
        for (int i = 0; i < 4; ++i) { const float a = v[i].x - mu, b2 = v[i].y - mu, c = v[i].z - mu, d = v[i].w - mu; q += (a * a + b2 * b2) + (c * c + d * d); }
#pragma unroll
        for (int o = 32; o > 0; o >>= 1) q += __shfl_xor(q, o);
        const float rstd = 1.0f / sqrtf(q * (1.f / 1024.f) + 1e-5f);
        const int b = row >> 13;
        const float* md = p.mod + (size_t)(nl * 4 + b) * 9216 + ns * 3072;
#pragma unroll
        for (int i = 0; i < 4; ++i) {
            const int c4 = lane * 4 + 256 * i;
            const float4 gg = *(const float4*)(g + c4), be = *(const float4*)(bb + c4);
            float4 o; o.x = (v[i].x - mu) * rstd * gg.x + be.x; o.y = (v[i].y - mu) * rstd * gg.y + be.y; o.z = (v[i].z - mu) * rstd * gg.z + be.z; o.w = (v[i].w - mu) * rstd * gg.w + be.w;
            *(float4*)(xr + c4) = o;
            if (has_next) {
                const float4 sh = *(const float4*)(md + c4), sc = *(const float4*)(md + 1024 + c4);
                ushort4 u; u.x = f2bf(o.x * (1.f + sc.x) + sh.x); u.y = f2bf(o.y * (1.f + sc.y) + sh.y); u.z = f2bf(o.z * (1.f + sc.z) + sh.z); u.w = f2bf(o.w * (1.f + sc.w) + sh.w);
                *(ushort4*)(p.ubuf + (size_t)row * 1024 + c4) = u;
            }
        }
    }
}
__device__ __forceinline__ void phase_inproj(const Params& p, int l, char* smem) {
    const bf16_t* W = p.wts + (size_t)l * WL_ELEMS + W_IN;
    const int tid = threadIdx.x, lane = tid & 63, wid = tid >> 6, wr = wid >> 1, wc = wid & 1, fr = lane & 15, fq = lane >> 4;
    for (int tile = blockIdx.x; tile < 256 * 30; tile += gridDim.x) {
        const int pm = tile / 30, pn = tile % 30;
        f32x4 acc[4][4]; zero_acc(acc);
        gemm_mainloop(acc, p.ubuf + (size_t)pm * 128 * 1024, 1024, W + (size_t)pn * 128 * 1024, 1024, 1024, smem);
#pragma unroll
        for (int n = 0; n < 4; ++n) {
            const int cb = pn * 128 + wc * 64 + n * 16, col = cb + fr;
            const bool rope = ((cb & 63) == 0) && (cb < 768 || (cb >= 1152 && cb < 1664) || (cb >= 1920 && cb < 2240));
#pragma unroll
            for (int m = 0; m < 4; ++m)
#pragma unroll
                for (int j = 0; j < 4; ++j) {
                    const int row = pm * 128 + wr * 64 + m * 16 + fq * 4 + j;
                    float v = acc[m][n][j];
                    if (rope) {
                        const float pr = __shfl_xor(v, 8);
                        const int t = row & (SEQ - 1);
                        const float2 cs = *(const float2*)(p.rope + ((size_t)t * 8 + (lane & 7)) * 2);
                        v = (lane & 8) ? (v * cs.x + pr * cs.y) : (v * cs.x - pr * cs.y);
                    }
                    p.proj[(size_t)row * NPROJ + col] = f2bf(v);
                    if (cb == PIW) {
                        if (fr < 4) p.iw[(size_t)row * 4 + fr] = v;
                        else if (fr < 8) p.logf[(size_t)row * 4 + (fr - 4)] = log_sigmoid(v + p.mix_b_forget[l * 4 + (fr - 4)]);
                    }
                }
        }
    }
}
__device__ __forceinline__ void phase_merge(const Params& p, int l, char* smem) {
    const bf16_t* WG = p.wts + (size_t)l * WL_ELEMS + W_GATE; const bf16_t* WB = p.wts + (size_t)l * WL_ELEMS + W_BR;
    const int tid = threadIdx.x, lane = tid & 63, wid = tid >> 6, wr = wid >> 1, wc = wid & 1, fr = lane & 15, fq = lane >> 4;
    for (int tile = blockIdx.x; tile < 256 * 8; tile += gridDim.x) {
        const int pm = tile / 8, pn = tile % 8;
        f32x4 accM[4][4]; zero_acc(accM);
#pragma unroll 1
        for (int br = 0; br < 4; ++br) {
            const int koff = br == 0 ? 0 : 128 + (br - 1) * 256, kb = br == 0 ? 128 : 256;
            f32x4 accG[4][4]; zero_acc(accG);
            gemm_mainloop(accG, p.ubuf + (size_t)pm * 128 * 1024, 1024, WG + (size_t)(br * 1024 + pn * 128) * 1024, 1024, 1024, smem);
            const float* bg = p.mix_b_gate + (size_t)l * 4096 + br * 1024;
#pragma unroll
            for (int n = 0; n < 4; ++n) {
                const float bv = bg[pn * 128 + wc * 64 + n * 16 + fr];
#pragma unroll
                for (int m = 0; m < 4; ++m)
#pragma unroll
                    for (int j = 0; j < 4; ++j) accG[m][n][j] = 1.f / (1.f + expf(-(accG[m][n][j] + bv)));
            }
            f32x4 accB[4][4]; zero_acc(accB);
            gemm_mainloop(accB, p.ybuf + (size_t)pm * 128 * 896 + koff, 896, WB + (size_t)pn * 128 * 896 + koff, 896, kb, smem);
#pragma unroll
            for (int m = 0; m < 4; ++m)
#pragma unroll
                for (int n = 0; n < 4; ++n) accM[m][n] += accG[m][n] * accB[m][n];
        }
#pragma unroll
        for (int m = 0; m < 4; ++m)
#pragma unroll
            for (int n = 0; n < 4; ++n)
#pragma unroll
                for (int j = 0; j < 4; ++j)
                    p.merged[(size_t)(pm * 128 + wr * 64 + m * 16 + fq * 4 + j) * 1024 + pn * 128 + wc * 64 + n * 16 + fr] = f2bf(accM[m][n][j]);
    }
}

__device__ __forceinline__ void load_row64(float (&q)[64], const bf16_t* row) {
    const uint4* r = (const uint4*)row;
#pragma unroll
    for (int c = 0; c < 8; ++c) { const uint4 v = r[c];
        q[c * 8 + 0] = blo(v.x); q[c * 8 + 1] = bhi(v.x); q[c * 8 + 2] = blo(v.y); q[c * 8 + 3] = bhi(v.y);
        q[c * 8 + 4] = blo(v.z); q[c * 8 + 5] = bhi(v.z); q[c * 8 + 6] = blo(v.w); q[c * 8 + 7] = bhi(v.w); }
}
__device__ __forceinline__ float dot64(const float (&q)[64], const bf16_t* row) {
    const uint4* r = (const uint4*)row; float a = 0.f;
#pragma unroll
    for (int c = 0; c < 8; ++c) { const uint4 v = r[c];
        a = fmaf(q[c * 8 + 0], blo(v.x), a); a = fmaf(q[c * 8 + 1], bhi(v.x), a); a = fmaf(q[c * 8 + 2], blo(v.y), a); a = fmaf(q[c * 8 + 3], bhi(v.y), a);
        a = fmaf(q[c * 8 + 4], blo(v.z), a); a = fmaf(q[c * 8 + 5], bhi(v.z), a); a = fmaf(q[c * 8 + 6], blo(v.w), a); a = fmaf(q[c * 8 + 7], bhi(v.w), a); }
    return a;
}
__device__ __forceinline__ void axpy64(float (&o)[64], float sc, float pw, const bf16_t* row) {
    const uint4* r = (const uint4*)row;
#pragma unroll
    for (int c = 0; c < 8; ++c) { const uint4 v = r[c];
        o[c * 8 + 0] = fmaf(pw, blo(v.x), o[c * 8 + 0] * sc); o[c * 8 + 1] = fmaf(pw, bhi(v.x), o[c * 8 + 1] * sc);
        o[c * 8 + 2] = fmaf(pw, blo(v.y), o[c * 8 + 2] * sc); o[c * 8 + 3] = fmaf(pw, bhi(v.y), o[c * 8 + 3] * sc);
        o[c * 8 + 4] = fmaf(pw, blo(v.z), o[c * 8 + 4] * sc); o[c * 8 + 5] = fmaf(pw, bhi(v.z), o[c * 8 + 5] * sc);
        o[c * 8 + 6] = fmaf(pw, blo(v.w), o[c * 8 + 6] * sc); o[c * 8 + 7] = fmaf(pw, bhi(v.w), o[c * 8 + 7] * sc); }
}
__device__ __forceinline__ void store_row64(bf16_t* dst, const float (&o)[64], float sc) {
    uint4* r = (uint4*)dst;
#pragma unroll
    for (int c = 0; c < 8; ++c) { uint4 v;
        v.x = (unsigned)f2bf(o[c * 8 + 0] * sc) | ((unsigned)f2bf(o[c * 8 + 1] * sc) << 16); v.y = (unsigned)f2bf(o[c * 8 + 2] * sc) | ((unsigned)f2bf(o[c * 8 + 3] * sc) << 16);
        v.z = (unsigned)f2bf(o[c * 8 + 4] * sc) | ((unsigned)f2bf(o[c * 8 + 5] * sc) << 16); v.w = (unsigned)f2bf(o[c * 8 + 6] * sc) | ((unsigned)f2bf(o[c * 8 + 7] * sc) << 16);
        r[c] = v; }
}
__device__ __forceinline__ void zero64(float (&o)[64]) {
#pragma unroll
    for (int i = 0; i < 64; ++i) o[i] = 0.f;
}

__device__ __forceinline__ void phase_attn_a(const Params& p) {
    const int lane = threadIdx.x & 63, gw = blockIdx.x * 4 + (threadIdx.x >> 6), nw = gridDim.x * 4;
    for (int item = gw; item < 4 * 2 * 128; item += nw) {
        const int hp = item & 1, blk = (item >> 1) & 127, b = item >> 8;
        const int t = blk * 64 + lane; const size_t tok = (size_t)b * SEQ + t;
        float o[64]; zero64(o); float mx = -INFINITY, lsum = 0.f;
#pragma unroll 1
        for (int g = 0; g < 3; ++g) {
            const int head = 2 * g + hp, dil = g == 0 ? 1 : (g == 1 ? 4 : 16);
            float q[64]; load_row64(q, p.proj + tok * NPROJ + PA + head * 64);
            for (int j = 0; j <= 128; ++j) {
                const int s = t - j * dil;
                if (s >= 0) {
                    const bf16_t* kr = p.proj + ((size_t)b * SEQ + s) * NPROJ + PA + 384 + head * 64;
                    const float x = dot64(q, kr) * 0.125f;
                    const float mn = fmaxf(mx, x), sc = expf(mx - mn), pw = expf(x - mn);
                    lsum = lsum * sc + pw; mx = mn;
                    axpy64(o, sc, pw, kr + 384);
                }
            }
        }
        store_row64(p.ybuf + tok * 896 + hp * 64, o, 1.f / lsum);
    }
}
__device__ __forceinline__ void phase_attn_c(const Params& p) {
    const int lane = threadIdx.x & 63, gw = blockIdx.x * 4 + (threadIdx.x >> 6), nw = gridDim.x * 4;
    for (int item = gw; item < 4 * 4 * 128; item += nw) {
        const int h = item & 3, blk = (item >> 2) & 127, b = item >> 9;
        const int t0 = blk * 64, t = t0 + lane; const size_t tok = (size_t)b * SEQ + t;
        float q[64]; load_row64(q, p.proj + tok * NPROJ + PC + h * 64);
        float o[64]; zero64(o); float run = 0.f;
        for (int s = t0 + 62; s >= 0; --s) {
            if (s < t) {
                const bf16_t* kr = p.proj + ((size_t)b * SEQ + s) * NPROJ + PC + 256 + h * 64;
                const float z = dot64(q, kr) * 0.125f;
                const float lb = log_sigmoid(z);
                const float a = expf(lb + run);
                axpy64(o, 1.f, a, kr + 256);
                run += lb - z;
            }
            if (__all(run < -60.f)) break;
        }
        store_row64(p.ybuf + tok * 896 + 384 + h * 64, o, 1.f);
    }
}
__device__ __forceinline__ void phase_attn_d(const Params& p) {
    const int lane = threadIdx.x & 63, gw = blockIdx.x * 4 + (threadIdx.x >> 6), nw = gridDim.x * 4;
    for (int item = gw; item < 4 * 4 * 128; item += nw) {
        const int h = item & 3, blk = 127 - ((item >> 2) & 127), b = item >> 9;
        const int t0 = blk * 64, t = t0 + lane; const size_t tok = (size_t)b * SEQ + t;
        float q[64]; load_row64(q, p.proj + tok * NPROJ + PD + h * 64);
        float o[64]; zero64(o); float mx = -INFINITY, lsum = 0.f;
        const float cq = p.cum[tok * 4 + h];
        for (int s = 0; s <= t0 + 63; ++s) {
            if (s <= t) {
                const bf16_t* kr = p.proj + ((size_t)b * SEQ + s) * NPROJ + PD + 256 + h * 64;
                const float x = dot64(q, kr) * 0.125f + (cq - p.cum[((size_t)b * SEQ + s) * 4 + h]);
                const float mn = fmaxf(mx, x), sc = expf(mx - mn), pw = expf(x - mn);
                lsum = lsum * sc + pw; mx = mn;
                axpy64(o, sc, pw, kr + 256);
            }
        }
        store_row64(p.ybuf + tok * 896 + 640 + h * 64, o, 1.f / lsum);
    }
}
__device__ __forceinline__ void phase_attn_b(const Params& p) {
    const int lane = threadIdx.x & 63, gw = blockIdx.x * 4 + (threadIdx.x >> 6), nw = gridDim.x * 4;
    for (int item = gw; item < 4 * 4 * 128; item += nw) {
        const int h = item & 3, blk = (item >> 2) & 127, b = item >> 9;
        const int t = blk * 64 + lane; const size_t tok = (size_t)b * SEQ + t;
        float q[64]; load_row64(q, p.proj + tok * NPROJ + PB + h * 64);
        float o[64]; zero64(o); float mx = -INFINITY, lsum = 0.f;
        const int cnt = t + 1 < 256 ? t + 1 : 256;
        const unsigned short* sl = p.sel + tok * 256;
        for (int i = 0; i < 256; ++i) {
            if (i < cnt) {
                const int s = sl[i];
                const bf16_t* kr = p.proj + ((size_t)b * SEQ + s) * NPROJ + PB + 256 + h * 64;
                const float x = dot64(q, kr) * 0.125f;
                const float mn = fmaxf(mx, x), sc = expf(mx - mn), pw = expf(x - mn);
                lsum = lsum * sc + pw; mx = mn;
                axpy64(o, sc, pw, kr + 256);
            }
        }
        store_row64(p.ybuf + tok * 896 + 128 + h * 64, o, 1.f / lsum);
    }
}
__device__ __forceinline__ void phase_scan(const Params& p, char* smem) {
    double* part = (double*)smem;
    const int tid = threadIdx.x;
    for (int item = blockIdx.x; item < 16; item += gridDim.x) {
        const int b = item >> 2, h = item & 3;
        const float* lf = p.logf + ((size_t)b * SEQ + tid * 32) * 4 + h;
        double s = 0.0;
        for (int i = 0; i < 32; ++i) s += (double)lf[i * 4];
        __syncthreads();
        part[tid] = s;
        __syncthreads();
        if (tid == 0) { double r = 0.0; for (int i = 0; i < 256; ++i) { const double v = part[i]; part[i] = r; r += v; } }
        __syncthreads();
        double r = part[tid];
        float* cm = p.cum + ((size_t)b * SEQ + tid * 32) * 4 + h;
        for (int i = 0; i < 32; ++i) { r += (double)lf[i * 4]; cm[i * 4] = (float)r; }
    }
}
__device__ __forceinline__ unsigned f2key(float f) { const unsigned u = __float_as_uint(f); return (u & 0x80000000u) ? ~u : (u | 0x80000000u); }
__device__ __forceinline__ void phase_topk(const Params& p, char* smem) {
    float* sc = (float*)smem;
    float* qs = sc + 8192;
    unsigned* hist = (unsigned*)(qs + 256);
    unsigned* cnts = hist + 256;
    unsigned* misc = cnts + 256;
    const int tid = threadIdx.x;
    for (int item = blockIdx.x; item < NTOK; item += gridDim.x) {
        const int tok = item, t = tok & (SEQ - 1), b = tok >> 13, n = t + 1;
        unsigned short* selrow = p.sel + (size_t)tok * 256;
        if (n <= 256) { if (tid < n) selrow[tid] = (unsigned short)tid; continue; }
        __syncthreads();
        qs[tid] = bf2f(p.proj[(size_t)tok * NPROJ + PIQ + tid]);
        const float w0 = p.iw[(size_t)tok * 4 + 0], w1 = p.iw[(size_t)tok * 4 + 1], w2 = p.iw[(size_t)tok * 4 + 2], w3 = p.iw[(size_t)tok * 4 + 3];
        __syncthreads();
        for (int s = tid; s < n; s += 256) {
            const uint4* kr = (const uint4*)(p.proj + ((size_t)b * SEQ + s) * NPROJ + PIK);
            float d0 = 0.f, d1 = 0.f, d2 = 0.f, d3 = 0.f;
#pragma unroll
            for (int c = 0; c < 8; ++c) {
                const uint4 kv = kr[c];
                const float kk[8] = {blo(kv.x), bhi(kv.x), blo(kv.y), bhi(kv.y), blo(kv.z), bhi(kv.z), blo(kv.w), bhi(kv.w)};
#pragma unroll
                for (int e = 0; e < 8; ++e) {
                    const int idx = c * 8 + e;
                    d0 = fmaf(qs[idx], kk[e], d0); d1 = fmaf(qs[64 + idx], kk[e], d1); d2 = fmaf(qs[128 + idx], kk[e], d2); d3 = fmaf(qs[192 + idx], kk[e], d3);
                }
            }
            float v = w0 * fmaxf(d0, 0.f);
            v = fmaf(w1, fmaxf(d1, 0.f), v); v = fmaf(w2, fmaxf(d2, 0.f), v); v = fmaf(w3, fmaxf(d3, 0.f), v);
            sc[s] = v + 0.0f;
        }
        __syncthreads();
        unsigned prefix = 0u, need = 256u;
#pragma unroll 1
        for (int pass = 3; pass >= 0; --pass) {
            hist[tid] = 0u;
            __syncthreads();
            for (int s = tid; s < n; s += 256) {
                const unsigned key = f2key(sc[s]);
                const bool match = (pass == 3) ? true : ((key >> (8 * (pass + 1))) == prefix);
                if (match) atomicAdd(&hist[(key >> (8 * pass)) & 255u], 1u);
            }
            __syncthreads();
            if (tid == 0) {
                unsigned cum = 0u; int bsel = 0;
                for (int bb = 255; bb >= 0; --bb) { const unsigned hh = hist[bb]; if (cum + hh >= need) { bsel = bb; break; } cum += hh; }
                misc[0] = (prefix << 8) | (unsigned)bsel; misc[1] = need - cum;
            }
            __syncthreads();
            prefix = misc[0]; need = misc[1];
            __syncthreads();
        }
        const unsigned tau = prefix, r = need;
        if (tid == 0) misc[2] = 0u;
        const int chunk = (n + 255) >> 8, s0 = tid * chunk, s1 = (s0 + chunk < n) ? s0 + chunk : n;
        unsigned myties = 0u;
        for (int s = s0; s < s1; ++s) myties += (f2key(sc[s]) == tau) ? 1u : 0u;
        cnts[tid] = myties;
        __syncthreads();
        if (tid == 0) { unsigned run = 0u; for (int i = 0; i < 256; ++i) { const unsigned v = cnts[i]; cnts[i] = run; run += v; } }
        __syncthreads();
        unsigned rank = cnts[tid];
        for (int s = s0; s < s1; ++s) {
            const unsigned key = f2key(sc[s]);
            if (key > tau) { const unsigned pos = atomicAdd(&misc[2], 1u); selrow[pos] = (unsigned short)s; }
            else if (key == tau) { if (rank < r) selrow[(256u - r) + rank] = (unsigned short)s; ++rank; }
        }
    }
}

#define N_PHASES 40
template <bool ALL>
__device__ __forceinline__ void run_phases(const Params& p, int only, char* smem) {
    int ph = 0;
#define PHASE(body) do { if (ALL || only == ph) { body; } if (ALL) cg::this_grid().sync(); ++ph; } while (0)
    PHASE(phase_prologue(p, smem));
    PHASE(phase_u0(p));
#pragma unroll 1
    for (int l = 0; l < 2; ++l) {
        const bf16_t* W = p.wts + (size_t)l * WL_ELEMS;
        PHASE(phase_ffn_in(p, l, 0, smem));
        PHASE(phase_gemm_res(p, p.act, DFF, W + W_FOUT0, DFF, l == 0 ? p.x : p.out, l, 0, 0.5f, smem));
        PHASE(phase_ln(p, l, 0, true));
        PHASE(phase_inproj(p, l, smem));
        PHASE(phase_topk(p, smem); phase_scan(p, smem); phase_attn_a(p); phase_attn_c(p));
        PHASE(phase_attn_d(p); phase_attn_b(p));
        PHASE(phase_merge(p, l, smem));
        PHASE(phase_gemm_res(p, p.merged, 1024, W + W_OUT, 1024, p.out, l, 1, 1.0f, smem));
        PHASE(phase_ln(p, l, 1, true));
        PHASE(phase_ffn_in(p, l, 1, smem));
        PHASE(phase_gemm_res(p, p.act, DFF, W + W_FOUT1, DFF, p.out, l, 2, 0.5f, smem));
        PHASE(phase_ln(p, l, 2, l == 0));
    }
#undef PHASE
}
constexpr int TOTAL_PHASES = 2 + 2 * 12;

__global__ void __launch_bounds__(256) mega_kernel(Params p) {
    __shared__ __attribute__((aligned(16))) char smem[36 * 1024];
    run_phases<true>(p, -1, smem);
}
__global__ void __launch_bounds__(256) phase_kernel(Params p, int only) {
    __shared__ __attribute__((aligned(16))) char smem[36 * 1024];
    run_phases<false>(p, only, smem);
}

extern "C" void kernel_launch(void* const* d_in, const int* in_sizes, int n_in, void* d_out, int out_size, void* d_ws, size_t ws_size, hipStream_t stream) {
    Params p{};
    p.x = (const float*)d_in[0]; p.c = (const float*)d_in[1]; p.ada_w = (const float*)d_in[2]; p.ada_b = (const float*)d_in[3];
    p.ln_g = (const float*)d_in[4]; p.ln_b = (const float*)d_in[5]; p.ffn_w_in = (const float*)d_in[6]; p.ffn_w_out = (const float*)d_in[7];
    p.mix_w_in = (const float*)d_in[8]; p.mix_b_gate = (const float*)d_in[9]; p.mix_b_forget = (const float*)d_in[10];
    p.mix_w_branch = (const float*)d_in[11]; p.mix_w_out = (const float*)d_in[12];
    p.out = (float*)d_out;
    char* ws = (char*)d_ws; size_t off = 0;
    auto take = [&](size_t bytes) { char* r = ws + off; off += (bytes + 255) & ~(size_t)255; return r; };
    p.wts = (bf16_t*)take(2 * WL_ELEMS * 2);
    p.mod = (float*)take(2 * 4 * 9216 * 4);
    p.rope = (float*)take(SEQ * 16 * 4);
    p.ubuf = (bf16_t*)take((size_t)NTOK * 1024 * 2);
    char* region = ws + off;
    p.act = (bf16_t*)region;
    p.proj = (bf16_t*)take((size_t)NTOK * NPROJ * 2);
    p.merged = p.proj;
    p.iw = (float*)take((size_t)NTOK * 16); p.logf = (float*)take((size_t)NTOK * 16); p.cum = (float*)take((size_t)NTOK * 16);
    p.sel = (unsigned short*)take((size_t)NTOK * 512);
    p.ybuf = (bf16_t*)take((size_t)NTOK * 896 * 2);
    if (off > ws_size) { fprintf(stderr, "workspace too small: need %zu have %zu\n", off, ws_size); return; }
#if COOP
    static int grid_blocks = 0;
    if (!grid_blocks) {
        int dev = 0, cus = 0, per_cu = 0;
        hipGetDevice(&dev);
        hipDeviceGetAttribute(&cus, hipDeviceAttributeMultiprocessorCount, dev);
        hipOccupancyMaxActiveBlocksPerMultiprocessor(&per_cu, mega_kernel, 256, 0);
        if (per_cu > 2) per_cu = 2;
        grid_blocks = cus * per_cu;
    }
    void* args[] = {&p};
    hipError_t e = hipLaunchCooperativeKernel((void*)mega_kernel, dim3(grid_blocks), dim3(256), args, 0, stream);
    if (e != hipSuccess) fprintf(stderr, "cooperative launch failed: %s (grid %d)\n", hipGetErrorString(e), grid_blocks);
#else
    for (int ph = 0; ph < TOTAL_PHASES; ++ph) phase_kernel<<<512, 256, 0, stream>>>(p, ph);
#endif
}
```

```cpp
#include <hip/hip_runtime.h>
#include <hip/hip_cooperative_groups.h>
#include <cstdio>
#include <cstdint>
namespace cg = cooperative_groups;

constexpr int NTHR = 512, NWV = 8;
constexpr int DM = 1024, SEQ = 8192, NTOK = 4 * 8192, DFF = 2816;
constexpr int NPROJ = 3840;
constexpr int PA = 0, PB = 1152, PIQ = 1920, PIK = 2176, PC = 2240, PD = 3008, PIW = 3776;
constexpr float ALPHA = 1.41421356237f;
constexpr size_t W_FIN0 = 0, W_FIN1 = 5767168, W_FOUT0 = 11534336, W_FOUT1 = 11534336 + 2883584, W_IN = 17301504,
                 W_GATE = 21233664, W_BR = 25427968, W_OUT = 26345472, WL_ELEMS = 27394048;
constexpr int LDS_BYTES = 131072;


typedef unsigned short bf16_t;
typedef short bf16x8 __attribute__((ext_vector_type(8)));
typedef float f32x4 __attribute__((ext_vector_type(4)));

struct Params {
    const float *x, *c, *ada_w, *ada_b, *ln_g, *ln_b, *ffn_w_in, *ffn_w_out, *mix_w_in, *mix_b_gate, *mix_b_forget, *mix_w_branch, *mix_w_out;
    float* out;
    bf16_t* wts; float* mod; float* rope; bf16_t* ubuf; bf16_t* act; bf16_t* proj; bf16_t* merged;
    float* iw; float* logf; float* cum; unsigned short* sel; bf16_t* ybuf;
};

__device__ __forceinline__ bf16_t f2bf(float f) { unsigned u = __float_as_uint(f); u += 0x7FFFu + ((u >> 16) & 1u); return (bf16_t)(u >> 16); }
__device__ __forceinline__ float bf2f(bf16_t h) { return __uint_as_float(((unsigned)h) << 16); }
__device__ __forceinline__ float blo(unsigned u) { return __uint_as_float(u << 16); }
__device__ __forceinline__ float bhi(unsigned u) { return __uint_as_float(u & 0xffff0000u); }
__device__ __forceinline__ int otid() { int t = threadIdx.x; asm volatile("" : "+v"(t)); return t; }
__device__ __forceinline__ float log_sigmoid(float x) { return fminf(x, 0.f) - log1pf(expf(-fabsf(x))); }

__device__ __forceinline__ int colmap(int mode, int n) {
    if (mode == 0) return n;
    if (mode == 1) { int q = n >> 8, r = n & 255; return r < 128 ? 128 * q + r : 2816 + 128 * q + (r - 128); }
    if (mode == 2) { if (n < 2240) return n; if (n < 3776) return n + 4; if (n < 3780) return 2240 + (n - 3776); if (n < 3784) return n; return -1; }
    return 3784 + n;
}
__device__ __forceinline__ void convert_job(const float* __restrict__ src, int K, int Nsrc, bf16_t* __restrict__ dst, int Ndst, int mode, char* smem) {
    float (*t)[33] = (float (*)[33])smem;
    const int tid = threadIdx.x, tx = tid & 31, ty = tid >> 5;
    const int kt_n = K / 64, ntiles = kt_n * (Ndst / 32);
    for (int tile = blockIdx.x; tile < ntiles; tile += gridDim.x) {
        const int k0 = (tile % kt_n) * 64, n0 = (tile / kt_n) * 32;
        const int sc = colmap(mode, n0 + tx);
        __syncthreads();
#pragma unroll
        for (int i = 0; i < 4; ++i) { const int k = ty + 16 * i; t[k][tx] = sc >= 0 ? src[(size_t)(k0 + k) * Nsrc + sc] : 0.f; }
        __syncthreads();
        const int kk = tid & 63, nb = tid >> 6;
#pragma unroll
        for (int i = 0; i < 4; ++i) { const int n = nb + 8 * i; dst[(size_t)(n0 + n) * K + k0 + kk] = f2bf(t[kk][n]); }
    }
}

__device__ __forceinline__ void phase_prologue(const Params& p, char* smem) {
    for (int l = 0; l < 2; ++l) {
        bf16_t* w = p.wts + (size_t)l * WL_ELEMS;
        convert_job(p.ffn_w_in + (size_t)(l * 2 + 0) * 1024 * 5632, 1024, 5632, w + W_FIN0, 5632, 1, smem);
        convert_job(p.ffn_w_in + (size_t)(l * 2 + 1) * 1024 * 5632, 1024, 5632, w + W_FIN1, 5632, 1, smem);
        convert_job(p.ffn_w_out + (size_t)(l * 2 + 0) * 2816 * 1024, 2816, 1024, w + W_FOUT0, 1024, 0, smem);
        convert_job(p.ffn_w_out + (size_t)(l * 2 + 1) * 2816 * 1024, 2816, 1024, w + W_FOUT1, 1024, 0, smem);
        convert_job(p.mix_w_in + (size_t)l * 1024 * 7880, 1024, 7880, w + W_IN, 3840, 2, smem);
        convert_job(p.mix_w_in + (size_t)l * 1024 * 7880, 1024, 7880, w + W_GATE, 4096, 3, smem);
        convert_job(p.mix_w_branch + (size_t)l * 896 * 1024, 896, 1024, w + W_BR, 1024, 0, smem);
        convert_job(p.mix_w_out + (size_t)l * 1024 * 1024, 1024, 1024, w + W_OUT, 1024, 0, smem);
    }
    for (int idx = blockIdx.x * NTHR + threadIdx.x; idx < SEQ * 8; idx += gridDim.x * NTHR) {
        const int t = idx >> 3, i = idx & 7;
        const float invf = powf(500000.0f, -(float)i * 0.125f);
        const float ang = (float)t * invf;
        p.rope[idx * 2 + 0] = cosf(ang);
        p.rope[idx * 2 + 1] = sinf(ang);
    }
    __syncthreads();
    float* scs = (float*)smem;
    float* red = scs + 4096;
    for (int i = threadIdx.x; i < 4096; i += NTHR) { const float v = p.c[i]; scs[i] = v / (1.f + expf(-v)); }
    __syncthreads();
    const int tid = threadIdx.x, cl = tid & 63, kq = tid >> 6;
    for (int item = blockIdx.x; item < 288; item += gridDim.x) {
        const int l = item / 144, col = (item % 144) * 64 + cl;
        float a0 = 0.f, a1 = 0.f, a2 = 0.f, a3 = 0.f;
        const float* wp = p.ada_w + ((size_t)l * 1024 + kq * 128) * 9216 + col;
#pragma unroll 8
        for (int k = 0; k < 128; ++k) {
            const float w = wp[(size_t)k * 9216]; const int kk = kq * 128 + k;
            a0 = fmaf(scs[kk], w, a0); a1 = fmaf(scs[1024 + kk], w, a1); a2 = fmaf(scs[2048 + kk], w, a2); a3 = fmaf(scs[3072 + kk], w, a3);
        }
        red[(kq * 4 + 0) * 64 + cl] = a0; red[(kq * 4 + 1) * 64 + cl] = a1; red[(kq * 4 + 2) * 64 + cl] = a2; red[(kq * 4 + 3) * 64 + cl] = a3;
        __syncthreads();
        if (kq < 4) {
            const int b = kq; float s = 0.f;
#pragma unroll
            for (int q = 0; q < 8; ++q) s += red[(q * 4 + b) * 64 + cl];
            p.mod[(size_t)(l * 4 + b) * 9216 + col] = s + p.ada_b[(size_t)l * 9216 + col];
        }
        __syncthreads();
    }
}

__device__ __forceinline__ void phase_u0(const Params& p) {
    const size_t n4 = (size_t)NTOK * 256;
    for (size_t i = (size_t)blockIdx.x * NTHR + threadIdx.x; i < n4; i += (size_t)gridDim.x * NTHR) {
        const size_t row = i >> 8; const int c4 = (int)(i & 255) * 4; const int b = (int)(row >> 13);
        const float4 v = *(const float4*)(p.x + row * 1024 + c4);
        const float* md = p.mod + (size_t)(0 * 4 + b) * 9216;
        const float4 sh = *(const float4*)(md + c4), sc = *(const float4*)(md + 1024 + c4);
        ushort4 o; o.x = f2bf(v.x * (1.f + sc.x) + sh.x); o.y = f2bf(v.y * (1.f + sc.y) + sh.y); o.z = f2bf(v.z * (1.f + sc.z) + sh.z); o.w = f2bf(v.w * (1.f + sc.w) + sh.w);
        *(ushort4*)(p.ubuf + row * 1024 + c4) = o;
    }
}

__device__ __forceinline__ void gemm_mainloop(f32x4 (&acc)[4][4], const bf16_t* __restrict__ A, int lda, const bf16_t* __restrict__ Bt, int ldb, int K, char* smem) {
    bf16_t* As = (bf16_t*)smem; bf16_t* Bs = As + 256 * 40;
    int tid_ = threadIdx.x; asm volatile("" : "+v"(tid_));
    const int tid = tid_, lane = tid & 63, wid = tid >> 6, wr = wid >> 1, wc = wid & 1;
    const int lr = tid >> 1, lk = (tid & 1) * 16;
    const int br = (tid & 255) >> 1;
    const bool ldB = tid < 256;
    const uint4* ga = (const uint4*)(A + (size_t)lr * lda + lk);
    const uint4* gb = (const uint4*)(Bt + (size_t)br * ldb + lk);
    uint4 ra0 = ga[0], ra1 = ga[1], rb0 = make_uint4(0, 0, 0, 0), rb1 = rb0;
    if (ldB) { rb0 = gb[0]; rb1 = gb[1]; }
    const int fr = lane & 15, fq = lane >> 4;
    for (int k0 = 0; k0 < K; k0 += 32) {
        __syncthreads();
        *(uint4*)&As[lr * 40 + lk] = ra0; *(uint4*)&As[lr * 40 + lk + 8] = ra1;
        if (ldB) { *(uint4*)&Bs[br * 40 + lk] = rb0; *(uint4*)&Bs[br * 40 + lk + 8] = rb1; }
        __syncthreads();
        if (k0 + 32 < K) { ga += 4; gb += 4; ra0 = ga[0]; ra1 = ga[1]; if (ldB) { rb0 = gb[0]; rb1 = gb[1]; } }
        bf16x8 a[4], b[4];
#pragma unroll
        for (int m = 0; m < 4; ++m) a[m] = *(const bf16x8*)&As[(wr * 64 + m * 16 + fr) * 40 + fq * 8];
#pragma unroll
        for (int n = 0; n < 4; ++n) b[n] = *(const bf16x8*)&Bs[(wc * 64 + n * 16 + fr) * 40 + fq * 8];
#pragma unroll
        for (int m = 0; m < 4; ++m)
#pragma unroll
            for (int n = 0; n < 4; ++n) acc[m][n] = __builtin_amdgcn_mfma_f32_16x16x32_bf16(a[m], b[n], acc[m][n], 0, 0, 0);
    }
}
__device__ __forceinline__ void zero_acc(f32x4 (&acc)[4][4]) {
#pragma unroll
    for (int m = 0; m < 4; ++m)
#pragma unroll
        for (int n = 0; n < 4; ++n) acc[m][n] = (f32x4){0.f, 0.f, 0.f, 0.f};
}
__device__ __forceinline__ void phase_merge(const Params& p, int l, char* smem) {
    const bf16_t* WG = p.wts + (size_t)l * WL_ELEMS + W_GATE; const bf16_t* WB = p.wts + (size_t)l * WL_ELEMS + W_BR;
    const int tid = otid(), lane = tid & 63, wid = tid >> 6, wr = wid >> 1, wc = wid & 1, fr = lane & 15, fq = lane >> 4;
    for (int tile = blockIdx.x; tile < 128 * 8; tile += gridDim.x) {
        const int pm = tile / 8, pn = tile % 8;
        f32x4 accM[4][4]; zero_acc(accM);
#pragma unroll 1
        for (int br = 0; br < 4; ++br) {
            const int koff = br == 0 ? 0 : 128 + (br - 1) * 256, kb = br == 0 ? 128 : 256;
            f32x4 accG[4][4]; zero_acc(accG);
            gemm_mainloop(accG, p.ubuf + (size_t)pm * 256 * 1024, 1024, WG + (size_t)(br * 1024 + pn * 128) * 1024, 1024, 1024, smem);
            const float* bg = p.mix_b_gate + (size_t)l * 4096 + br * 1024;
#pragma unroll
            for (int n = 0; n < 4; ++n) {
                const float bv = bg[pn * 128 + wc * 64 + n * 16 + fr];
#pragma unroll
                for (int m = 0; m < 4; ++m)
#pragma unroll
                    for (int j = 0; j < 4; ++j) accG[m][n][j] = 1.f / (1.f + expf(-(accG[m][n][j] + bv)));
            }
            unsigned* gst = (unsigned*)(smem + 32768) + tid;
#pragma unroll
            for (int m = 0; m < 4; ++m)
#pragma unroll
                for (int n = 0; n < 4; ++n) {
                    gst[((m * 4 + n) * 2 + 0) * NTHR] = (unsigned)f2bf(accG[m][n][0]) | ((unsigned)f2bf(accG[m][n][1]) << 16);
                    gst[((m * 4 + n) * 2 + 1) * NTHR] = (unsigned)f2bf(accG[m][n][2]) | ((unsigned)f2bf(accG[m][n][3]) << 16);
                }
            zero_acc(accG);
            gemm_mainloop(accG, p.ybuf + (size_t)pm * 256 * 896 + koff, 896, WB + (size_t)pn * 128 * 896 + koff, 896, kb, smem);
#pragma unroll
            for (int m = 0; m < 4; ++m)
#pragma unroll
                for (int n = 0; n < 4; ++n) {
                    const unsigned g01 = gst[((m * 4 + n) * 2 + 0) * NTHR], g23 = gst[((m * 4 + n) * 2 + 1) * NTHR];
                    accM[m][n][0] += blo(g01) * accG[m][n][0]; accM[m][n][1] += bhi(g01) * accG[m][n][1];
                    accM[m][n][2] += blo(g23) * accG[m][n][2]; accM[m][n][3] += bhi(g23) * accG[m][n][3];
                }
        }
#pragma unroll
        for (int m = 0; m < 4; ++m)
#pragma unroll
            for (int n = 0; n < 4; ++n)
#pragma unroll
                for (int j = 0; j < 4; ++j)
                    p.merged[(size_t)(pm * 256 + wr * 64 + m * 16 + fq * 4 + j) * 1024 + pn * 128 + wc * 64 + n * 16 + fr] = f2bf(accM[m][n][j]);
    }
}

__device__ __forceinline__ void phase_ln(const Params& p, int l, int s, bool has_next) {
    const int tid_ = otid(), lane = tid_ & 63, wid = tid_ >> 6;
    const float* g = p.ln_g + (size_t)(l * 3 + s) * 1024; const float* bb = p.ln_b + (size_t)(l * 3 + s) * 1024;
    const int nl = s < 2 ? l : l + 1, ns = s < 2 ? s + 1 : 0;
    for (int row = blockIdx.x * NWV + wid; row < NTOK; row += gridDim.x * NWV) {
        float* xr = p.out + (size_t)row * 1024;
        float4 v[4]; float sum = 0.f;
#pragma unroll
        for (int i = 0; i < 4; ++i) { v[i] = *(const float4*)(xr + lane * 4 + 256 * i); sum += (v[i].x + v[i].y) + (v[i].z + v[i].w); }
#pragma unroll
        for (int o = 32; o > 0; o >>= 1) sum += __shfl_xor(sum, o);
        const float mu = sum * (1.f / 1024.f); float q = 0.f;
#pragma unroll
        for (int i = 0; i < 4; ++i) { const float a = v[i].x - mu, b2 = v[i].y - mu, c = v[i].z - mu, d = v[i].w - mu; q += (a * a + b2 * b2) + (c * c + d * d); }
#pragma unroll
        for (int o = 32; o > 0; o >>= 1) q += __shfl_xor(q, o);
        const float rstd = 1.0f / sqrtf(q * (1.f / 1024.f) + 1e-5f);
        const int b = row >> 13;
        const float* md = p.mod + (size_t)(nl * 4 + b) * 9216 + ns * 3072;
#pragma unroll
        for (int i = 0; i < 4; ++i) {
            const int c4 = lane * 4 + 256 * i;
            const float4 gg = *(const float4*)(g + c4), be = *(const float4*)(bb + c4);
            float4 o; o.x = (v[i].x - mu) * rstd * gg.x + be.x; o.y = (v[i].y - mu) * rstd * gg.y + be.y; o.z = (v[i].z - mu) * rstd * gg.z + be.z; o.w = (v[i].w - mu) * rstd * gg.w + be.w;
            *(float4*)(xr + c4) = o;
            if (has_next) {
                const float4 sh = *(const float4*)(md + c4), sc = *(const float4*)(md + 1024 + c4);
                ushort4 u; u.x = f2bf(o.x * (1.f + sc.x) + sh.x); u.y = f2bf(o.y * (1.f + sc.y) + sh.y); u.z = f2bf(o.z * (1.f + sc.z) + sh.z); u.w = f2bf(o.w * (1.f + sc.w) + sh.w);
                *(ushort4*)(p.ubuf + (size_t)row * 1024 + c4) = u;
            }
        }
    }
}

__device__ __forceinline__ void load_row32(float (&q)[32], const bf16_t* row) {
    const uint4* r = (const uint4*)row;
#pragma unroll
    for (int c = 0; c < 4; ++c) { const uint4 v = r[c];
        q[c * 8 + 0] = blo(v.x); q[c * 8 + 1] = bhi(v.x); q[c * 8 + 2] = blo(v.y); q[c * 8 + 3] = bhi(v.y);
        q[c * 8 + 4] = blo(v.z); q[c * 8 + 5] = bhi(v.z); q[c * 8 + 6] = blo(v.w); q[c * 8 + 7] = bhi(v.w); }
}
__device__ __forceinline__ float dot32(const float (&q)[32], const bf16_t* row) {
    const uint4* r = (const uint4*)row; float a = 0.f;
#pragma unroll
    for (int c = 0; c < 4; ++c) { const uint4 v = r[c];
        a = fmaf(q[c * 8 + 0], blo(v.x), a); a = fmaf(q[c * 8 + 1], bhi(v.x), a); a = fmaf(q[c * 8 + 2], blo(v.y), a); a = fmaf(q[c * 8 + 3], bhi(v.y), a);
        a = fmaf(q[c * 8 + 4], blo(v.z), a); a = fmaf(q[c * 8 + 5], bhi(v.z), a); a = fmaf(q[c * 8 + 6], blo(v.w), a); a = fmaf(q[c * 8 + 7], bhi(v.w), a); }
    return a + __shfl_xor(a, 1);
}
__device__ __forceinline__ void axpy32(float (&o)[32], float sc, float pw, const bf16_t* row) {
    const uint4* r = (const uint4*)row;
#pragma unroll
    for (int c = 0; c < 4; ++c) { const uint4 v = r[c];
        o[c * 8 + 0] = fmaf(pw, blo(v.x), o[c * 8 + 0] * sc); o[c * 8 + 1] = fmaf(pw, bhi(v.x), o[c * 8 + 1] * sc);
        o[c * 8 + 2] = fmaf(pw, blo(v.y), o[c * 8 + 2] * sc); o[c * 8 + 3] = fmaf(pw, bhi(v.y), o[c * 8 + 3] * sc);
        o[c * 8 + 4] = fmaf(pw, blo(v.z), o[c * 8 + 4] * sc); o[c * 8 + 5] = fmaf(pw, bhi(v.z), o[c * 8 + 5] * sc);
        o[c * 8 + 6] = fmaf(pw, blo(v.w), o[c * 8 + 6] * sc); o[c * 8 + 7] = fmaf(pw, bhi(v.w), o[c * 8 + 7] * sc); }
}
__device__ __forceinline__ void store_row32(bf16_t* dst, const float (&o)[32], float sc) {
    uint4* r = (uint4*)dst;
#pragma unroll
    for (int c = 0; c < 4; ++c) { uint4 v;
        v.x = (unsigned)f2bf(o[c * 8 + 0] * sc) | ((unsigned)f2bf(o[c * 8 + 1] * sc) << 16); v.y = (unsigned)f2bf(o[c * 8 + 2] * sc) | ((unsigned)f2bf(o[c * 8 + 3] * sc) << 16);
        v.z = (unsigned)f2bf(o[c * 8 + 4] * sc) | ((unsigned)f2bf(o[c * 8 + 5] * sc) << 16); v.w = (unsigned)f2bf(o[c * 8 + 6] * sc) | ((unsigned)f2bf(o[c * 8 + 7] * sc) << 16);
        r[c] = v; }
}
__device__ __forceinline__ void zero32(float (&o)[32]) {
#pragma unroll
    for (int i = 0; i < 32; ++i) o[i] = 0.f;
}

__device__ __forceinline__ void phase_attn_a(const Params& p) {
    const int tid_ = otid(), lane = tid_ & 63, gw = blockIdx.x * NWV + (tid_ >> 6), nw = gridDim.x * NWV, hf = (lane & 1) * 32;
    for (int item = gw; item < 4 * 2 * 256; item += nw) {
        const int hp = item & 1, blk = (item >> 1) & 255, b = item >> 9;
        const int t = blk * 32 + (lane >> 1); const size_t tok = (size_t)b * SEQ + t;
        float o[32]; zero32(o); float mx = -INFINITY, lsum = 0.f;
#pragma unroll 1
        for (int g = 0; g < 3; ++g) {
            const int head = 2 * g + hp, dil = g == 0 ? 1 : (g == 1 ? 4 : 16);
            float q[32]; load_row32(q, p.proj + tok * NPROJ + PA + head * 64 + hf);
#pragma unroll 1
            for (int j = 0; j <= 128; ++j) {
                const int s = t - j * dil;
                if (s >= 0) {
                    const bf16_t* kr = p.proj + ((size_t)b * SEQ + s) * NPROJ + PA + 384 + head * 64 + hf;
                    const float x = dot32(q, kr) * 0.125f;
                    const float mn = fmaxf(mx, x), sc = expf(mx - mn), pw = expf(x - mn);
                    lsum = lsum * sc + pw; mx = mn;
                    axpy32(o, sc, pw, kr + 384);
                }
            }
        }
        store_row32(p.ybuf + tok * 896 + hp * 64 + hf, o, 1.f / lsum);
    }
}
__device__ __forceinline__ void phase_attn_c(const Params& p) {
    const int tid_ = otid(), lane = tid_ & 63, gw = blockIdx.x * NWV + (tid_ >> 6), nw = gridDim.x * NWV, hf = (lane & 1) * 32;
    for (int item = gw; item < 4 * 4 * 256; item += nw) {
        const int h = item & 3, blk = (item >> 2) & 255, b = item >> 10;
        const int t0 = blk * 32, t = t0 + (lane >> 1); const size_t tok = (size_t)b * SEQ + t;
        float q[32]; load_row32(q, p.proj + tok * NPROJ + PC + h * 64 + hf);
        float o[32]; zero32(o); float run = 0.f;
#pragma unroll 1
        for (int s = t0 + 30; s >= 0; --s) {
            if (s < t) {
                const bf16_t* kr = p.proj + ((size_t)b * SEQ + s) * NPROJ + PC + 256 + h * 64 + hf;
                const float z = dot32(q, kr) * 0.125f;
                const float lb = log_sigmoid(z);
                const float a = expf(lb + run);
                axpy32(o, 1.f, a, kr + 256);
                run += lb - z;
            }
            if (__all(run < -60.f)) break;
        }
        store_row32(p.ybuf + tok * 896 + 384 + h * 64 + hf, o, 1.f);
    }
}
__device__ __forceinline__ void phase_attn_d(const Params& p) {
    const int tid_ = otid(), lane = tid_ & 63, gw = blockIdx.x * NWV + (tid_ >> 6), nw = gridDim.x * NWV, hf = (lane & 1) * 32;
    for (int item = gw; item < 4 * 4 * 256; item += nw) {
        const int h = item & 3, b = (item >> 2) & 3; int blk = item >> 4; if (blk >= 128) blk = 383 - blk;
        const int t0 = blk * 32, t = t0 + (lane >> 1); const size_t tok = (size_t)b * SEQ + t;
        float q[32]; load_row32(q, p.proj + tok * NPROJ + PD + h * 64 + hf);
        float o[32]; zero32(o); float mx = -INFINITY, lsum = 0.f;
        const float cq = p.cum[tok * 4 + h];
#pragma unroll 1
        for (int s = 0; s <= t0 + 31; ++s) {
            if (s <= t) {
                const bf16_t* kr = p.proj + ((size_t)b * SEQ + s) * NPROJ + PD + 256 + h * 64 + hf;
                const float x = dot32(q, kr) * 0.125f + (cq - p.cum[((size_t)b * SEQ + s) * 4 + h]);
                const float mn = fmaxf(mx, x), sc = expf(mx - mn), pw = expf(x - mn);
                lsum = lsum * sc + pw; mx = mn;
                axpy32(o, sc, pw, kr + 256);
            }
        }
        store_row32(p.ybuf + tok * 896 + 640 + h * 64 + hf, o, 1.f / lsum);
    }
}
__device__ __forceinline__ void phase_attn_b(const Params& p) {
    const int tid_ = otid(), lane = tid_ & 63, gw = blockIdx.x * NWV + (tid_ >> 6), nw = gridDim.x * NWV, hf = (lane & 1) * 32;
    for (int item = gw; item < 4 * 4 * 256; item += nw) {
        const int h = item & 3, blk = (item >> 2) & 255, b = item >> 10;
        const int t = blk * 32 + (lane >> 1); const size_t tok = (size_t)b * SEQ + t;
        float q[32]; load_row32(q, p.proj + tok * NPROJ + PB + h * 64 + hf);
        float o[32]; zero32(o); float mx = -INFINITY, lsum = 0.f;
        const int cnt = t + 1 < 256 ? t + 1 : 256;
        const unsigned short* sl = p.sel + tok * 256;
#pragma unroll 1
        for (int i = 0; i < 256; ++i) {
            if (i < cnt) {
                const int s = sl[i];
                const bf16_t* kr = p.proj + ((size_t)b * SEQ + s) * NPROJ + PB + 256 + h * 64 + hf;
                const float x = dot32(q, kr) * 0.125f;
                const float mn = fmaxf(mx, x), sc = expf(mx - mn), pw = expf(x - mn);
                lsum = lsum * sc + pw; mx = mn;
                axpy32(o, sc, pw, kr + 256);
            }
        }
        store_row32(p.ybuf + tok * 896 + 128 + h * 64 + hf, o, 1.f / lsum);
    }
}
__device__ __forceinline__ void phase_scan(const Params& p, char* smem) {
    double* part = (double*)smem;
    const int tid = otid();
    for (int item = blockIdx.x; item < 16; item += gridDim.x) {
        const int b = item >> 2, h = item & 3;
        const float* lf = p.logf + ((size_t)b * SEQ + tid * 16) * 4 + h;
        double s = 0.0;
        for (int i = 0; i < 16; ++i) s += (double)lf[i * 4];
        __syncthreads();
        part[tid] = s;
        __syncthreads();
        if (tid == 0) { double r = 0.0; for (int i = 0; i < NTHR; ++i) { const double v = part[i]; part[i] = r; r += v; } }
        __syncthreads();
        double r = part[tid];
        float* cm = p.cum + ((size_t)b * SEQ + tid * 16) * 4 + h;
        for (int i = 0; i < 16; ++i) { r += (double)lf[i * 4]; cm[i * 4] = (float)r; }
    }
}
__device__ __forceinline__ unsigned f2key(float f) { const unsigned u = __float_as_uint(f); return (u & 0x80000000u) ? ~u : (u | 0x80000000u); }
__device__ __forceinline__ void phase_topk(const Params& p, char* smem) {
    float* sc = (float*)smem;
    float* qs = sc + 8192;
    unsigned* hist = (unsigned*)(qs + 256);
    unsigned* cnts = hist + 256;
    unsigned* misc = cnts + NTHR;
    const int tid = otid();
    for (int item = blockIdx.x; item < NTOK; item += gridDim.x) {
        const int tok = item, t = tok & (SEQ - 1), b = tok >> 13, n = t + 1;
        unsigned short* selrow = p.sel + (size_t)tok * 256;
        if (n <= 256) { if (tid < n) selrow[tid] = (unsigned short)tid; continue; }
        __syncthreads();
        if (tid < 256) qs[tid] = bf2f(p.proj[(size_t)tok * NPROJ + PIQ + tid]);
        const float w0 = p.iw[(size_t)tok * 4 + 0], w1 = p.iw[(size_t)tok * 4 + 1], w2 = p.iw[(size_t)tok * 4 + 2], w3 = p.iw[(size_t)tok * 4 + 3];
        __syncthreads();
        for (int s = tid; s < n; s += NTHR) {
            const uint4* kr = (const uint4*)(p.proj + ((size_t)b * SEQ + s) * NPROJ + PIK);
            float d0 = 0.f, d1 = 0.f, d2 = 0.f, d3 = 0.f;
#pragma unroll
            for (int c = 0; c < 8; ++c) {
                const uint4 kv = kr[c];
                const float kk[8] = {blo(kv.x), bhi(kv.x), blo(kv.y), bhi(kv.y), blo(kv.z), bhi(kv.z), blo(kv.w), bhi(kv.w)};
#pragma unroll
                for (int e = 0; e < 8; ++e) {
                    const int idx = c * 8 + e;
                    d0 = fmaf(qs[idx], kk[e], d0); d1 = fmaf(qs[64 + idx], kk[e], d1); d2 = fmaf(qs[128 + idx], kk[e], d2); d3 = fmaf(qs[192 + idx], kk[e], d3);
                }
            }
            float v = w0 * fmaxf(d0, 0.f);
            v = fmaf(w1, fmaxf(d1, 0.f), v); v = fmaf(w2, fmaxf(d2, 0.f), v); v = fmaf(w3, fmaxf(d3, 0.f), v);
            sc[s] = v + 0.0f;
        }
        __syncthreads();
        unsigned prefix = 0u, need = 256u;
#pragma unroll 1
        for (int pass = 3; pass >= 0; --pass) {
            if (tid < 256) hist[tid] = 0u;
            __syncthreads();
            for (int s = tid; s < n; s += NTHR) {
                const unsigned key = f2key(sc[s]);
                const bool match = (pass == 3) ? true : ((key >> (8 * (pass + 1))) == prefix);
                if (match) atomicAdd(&hist[(key >> (8 * pass)) & 255u], 1u);
            }
            __syncthreads();
            if (tid == 0) {
                unsigned cum = 0u; int bsel = 0;
                for (int bb = 255; bb >= 0; --bb) { const unsigned hh = hist[bb]; if (cum + hh >= need) { bsel = bb; break; } cum += hh; }
                misc[0] = (prefix << 8) | (unsigned)bsel; misc[1] = need - cum;
            }
            __syncthreads();
            prefix = misc[0]; need = misc[1];
            __syncthreads();
        }
        const unsigned tau = prefix, r = need;
        if (tid == 0) misc[2] = 0u;
        const int chunk = (n + NTHR - 1) / NTHR, s0 = tid * chunk < n ? tid * chunk : n, s1 = (s0 + chunk < n) ? s0 + chunk : n;
        unsigned myties = 0u;
        for (int s = s0; s < s1; ++s) myties += (f2key(sc[s]) == tau) ? 1u : 0u;
        cnts[tid] = myties;
        __syncthreads();
        if (tid == 0) { unsigned run = 0u; for (int i = 0; i < NTHR; ++i) { const unsigned v = cnts[i]; cnts[i] = run; run += v; } }
        __syncthreads();
        unsigned rank = cnts[tid];
        for (int s = s0; s < s1; ++s) {
            const unsigned key = f2key(sc[s]);
            if (key > tau) { const unsigned pos = atomicAdd(&misc[2], 1u); selrow[pos] = (unsigned short)s; }
            else if (key == tau) { if (rank < r) selrow[(256u - r) + rank] = (unsigned short)s; ++rank; }
        }
    }
}

namespace pg8 {
#define PG8_LAS __attribute__((address_space(3)))
typedef unsigned short bf16_t;
typedef short bf16x8 __attribute__((ext_vector_type(8)));
typedef float f32x4 __attribute__((ext_vector_type(4)));
typedef unsigned u32x4 __attribute__((ext_vector_type(4)));
constexpr int BM = 256, BK = 64, HALF = 128, HTB = HALF * BK * 2  , STAGE_BYTES = 8 * HTB, NXCD = 8, WGM = 8;

__host__ __device__ __forceinline__ int lds_byte(int r, int c) { const int st = (r >> 4) * 2 + (c >> 5), rr = r & 15, cc = c & 31, ob = rr * 64 + cc * 2; return st * 1024 + (ob ^ (((ob >> 9) & 1) << 5)); }
__host__ __device__ __forceinline__ void stage_rc(int b, int& R, int& C) { const int st = b / 1024, sb = b % 1024, swz = sb ^ (((sb >> 9) & 1) << 5); R = (st >> 1) * 16 + swz / 64; C = (st & 1) * 32 + (swz % 64) / 2; }
__host__ __device__ __forceinline__ int perm32(int rho) { const int n = rho >> 4, i = rho & 15; return 8 * (i >> 2) + 4 * n + (i & 3); }

struct Unit { int pm, pn; };
struct Gemm { const bf16_t* A; const bf16_t* Bt; int M, N, K; };

struct StaticOrder {
    int nM, nN, nwg, G, c;
    __host__ __device__ void init(int M, int N, int G_, int c_) { nM = M / BM; nN = N / BM; nwg = nM * nN; G = G_; c = c_; }
    __host__ __device__ bool next(int i, Unit& u) const {
        const long L = (long)i * G + c; if (L >= nwg) return false;
        int wgid = (int)L; { const int q = nwg / NXCD, r = nwg % NXCD, xcd = wgid % NXCD, off = wgid / NXCD; wgid = (xcd < r ? xcd * (q + 1) : r * (q + 1) + (xcd - r) * q) + off; }
        const int nig = WGM * nN, gid = wgid / nig, fm = gid * WGM, gsz = (nM - fm) < WGM ? (nM - fm) : WGM;
        u.pm = fm + ((wgid % nig) % gsz); u.pn = (wgid % nig) / gsz; return true;
    }
    __device__ __forceinline__ void a_ready(const Unit&) const {}
    __device__ __forceinline__ void done(const Unit&) const {}
};

__device__ __forceinline__ unsigned cvt_pk_bf16(float lo, float hi) { unsigned r; asm volatile("v_cvt_pk_bf16_f32 %0, %1, %2" : "=v"(r) : "v"(lo), "v"(hi)); return r; }
__device__ __forceinline__ float silu_f(float g) { return g / (1.f + __expf(-g)); }
struct EpiSwiGLU {
    static constexpr bool PERM = true, AFTER_DRAIN = false;
    bf16_t* O;
    __device__ __forceinline__ void operator()(const f32x4 (&acc)[2][2][4][2], const Unit& u, int wr, int wc, int fr, int fq) const {
        const int row0 = u.pm * BM + wr * 64 + fr, col0 = u.pn * 128 + wc * 32 + 8 * fq;
#pragma unroll
        for (int ai = 0; ai < 2; ++ai)
#pragma unroll
            for (int m = 0; m < 4; ++m) {
                bf16_t* rowp = O + (size_t)(row0 + ai * HALF + m * 16) * 2816 + col0;
                const f32x4 g0 = acc[ai][0][m][0], g1 = acc[ai][0][m][1], u0 = acc[ai][1][m][0], u1 = acc[ai][1][m][1];
                u32x4 w;
                w.x = cvt_pk_bf16(silu_f(g0[0]) * u0[0], silu_f(g0[1]) * u0[1]); w.y = cvt_pk_bf16(silu_f(g0[2]) * u0[2], silu_f(g0[3]) * u0[3]);
                w.z = cvt_pk_bf16(silu_f(g1[0]) * u1[0], silu_f(g1[1]) * u1[1]); w.w = cvt_pk_bf16(silu_f(g1[2]) * u1[2], silu_f(g1[3]) * u1[3]);
                *(u32x4*)rowp = w;
            }
    }
};
struct EpiRes {
    static constexpr bool PERM = false, AFTER_DRAIN = false;
    const float* xres; float* out; const float* modl; int sub; float fac;
    __device__ __forceinline__ void operator()(const f32x4 (&acc)[2][2][4][2], const Unit& u, int wr, int wc, int fr, int fq) const {
        const int b = (u.pm * BM) >> 13;
        const float* gate = modl + (size_t)b * 9216 + sub * 3072 + 2048;
        const int col0 = u.pn * BM + wc * 32 + 4 * fq;
#pragma unroll
        for (int bj = 0; bj < 2; ++bj)
#pragma unroll
            for (int n = 0; n < 2; ++n) {
                const int col = col0 + bj * HALF + n * 16;
                f32x4 gm = *(const f32x4*)(gate + col); gm = (gm + 1.0f) * fac;
#pragma unroll
                for (int ai = 0; ai < 2; ++ai)
#pragma unroll
                    for (int m = 0; m < 4; ++m) {
                        const size_t off = (size_t)(u.pm * BM + ai * HALF + wr * 64 + m * 16 + fr) * 1024 + col;
                        const f32x4 xr = *(const f32x4*)(xres + off);
                        *(f32x4*)(out + off) = xr * 1.41421356237f + gm * acc[ai][bj][m][n];
                    }
            }
    }
};
struct EpiInproj {
    static constexpr bool PERM = true, AFTER_DRAIN = false;
    bf16_t* proj; const float* rope; float* iw; float* logf; const float* bfg;
    __device__ __forceinline__ void operator()(const f32x4 (&acc)[2][2][4][2], const Unit& u, int wr, int wc, int fr, int fq) const {
#pragma unroll
        for (int bj = 0; bj < 2; ++bj) {
            const int cb32 = u.pn * BM + bj * HALF + wc * 32;
            const bool rp = ((cb32 & 63) == 0) && (cb32 < 768 || (cb32 >= 1152 && cb32 < 1664) || (cb32 >= 1920 && cb32 < 2240));
#pragma unroll
            for (int ai = 0; ai < 2; ++ai)
#pragma unroll
                for (int m = 0; m < 4; ++m) {
                    const int row = u.pm * BM + ai * HALF + wr * 64 + m * 16 + fr;
                    f32x4 v0 = acc[ai][bj][m][0], v1 = acc[ai][bj][m][1];
                    if (rp) {
                        const int t = row & 8191;
                        const f32x4* rt = (const f32x4*)(rope + (size_t)t * 16);
                        const f32x4 r0 = rt[0], r1 = rt[1], r2 = rt[2], r3 = rt[3];
                        f32x4 p0, p1;
#pragma unroll
                        for (int j = 0; j < 4; ++j) { p0[j] = __shfl_xor(v0[j], 16); p1[j] = __shfl_xor(v1[j], 16); }
                        if (fq == 0) {
                            v0[0] = v0[0] * r0[0] - p0[0] * r0[1]; v0[1] = v0[1] * r0[2] - p0[1] * r0[3]; v0[2] = v0[2] * r1[0] - p0[2] * r1[1]; v0[3] = v0[3] * r1[2] - p0[3] * r1[3];
                            v1[0] = v1[0] * r2[0] - p1[0] * r2[1]; v1[1] = v1[1] * r2[2] - p1[1] * r2[3]; v1[2] = v1[2] * r3[0] - p1[2] * r3[1]; v1[3] = v1[3] * r3[2] - p1[3] * r3[3];
                        } else if (fq == 1) {
                            v0[0] = v0[0] * r0[0] + p0[0] * r0[1]; v0[1] = v0[1] * r0[2] + p0[1] * r0[3]; v0[2] = v0[2] * r1[0] + p0[2] * r1[1]; v0[3] = v0[3] * r1[2] + p0[3] * r1[3];
                            v1[0] = v1[0] * r2[0] + p1[0] * r2[1]; v1[1] = v1[1] * r2[2] + p1[1] * r2[3]; v1[2] = v1[2] * r3[0] + p1[2] * r3[1]; v1[3] = v1[3] * r3[2] + p1[3] * r3[3];
                        }
                    }
                    u32x4 w; w.x = cvt_pk_bf16(v0[0], v0[1]); w.y = cvt_pk_bf16(v0[2], v0[3]); w.z = cvt_pk_bf16(v1[0], v1[1]); w.w = cvt_pk_bf16(v1[2], v1[3]);
                    *(u32x4*)(proj + (size_t)row * 3840 + cb32 + 8 * fq) = w;
                    if (cb32 == 3776 && fq == 0) {
                        *(f32x4*)(iw + (size_t)row * 4) = v0;
                        f32x4 lf;
#pragma unroll
                        for (int j = 0; j < 4; ++j) { const float xx = v1[j] + bfg[j]; lf[j] = fminf(xx, 0.f) - log1pf(expf(-fabsf(xx))); }
                        *(f32x4*)(logf + (size_t)row * 4) = lf;
                    }
                }
        }
    }
};
template <class Epi, class Sched, bool ALIGN_EPI = false, bool SP2 = false>
__device__ __forceinline__ void gemm_phase(PG8_LAS unsigned char* lds, const Gemm g, const Sched& S, const Epi& E) {
    int tid_ = threadIdx.x; asm volatile("" : "+v"(tid_));
    const int tid = tid_, wid = __builtin_amdgcn_readfirstlane(tid >> 6), lane = tid & 63, wr = wid >> 2, wc = wid & 3, fr = lane & 15, fq = lane >> 4;
    const int K = g.K, nt = K / BK;
    unsigned voffA[2], voffB[2];
#pragma unroll
    for (int i = 0; i < 2; ++i) { int R, C; stage_rc(tid * 16 + i * 8192, R, C); const int Rb = Epi::PERM ? ((R & ~31) + perm32(R & 31)) : R;
        voffA[i] = (unsigned)(R * K + C) * 2u; voffB[i] = (unsigned)(Rb * K + C) * 2u; }
    const size_t kstep = (size_t)(BK * 2);
    const size_t hstep = (size_t)HALF * K * 2;
    const size_t tstep = 2 * hstep;
    const unsigned ldsw = (unsigned)wid * 1024u;
    const int aoff = lds_byte(wr * 64 + fr, fq * 8), boff = lds_byte(wc * 32 + fr, fq * 8);
#define PG8_SA(b, h) (((b) * 2 + (h)) * HTB)
#define PG8_SB(b, h) ((4 + (b) * 2 + (h)) * HTB)
#define PG8_STAGE(bufoff, gbase, voff) do { _Pragma("unroll") for (int _i = 0; _i < 2; ++_i) \
        __builtin_amdgcn_global_load_lds((const unsigned*)((const char*)(gbase) + (voff)[_i]), (PG8_LAS unsigned*)(lds + (bufoff) + ldsw + _i * 8192), 16, 0, 0); } while (0)
#define PG8_LDA(dst, b, h) do { _Pragma("unroll") for (int m = 0; m < 4; ++m) _Pragma("unroll") for (int k = 0; k < 2; ++k) dst[m][k] = *(const PG8_LAS bf16x8*)(lds + PG8_SA(b, h) + aoff + m * 2048 + k * 1024); } while (0)
#define PG8_LDB(dst, b, h) do { _Pragma("unroll") for (int n = 0; n < 2; ++n) _Pragma("unroll") for (int k = 0; k < 2; ++k) dst[n][k] = *(const PG8_LAS bf16x8*)(lds + PG8_SB(b, h) + boff + n * 2048 + k * 1024); } while (0)
#define PG8_MMA(ai, bj, At, Bt) do { __builtin_amdgcn_s_setprio(1); _Pragma("unroll") for (int m = 0; m < 4; ++m) _Pragma("unroll") for (int n = 0; n < 2; ++n) _Pragma("unroll") for (int k = 0; k < 2; ++k) \
        acc[ai][bj][m][n] = __builtin_amdgcn_mfma_f32_16x16x32_bf16(Bt[n][k], At[m][k], acc[ai][bj][m][n], 0, 0, 0); __builtin_amdgcn_s_setprio(0); } while (0)
#define PG8_WAIT_V(n) asm volatile("s_waitcnt vmcnt(" #n ")" ::: "memory")
#define PG8_WAIT_L(n) asm volatile("s_waitcnt lgkmcnt(" #n ")" ::: "memory")
#define PG8_BAR __builtin_amdgcn_s_barrier()
#define PG8_SCHED __builtin_amdgcn_sched_barrier(0)
    Unit cur, nxt; int ui = 0;
    if (!S.next(0, cur)) return;
    f32x4 acc[2][2][4][2];
#pragma unroll
    for (int a = 0; a < 2; ++a)
#pragma unroll
        for (int b = 0; b < 2; ++b)
#pragma unroll
            for (int m = 0; m < 4; ++m)
#pragma unroll
                for (int n = 0; n < 2; ++n) acc[a][b][m][n] = (f32x4){0.f, 0.f, 0.f, 0.f};
    bf16x8 At[4][2], B0[2][2], B1[2][2];
    const char* cA = (const char*)g.A + (size_t)cur.pm * tstep; const char* cB = (const char*)g.Bt + (size_t)cur.pn * tstep;
    S.a_ready(cur);
    if constexpr (SP2) {
        PG8_STAGE(PG8_SB(0, 0), cB, voffB); PG8_STAGE(PG8_SB(0, 1), cB + hstep, voffB); PG8_STAGE(PG8_SA(0, 0), cA, voffA); PG8_STAGE(PG8_SA(0, 1), cA + hstep, voffA);
        if (wr == 1) PG8_BAR;
        PG8_WAIT_V(2); PG8_BAR;
        PG8_STAGE(PG8_SB(1, 0), cB + kstep, voffB); PG8_STAGE(PG8_SA(1, 0), cA + kstep, voffA); PG8_STAGE(PG8_SB(1, 1), cB + hstep + kstep, voffB);
        PG8_WAIT_V(6); PG8_BAR;
    } else {
        PG8_STAGE(PG8_SB(0, 0), cB, voffB); PG8_STAGE(PG8_SA(0, 0), cA, voffA); PG8_STAGE(PG8_SB(0, 1), cB + hstep, voffB); PG8_STAGE(PG8_SA(0, 1), cA + hstep, voffA);
        if (wr == 1) PG8_BAR;
        PG8_WAIT_V(4); PG8_BAR;
        PG8_STAGE(PG8_SB(1, 0), cB + kstep, voffB); PG8_STAGE(PG8_SA(1, 0), cA + kstep, voffA); PG8_STAGE(PG8_SB(1, 1), cB + hstep + kstep, voffB);
        PG8_WAIT_V(6); PG8_BAR;
    }
    for (;;) {
        const bool has_next = S.next(ui + 1, nxt);
        const char* nA = has_next ? (const char*)g.A + (size_t)nxt.pm * tstep : cA; const char* nB = has_next ? (const char*)g.Bt + (size_t)nxt.pn * tstep : cB;
        for (int t = 0; t < nt; t += 2) {
            const bool last = (t == nt - 2);
            const char* a1 = cA + (size_t)(t + 1) * kstep;
            const char* a2 = last ? nA : cA + (size_t)(t + 2) * kstep; const char* b2 = last ? nB : cB + (size_t)(t + 2) * kstep;
            const char* a3 = a2 + kstep; const char* b3 = b2 + kstep;
            if (last && has_next) S.a_ready(nxt);
            if constexpr (SP2) {
            PG8_LDB(B0, 0, 0); PG8_LDB(B1, 0, 1); PG8_SCHED; PG8_LDA(At, 0, 0); PG8_STAGE(PG8_SA(1, 1), a1 + hstep, voffA);
            PG8_WAIT_V(8); PG8_WAIT_L(0); PG8_BAR; PG8_MMA(0, 0, At, B0); PG8_MMA(0, 1, At, B1); PG8_BAR; PG8_SCHED;
            PG8_LDA(At, 0, 1); PG8_STAGE(PG8_SB(0, 0), b2, voffB); PG8_STAGE(PG8_SB(0, 1), b2 + hstep, voffB); PG8_STAGE(PG8_SA(0, 0), a2, voffA);
            PG8_WAIT_V(8); PG8_WAIT_L(0); PG8_BAR; PG8_MMA(1, 0, At, B0); PG8_MMA(1, 1, At, B1); PG8_BAR; PG8_SCHED;
            PG8_LDB(B0, 1, 0); PG8_LDB(B1, 1, 1); PG8_SCHED; PG8_LDA(At, 1, 0); PG8_STAGE(PG8_SA(0, 1), a2 + hstep, voffA);
            PG8_WAIT_V(8); PG8_WAIT_L(0); PG8_BAR; PG8_MMA(0, 0, At, B0); PG8_MMA(0, 1, At, B1); PG8_BAR; PG8_SCHED;
            PG8_LDA(At, 1, 1); PG8_STAGE(PG8_SB(1, 0), b3, voffB); PG8_STAGE(PG8_SB(1, 1), b3 + hstep, voffB); PG8_STAGE(PG8_SA(1, 0), a3, voffA);
            PG8_WAIT_V(8); PG8_WAIT_L(0); PG8_BAR; PG8_MMA(1, 0, At, B0); PG8_MMA(1, 1, At, B1); PG8_BAR; PG8_SCHED;
            } else {
            PG8_LDB(B0, 0, 0); PG8_SCHED; PG8_LDA(At, 0, 0); PG8_STAGE(PG8_SA(1, 1), a1 + hstep, voffA);
            PG8_WAIT_L(8); PG8_BAR; PG8_WAIT_L(0); PG8_MMA(0, 0, At, B0); PG8_BAR; PG8_SCHED;
            PG8_LDB(B1, 0, 1); PG8_STAGE(PG8_SB(0, 0), b2, voffB);
            PG8_BAR; PG8_WAIT_L(0); PG8_MMA(0, 1, At, B1); PG8_BAR;
            PG8_LDA(At, 0, 1); PG8_STAGE(PG8_SA(0, 0), a2, voffA);
            PG8_BAR; PG8_WAIT_L(0); PG8_MMA(1, 0, At, B0); PG8_BAR; PG8_SCHED;
            PG8_STAGE(PG8_SB(0, 1), b2 + hstep, voffB);
            PG8_WAIT_V(6); PG8_BAR; PG8_MMA(1, 1, At, B1); PG8_BAR;
            PG8_LDB(B0, 1, 0); PG8_SCHED; PG8_LDA(At, 1, 0); PG8_STAGE(PG8_SA(0, 1), a2 + hstep, voffA);
            PG8_WAIT_L(8); PG8_BAR; PG8_WAIT_L(0); PG8_MMA(0, 0, At, B0); PG8_BAR; PG8_SCHED;
            PG8_LDB(B1, 1, 1); PG8_STAGE(PG8_SB(1, 0), b3, voffB);
            PG8_BAR; PG8_WAIT_L(0); PG8_MMA(0, 1, At, B1); PG8_BAR;
            PG8_LDA(At, 1, 1); PG8_STAGE(PG8_SA(1, 0), a3, voffA);
            PG8_BAR; PG8_WAIT_L(0); PG8_MMA(1, 0, At, B0); PG8_BAR; PG8_SCHED;
            PG8_STAGE(PG8_SB(1, 1), b3 + hstep, voffB);
            PG8_WAIT_V(6); PG8_BAR; PG8_MMA(1, 1, At, B1); PG8_BAR;
            }
        }
        if constexpr (ALIGN_EPI) { if (wr == 0) PG8_BAR; }
        if constexpr (!Epi::AFTER_DRAIN) { E(acc, cur, wr, wc, fr, fq); S.done(cur); }
        if (!has_next) break;
#pragma unroll
        for (int a = 0; a < 2; ++a)
#pragma unroll
            for (int b = 0; b < 2; ++b)
#pragma unroll
                for (int m = 0; m < 4; ++m)
#pragma unroll
                    for (int n = 0; n < 2; ++n) acc[a][b][m][n] = (f32x4){0.f, 0.f, 0.f, 0.f};
        cur = nxt; cA = nA; cB = nB; ++ui;
        if constexpr (ALIGN_EPI) { if (wr == 1) PG8_BAR; }
    }
    PG8_WAIT_V(0);
    if constexpr (!ALIGN_EPI) { if (wr == 0) PG8_BAR; }
    PG8_BAR;
    if constexpr (Epi::AFTER_DRAIN) { E.fused(acc, cur, wr, wc, fr, fq, lds, wid, lane); S.done(cur); }
#undef PG8_SA
#undef PG8_SB
#undef PG8_STAGE
#undef PG8_LDA
#undef PG8_LDB
#undef PG8_MMA
#undef PG8_WAIT_V
#undef PG8_WAIT_L
#undef PG8_BAR
#undef PG8_SCHED
}
}

template <class Epi>
__device__ __forceinline__ void run_gemm(PG8_LAS unsigned char* lds, const bf16_t* A, const bf16_t* Bt, int N, int K, const Epi& E) {
    pg8::Gemm g{A, Bt, NTOK, N, K}; pg8::StaticOrder S; S.init(NTOK, N, (int)gridDim.x, (int)blockIdx.x);
    pg8::gemm_phase<Epi, pg8::StaticOrder, true, true>(lds, g, S, E);
}

__global__ void __launch_bounds__(NTHR, 2) mega_kernel(Params p) {
    extern __shared__ __attribute__((aligned(16))) unsigned char lds_raw[];
    PG8_LAS unsigned char* lds = (PG8_LAS unsigned char*)lds_raw;
    char* smem = (char*)lds_raw;
    cg::grid_group grid = cg::this_grid();
    phase_prologue(p, smem);
    grid.sync();
    phase_u0(p);
    grid.sync();
#define LL(v) ({ int l_ = (v); asm volatile("" : "+s"(l_)); l_; })
#define WL(v) (p.wts + (size_t)(v) * WL_ELEMS)
#define ML(v) (p.mod + (size_t)(v) * 4 * 9216)
#pragma unroll 1
    for (int l = 0; l < 2; ++l) {
        { const int k = LL(l); run_gemm(lds, p.ubuf, WL(k) + W_FIN0, 5632, 1024, pg8::EpiSwiGLU{p.act}); }
        grid.sync();
        { const int k = LL(l); run_gemm(lds, p.act, WL(k) + W_FOUT0, 1024, DFF, pg8::EpiRes{k == 0 ? p.x : p.out, p.out, ML(k), 0, 0.5f}); }
        grid.sync();
        phase_ln(p, LL(l), 0, true);
        grid.sync();
        { const int k = LL(l); run_gemm(lds, p.ubuf, WL(k) + W_IN, NPROJ, 1024, pg8::EpiInproj{p.proj, p.rope, p.iw, p.logf, p.mix_b_forget + k * 4}); }
        grid.sync();
        phase_topk(p, smem); phase_scan(p, smem); phase_attn_a(p); phase_attn_c(p);
        grid.sync();
        phase_attn_d(p); phase_attn_b(p);
        grid.sync();
        phase_merge(p, LL(l), smem);
        grid.sync();
        { const int k = LL(l); run_gemm(lds, p.merged, WL(k) + W_OUT, 1024, 1024, pg8::EpiRes{p.out, p.out, ML(k), 1, 1.0f}); }
        grid.sync();
        phase_ln(p, LL(l), 1, true);
        grid.sync();
        { const int k = LL(l); run_gemm(lds, p.ubuf, WL(k) + W_FIN1, 5632, 1024, pg8::EpiSwiGLU{p.act}); }
        grid.sync();
        { const int k = LL(l); run_gemm(lds, p.act, WL(k) + W_FOUT1, 1024, DFF, pg8::EpiRes{p.out, p.out, ML(k), 2, 0.5f}); }
        grid.sync();
        { const int k = LL(l); phase_ln(p, k, 2, k == 0); }
        if (l == 0) grid.sync();
    }
}

extern "C" void kernel_launch(void* const* d_in, const int* in_sizes, int n_in, void* d_out, int out_size, void* d_ws, size_t ws_size, hipStream_t stream) {
    Params p{};
    p.x = (const float*)d_in[0]; p.c = (const float*)d_in[1]; p.ada_w = (const float*)d_in[2]; p.ada_b = (const float*)d_in[3];
    p.ln_g = (const float*)d_in[4]; p.ln_b = (const float*)d_in[5]; p.ffn_w_in = (const float*)d_in[6]; p.ffn_w_out = (const float*)d_in[7];
    p.mix_w_in = (const float*)d_in[8]; p.mix_b_gate = (const float*)d_in[9]; p.mix_b_forget = (const float*)d_in[10];
    p.mix_w_branch = (const float*)d_in[11]; p.mix_w_out = (const float*)d_in[12];
    p.out = (float*)d_out;
    char* ws = (char*)d_ws; size_t off = 0;
    auto take = [&](size_t bytes) { char* r = ws + off; off += (bytes + 255) & ~(size_t)255; return r; };
    p.wts = (bf16_t*)take(2 * WL_ELEMS * 2);
    p.mod = (float*)take(2 * 4 * 9216 * 4);
    p.rope = (float*)take(SEQ * 16 * 4);
    p.ubuf = (bf16_t*)take((size_t)NTOK * 1024 * 2);
    p.act = (bf16_t*)(ws + off);
    p.proj = (bf16_t*)take((size_t)NTOK * NPROJ * 2);
    p.merged = p.proj;
    p.iw = (float*)take((size_t)NTOK * 16); p.logf = (float*)take((size_t)NTOK * 16); p.cum = (float*)take((size_t)NTOK * 16);
    p.sel = (unsigned short*)take((size_t)NTOK * 512);
    p.ybuf = (bf16_t*)take((size_t)NTOK * 896 * 2);
    if (off > ws_size) { fprintf(stderr, "workspace too small: need %zu have %zu\n", off, ws_size); return; }
    static int grid_blocks = 0;
    if (!grid_blocks) {
        int dev = 0, cus = 0, per_cu = 0;
        (void)hipGetDevice(&dev);
        (void)hipDeviceGetAttribute(&cus, hipDeviceAttributeMultiprocessorCount, dev);
        (void)hipFuncSetAttribute((const void*)mega_kernel, hipFuncAttributeMaxDynamicSharedMemorySize, LDS_BYTES);
        (void)hipOccupancyMaxActiveBlocksPerMultiprocessor(&per_cu, mega_kernel, NTHR, LDS_BYTES);
        if (per_cu < 1) per_cu = 1;
        if (per_cu > 1) per_cu = 1;
        grid_blocks = cus * per_cu;
    }
    void* args[] = {&p};
    hipError_t e = hipLaunchCooperativeKernel((void*)mega_kernel, dim3(grid_blocks), dim3(NTHR), args, LDS_BYTES, stream);
    if (e != hipSuccess) fprintf(stderr, "cooperative launch failed: %s (grid %d)\n", hipGetErrorString(e), grid_blocks);
}
```

```cpp
#include <hip/hip_runtime.h>
#include <hip/hip_cooperative_groups.h>
#include <cstdio>
#include <cstdint>
namespace cg = cooperative_groups;

constexpr int NTHR = 512, NWV = 8;
constexpr int DM = 1024, SEQ = 8192, NTOK = 4 * 8192, DFF = 2816;
constexpr int NPROJ = 3840;
constexpr int PA = 0, PB = 1152, PIQ = 1920, PIK = 2176, PC = 2240, PD = 3008, PIW = 3776;
constexpr float ALPHA = 1.41421356237f;
constexpr size_t W_FIN0 = 0, W_FIN1 = 5767168, W_FOUT0 = 11534336, W_FOUT1 = 11534336 + 2883584, W_IN = 17301504,
                 W_GATE = 21233664, W_BR = 25427968, W_OUT = 26345472, WL_ELEMS = 27394048;
constexpr int LDS_BYTES = 131072;


typedef unsigned short bf16_t;
typedef short bf16x8 __attribute__((ext_vector_type(8)));
typedef float f32x4 __attribute__((ext_vector_type(4)));

struct Params {
    const float *x, *c, *ada_w, *ada_b, *ln_g, *ln_b, *ffn_w_in, *ffn_w_out, *mix_w_in, *mix_b_gate, *mix_b_forget, *mix_w_branch, *mix_w_out;
    float* out;
    bf16_t* wts; float* mod; float* rope; bf16_t* ubuf; bf16_t* act; bf16_t* proj; bf16_t* merged;
    float* iw; float* logf; float* cum; unsigned* maskb; bf16_t* ybuf;
};

__device__ __forceinline__ bf16_t f2bf(float f) { unsigned u = __float_as_uint(f); u += 0x7FFFu + ((u >> 16) & 1u); return (bf16_t)(u >> 16); }
__device__ __forceinline__ float bf2f(bf16_t h) { return __uint_as_float(((unsigned)h) << 16); }
__device__ __forceinline__ float blo(unsigned u) { return __uint_as_float(u << 16); }
__device__ __forceinline__ float bhi(unsigned u) { return __uint_as_float(u & 0xffff0000u); }
__device__ __forceinline__ int otid() { int t = threadIdx.x; asm volatile("" : "+v"(t)); return t; }
__device__ __forceinline__ float log_sigmoid(float x) { return fminf(x, 0.f) - log1pf(expf(-fabsf(x))); }

__device__ __forceinline__ int colmap(int mode, int n) {
    if (mode == 0) return n;
    if (mode == 1) { int q = n >> 8, r = n & 255; return r < 128 ? 128 * q + r : 2816 + 128 * q + (r - 128); }
    if (mode == 2) { if (n < 2240) return n; if (n < 3776) return n + 4; if (n < 3780) return 2240 + (n - 3776); if (n < 3784) return n; return -1; }
    return 3784 + n;
}
__device__ __forceinline__ void convert_job(const float* __restrict__ src, int K, int Nsrc, bf16_t* __restrict__ dst, int Ndst, int mode, char* smem) {
    float (*t)[33] = (float (*)[33])smem;
    const int tid = threadIdx.x, tx = tid & 31, ty = tid >> 5;
    const int kt_n = K / 64, ntiles = kt_n * (Ndst / 32);
    for (int tile = blockIdx.x; tile < ntiles; tile += gridDim.x) {
        const int k0 = (tile % kt_n) * 64, n0 = (tile / kt_n) * 32;
        const int sc = colmap(mode, n0 + tx);
        __syncthreads();
#pragma unroll
        for (int i = 0; i < 4; ++i) { const int k = ty + 16 * i; t[k][tx] = sc >= 0 ? src[(size_t)(k0 + k) * Nsrc + sc] : 0.f; }
        __syncthreads();
        const int kk = tid & 63, nb = tid >> 6;
#pragma unroll
        for (int i = 0; i < 4; ++i) { const int n = nb + 8 * i; dst[(size_t)(n0 + n) * K + k0 + kk] = f2bf(t[kk][n]); }
    }
}

__device__ __forceinline__ void phase_prologue(const Params& p, char* smem) {
    for (int l = 0; l < 2; ++l) {
        bf16_t* w = p.wts + (size_t)l * WL_ELEMS;
        convert_job(p.ffn_w_in + (size_t)(l * 2 + 0) * 1024 * 5632, 1024, 5632, w + W_FIN0, 5632, 1, smem);
        convert_job(p.ffn_w_in + (size_t)(l * 2 + 1) * 1024 * 5632, 1024, 5632, w + W_FIN1, 5632, 1, smem);
        convert_job(p.ffn_w_out + (size_t)(l * 2 + 0) * 2816 * 1024, 2816, 1024, w + W_FOUT0, 1024, 0, smem);
        convert_job(p.ffn_w_out + (size_t)(l * 2 + 1) * 2816 * 1024, 2816, 1024, w + W_FOUT1, 1024, 0, smem);
        convert_job(p.mix_w_in + (size_t)l * 1024 * 7880, 1024, 7880, w + W_IN, 3840, 2, smem);
        convert_job(p.mix_w_in + (size_t)l * 1024 * 7880, 1024, 7880, w + W_GATE, 4096, 3, smem);
        convert_job(p.mix_w_branch + (size_t)l * 896 * 1024, 896, 1024, w + W_BR, 1024, 0, smem);
        convert_job(p.mix_w_out + (size_t)l * 1024 * 1024, 1024, 1024, w + W_OUT, 1024, 0, smem);
    }
    for (int idx = blockIdx.x * NTHR + threadIdx.x; idx < SEQ * 8; idx += gridDim.x * NTHR) {
        const int t = idx >> 3, i = idx & 7;
        const float invf = powf(500000.0f, -(float)i * 0.125f);
        const float ang = (float)t * invf;
        p.rope[idx * 2 + 0] = cosf(ang);
        p.rope[idx * 2 + 1] = sinf(ang);
    }
    __syncthreads();
    float* scs = (float*)smem;
    float* red = scs + 4096;
    for (int i = threadIdx.x; i < 4096; i += NTHR) { const float v = p.c[i]; scs[i] = v / (1.f + expf(-v)); }
    __syncthreads();
    const int tid = threadIdx.x, cl = tid & 63, kq = tid >> 6;
    for (int item = blockIdx.x; item < 288; item += gridDim.x) {
        const int l = item / 144, col = (item % 144) * 64 + cl;
        float a0 = 0.f, a1 = 0.f, a2 = 0.f, a3 = 0.f;
        const float* wp = p.ada_w + ((size_t)l * 1024 + kq * 128) * 9216 + col;
#pragma unroll 8
        for (int k = 0; k < 128; ++k) {
            const float w = wp[(size_t)k * 9216]; const int kk = kq * 128 + k;
            a0 = fmaf(scs[kk], w, a0); a1 = fmaf(scs[1024 + kk], w, a1); a2 = fmaf(scs[2048 + kk], w, a2); a3 = fmaf(scs[3072 + kk], w, a3);
        }
        red[(kq * 4 + 0) * 64 + cl] = a0; red[(kq * 4 + 1) * 64 + cl] = a1; red[(kq * 4 + 2) * 64 + cl] = a2; red[(kq * 4 + 3) * 64 + cl] = a3;
        __syncthreads();
        if (kq < 4) {
            const int b = kq; float s = 0.f;
#pragma unroll
            for (int q = 0; q < 8; ++q) s += red[(q * 4 + b) * 64 + cl];
            p.mod[(size_t)(l * 4 + b) * 9216 + col] = s + p.ada_b[(size_t)l * 9216 + col];
        }
        __syncthreads();
    }
}

__device__ __forceinline__ void phase_u0(const Params& p) {
    const size_t n4 = (size_t)NTOK * 256;
    for (size_t i = (size_t)blockIdx.x * NTHR + threadIdx.x; i < n4; i += (size_t)gridDim.x * NTHR) {
        const size_t row = i >> 8; const int c4 = (int)(i & 255) * 4; const int b = (int)(row >> 13);
        const float4 v = *(const float4*)(p.x + row * 1024 + c4);
        const float* md = p.mod + (size_t)(0 * 4 + b) * 9216;
        const float4 sh = *(const float4*)(md + c4), sc = *(const float4*)(md + 1024 + c4);
        ushort4 o; o.x = f2bf(v.x * (1.f + sc.x) + sh.x); o.y = f2bf(v.y * (1.f + sc.y) + sh.y); o.z = f2bf(v.z * (1.f + sc.z) + sh.z); o.w = f2bf(v.w * (1.f + sc.w) + sh.w);
        *(ushort4*)(p.ubuf + row * 1024 + c4) = o;
    }
}

__device__ __forceinline__ void gemm_mainloop(f32x4 (&acc)[4][4], const bf16_t* __restrict__ A, int lda, const bf16_t* __restrict__ Bt, int ldb, int K, char* smem) {
    bf16_t* As = (bf16_t*)smem; bf16_t* Bs = As + 256 * 40;
    int tid_ = threadIdx.x; asm volatile("" : "+v"(tid_));
    const int tid = tid_, lane = tid & 63, wid = tid >> 6, wr = wid >> 1, wc = wid & 1;
    const int lr = tid >> 1, lk = (tid & 1) * 16;
    const int br = (tid & 255) >> 1;
    const bool ldB = tid < 256;
    const uint4* ga = (const uint4*)(A + (size_t)lr * lda + lk);
    const uint4* gb = (const uint4*)(Bt + (size_t)br * ldb + lk);
    uint4 ra0 = ga[0], ra1 = ga[1], rb0 = make_uint4(0, 0, 0, 0), rb1 = rb0;
    if (ldB) { rb0 = gb[0]; rb1 = gb[1]; }
    const int fr = lane & 15, fq = lane >> 4;
    for (int k0 = 0; k0 < K; k0 += 32) {
        __syncthreads();
        *(uint4*)&As[lr * 40 + lk] = ra0; *(uint4*)&As[lr * 40 + lk + 8] = ra1;
        if (ldB) { *(uint4*)&Bs[br * 40 + lk] = rb0; *(uint4*)&Bs[br * 40 + lk + 8] = rb1; }
        __syncthreads();
        if (k0 + 32 < K) { ga += 4; gb += 4; ra0 = ga[0]; ra1 = ga[1]; if (ldB) { rb0 = gb[0]; rb1 = gb[1]; } }
        bf16x8 a[4], b[4];
#pragma unroll
        for (int m = 0; m < 4; ++m) a[m] = *(const bf16x8*)&As[(wr * 64 + m * 16 + fr) * 40 + fq * 8];
#pragma unroll
        for (int n = 0; n < 4; ++n) b[n] = *(const bf16x8*)&Bs[(wc * 64 + n * 16 + fr) * 40 + fq * 8];
#pragma unroll
        for (int m = 0; m < 4; ++m)
#pragma unroll
            for (int n = 0; n < 4; ++n) acc[m][n] = __builtin_amdgcn_mfma_f32_16x16x32_bf16(a[m], b[n], acc[m][n], 0, 0, 0);
    }
}
__device__ __forceinline__ void zero_acc(f32x4 (&acc)[4][4]) {
#pragma unroll
    for (int m = 0; m < 4; ++m)
#pragma unroll
        for (int n = 0; n < 4; ++n) acc[m][n] = (f32x4){0.f, 0.f, 0.f, 0.f};
}
__device__ __forceinline__ void phase_merge(const Params& p, int l, char* smem) {
    const bf16_t* WG = p.wts + (size_t)l * WL_ELEMS + W_GATE; const bf16_t* WB = p.wts + (size_t)l * WL_ELEMS + W_BR;
    const int tid = otid(), lane = tid & 63, wid = tid >> 6, wr = wid >> 1, wc = wid & 1, fr = lane & 15, fq = lane >> 4;
    for (int tile = blockIdx.x; tile < 128 * 8; tile += gridDim.x) {
        const int pm = tile / 8, pn = tile % 8;
        f32x4 accM[4][4]; zero_acc(accM);
#pragma unroll 1
        for (int br = 0; br < 4; ++br) {
            const int koff = br == 0 ? 0 : 128 + (br - 1) * 256, kb = br == 0 ? 128 : 256;
            f32x4 accG[4][4]; zero_acc(accG);
            gemm_mainloop(accG, p.ubuf + (size_t)pm * 256 * 1024, 1024, WG + (size_t)(br * 1024 + pn * 128) * 1024, 1024, 1024, smem);
            const float* bg = p.mix_b_gate + (size_t)l * 4096 + br * 1024;
#pragma unroll
            for (int n = 0; n < 4; ++n) {
                const float bv = bg[pn * 128 + wc * 64 + n * 16 + fr];
#pragma unroll
                for (int m = 0; m < 4; ++m)
#pragma unroll
                    for (int j = 0; j < 4; ++j) accG[m][n][j] = 1.f / (1.f + expf(-(accG[m][n][j] + bv)));
            }
            unsigned* gst = (unsigned*)(smem + 32768) + tid;
#pragma unroll
            for (int m = 0; m < 4; ++m)
#pragma unroll
                for (int n = 0; n < 4; ++n) {
                    gst[((m * 4 + n) * 2 + 0) * NTHR] = (unsigned)f2bf(accG[m][n][0]) | ((unsigned)f2bf(accG[m][n][1]) << 16);
                    gst[((m * 4 + n) * 2 + 1) * NTHR] = (unsigned)f2bf(accG[m][n][2]) | ((unsigned)f2bf(accG[m][n][3]) << 16);
                }
            zero_acc(accG);
            gemm_mainloop(accG, p.ybuf + (size_t)pm * 256 * 896 + koff, 896, WB + (size_t)pn * 128 * 896 + koff, 896, kb, smem);
#pragma unroll
            for (int m = 0; m < 4; ++m)
#pragma unroll
                for (int n = 0; n < 4; ++n) {
                    const unsigned g01 = gst[((m * 4 + n) * 2 + 0) * NTHR], g23 = gst[((m * 4 + n) * 2 + 1) * NTHR];
                    accM[m][n][0] += blo(g01) * accG[m][n][0]; accM[m][n][1] += bhi(g01) * accG[m][n][1];
                    accM[m][n][2] += blo(g23) * accG[m][n][2]; accM[m][n][3] += bhi(g23) * accG[m][n][3];
                }
        }
#pragma unroll
        for (int m = 0; m < 4; ++m)
#pragma unroll
            for (int n = 0; n < 4; ++n)
#pragma unroll
                for (int j = 0; j < 4; ++j)
                    p.merged[(size_t)(pm * 256 + wr * 64 + m * 16 + fq * 4 + j) * 1024 + pn * 128 + wc * 64 + n * 16 + fr] = f2bf(accM[m][n][j]);
    }
}

__device__ __forceinline__ void phase_ln(const Params& p, int l, int s, bool has_next) {
    const int tid_ = otid(), lane = tid_ & 63, wid = tid_ >> 6;
    const float* g = p.ln_g + (size_t)(l * 3 + s) * 1024; const float* bb = p.ln_b + (size_t)(l * 3 + s) * 1024;
    const int nl = s < 2 ? l : l + 1, ns = s < 2 ? s + 1 : 0;
    for (int row = blockIdx.x * NWV + wid; row < NTOK; row += gridDim.x * NWV) {
        float* xr = p.out + (size_t)row * 1024;
        float4 v[4]; float sum = 0.f;
#pragma unroll
        for (int i = 0; i < 4; ++i) { v[i] = *(const float4*)(xr + lane * 4 + 256 * i); sum += (v[i].x + v[i].y) + (v[i].z + v[i].w); }
#pragma unroll
        for (int o = 32; o > 0; o >>= 1) sum += __shfl_xor(sum, o);
        const float mu = sum * (1.f / 1024.f); float q = 0.f;
#pragma unroll
        for (int i = 0; i < 4; ++i) { const float a = v[i].x - mu, b2 = v[i].y - mu, c = v[i].z - mu, d = v[i].w - mu; q += (a * a + b2 * b2) + (c * c + d * d); }
#pragma unroll
        for (int o = 32; o > 0; o >>= 1) q += __shfl_xor(q, o);
        const float rstd = 1.0f / sqrtf(q * (1.f / 1024.f) + 1e-5f);
        const int b = row >> 13;
        const float* md = p.mod + (size_t)(nl * 4 + b) * 9216 + ns * 3072;
#pragma unroll
        for (int i = 0; i < 4; ++i) {
            const int c4 = lane * 4 + 256 * i;
            const float4 gg = *(const float4*)(g + c4), be = *(const float4*)(bb + c4);
            float4 o; o.x = (v[i].x - mu) * rstd * gg.x + be.x; o.y = (v[i].y - mu) * rstd * gg.y + be.y; o.z = (v[i].z - mu) * rstd * gg.z + be.z; o.w = (v[i].w - mu) * rstd * gg.w + be.w;
            *(float4*)(xr + c4) = o;
            if (has_next) {
                const float4 sh = *(const float4*)(md + c4), sc = *(const float4*)(md + 1024 + c4);
                ushort4 u; u.x = f2bf(o.x * (1.f + sc.x) + sh.x); u.y = f2bf(o.y * (1.f + sc.y) + sh.y); u.z = f2bf(o.z * (1.f + sc.z) + sh.z); u.w = f2bf(o.w * (1.f + sc.w) + sh.w);
                *(ushort4*)(p.ubuf + (size_t)row * 1024 + c4) = u;
            }
        }
    }
}

__device__ __forceinline__ void load_row32(float (&q)[32], const bf16_t* row) {
    const uint4* r = (const uint4*)row;
#pragma unroll
    for (int c = 0; c < 4; ++c) { const uint4 v = r[c];
        q[c * 8 + 0] = blo(v.x); q[c * 8 + 1] = bhi(v.x); q[c * 8 + 2] = blo(v.y); q[c * 8 + 3] = bhi(v.y);
        q[c * 8 + 4] = blo(v.z); q[c * 8 + 5] = bhi(v.z); q[c * 8 + 6] = blo(v.w); q[c * 8 + 7] = bhi(v.w); }
}
__device__ __forceinline__ float dot32(const float (&q)[32], const bf16_t* row) {
    const uint4* r = (const uint4*)row; float a = 0.f;
#pragma unroll
    for (int c = 0; c < 4; ++c) { const uint4 v = r[c];
        a = fmaf(q[c * 8 + 0], blo(v.x), a); a = fmaf(q[c * 8 + 1], bhi(v.x), a); a = fmaf(q[c * 8 + 2], blo(v.y), a); a = fmaf(q[c * 8 + 3], bhi(v.y), a);
        a = fmaf(q[c * 8 + 4], blo(v.z), a); a = fmaf(q[c * 8 + 5], bhi(v.z), a); a = fmaf(q[c * 8 + 6], blo(v.w), a); a = fmaf(q[c * 8 + 7], bhi(v.w), a); }
    return a + __shfl_xor(a, 1);
}
__device__ __forceinline__ void axpy32(float (&o)[32], float sc, float pw, const bf16_t* row) {
    const uint4* r = (const uint4*)row;
#pragma unroll
    for (int c = 0; c < 4; ++c) { const uint4 v = r[c];
        o[c * 8 + 0] = fmaf(pw, blo(v.x), o[c * 8 + 0] * sc); o[c * 8 + 1] = fmaf(pw, bhi(v.x), o[c * 8 + 1] * sc);
        o[c * 8 + 2] = fmaf(pw, blo(v.y), o[c * 8 + 2] * sc); o[c * 8 + 3] = fmaf(pw, bhi(v.y), o[c * 8 + 3] * sc);
        o[c * 8 + 4] = fmaf(pw, blo(v.z), o[c * 8 + 4] * sc); o[c * 8 + 5] = fmaf(pw, bhi(v.z), o[c * 8 + 5] * sc);
        o[c * 8 + 6] = fmaf(pw, blo(v.w), o[c * 8 + 6] * sc); o[c * 8 + 7] = fmaf(pw, bhi(v.w), o[c * 8 + 7] * sc); }
}
__device__ __forceinline__ void store_row32(bf16_t* dst, const float (&o)[32], float sc) {
    uint4* r = (uint4*)dst;
#pragma unroll
    for (int c = 0; c < 4; ++c) { uint4 v;
        v.x = (unsigned)f2bf(o[c * 8 + 0] * sc) | ((unsigned)f2bf(o[c * 8 + 1] * sc) << 16); v.y = (unsigned)f2bf(o[c * 8 + 2] * sc) | ((unsigned)f2bf(o[c * 8 + 3] * sc) << 16);
        v.z = (unsigned)f2bf(o[c * 8 + 4] * sc) | ((unsigned)f2bf(o[c * 8 + 5] * sc) << 16); v.w = (unsigned)f2bf(o[c * 8 + 6] * sc) | ((unsigned)f2bf(o[c * 8 + 7] * sc) << 16);
        r[c] = v; }
}
__device__ __forceinline__ void zero32(float (&o)[32]) {
#pragma unroll
    for (int i = 0; i < 32; ++i) o[i] = 0.f;
}

__device__ __forceinline__ void phase_attn_a(const Params& p) {
    const int tid_ = otid(), lane = tid_ & 63, gw = blockIdx.x * NWV + (tid_ >> 6), nw = gridDim.x * NWV, hf = (lane & 1) * 32;
    for (int item = gw; item < 4 * 2 * 256; item += nw) {
        const int hp = item & 1, blk = (item >> 1) & 255, b = item >> 9;
        const int t = blk * 32 + (lane >> 1); const size_t tok = (size_t)b * SEQ + t;
        float o[32]; zero32(o); float mx = -INFINITY, lsum = 0.f;
#pragma unroll 1
        for (int g = 0; g < 3; ++g) {
            const int head = 2 * g + hp, dil = g == 0 ? 1 : (g == 1 ? 4 : 16);
            float q[32]; load_row32(q, p.proj + tok * NPROJ + PA + head * 64 + hf);
#pragma unroll 1
            for (int j = 0; j <= 128; ++j) {
                const int s = t - j * dil;
                if (s >= 0) {
                    const bf16_t* kr = p.proj + ((size_t)b * SEQ + s) * NPROJ + PA + 384 + head * 64 + hf;
                    const float x = dot32(q, kr) * 0.125f;
                    const float mn = fmaxf(mx, x), sc = expf(mx - mn), pw = expf(x - mn);
                    lsum = lsum * sc + pw; mx = mn;
                    axpy32(o, sc, pw, kr + 384);
                }
            }
        }
        store_row32(p.ybuf + tok * 896 + hp * 64 + hf, o, 1.f / lsum);
    }
}
__device__ __forceinline__ void phase_attn_c(const Params& p) {
    const int tid_ = otid(), lane = tid_ & 63, gw = blockIdx.x * NWV + (tid_ >> 6), nw = gridDim.x * NWV, hf = (lane & 1) * 32;
    for (int item = gw; item < 4 * 4 * 256; item += nw) {
        const int h = item & 3, blk = (item >> 2) & 255, b = item >> 10;
        const int t0 = blk * 32, t = t0 + (lane >> 1); const size_t tok = (size_t)b * SEQ + t;
        float q[32]; load_row32(q, p.proj + tok * NPROJ + PC + h * 64 + hf);
        float o[32]; zero32(o); float run = 0.f;
#pragma unroll 1
        for (int s = t0 + 30; s >= 0; --s) {
            if (s < t) {
                const bf16_t* kr = p.proj + ((size_t)b * SEQ + s) * NPROJ + PC + 256 + h * 64 + hf;
                const float z = dot32(q, kr) * 0.125f;
                const float lb = log_sigmoid(z);
                const float a = expf(lb + run);
                axpy32(o, 1.f, a, kr + 256);
                run += lb - z;
            }
            if (__all(run < -60.f)) break;
        }
        store_row32(p.ybuf + tok * 896 + 384 + h * 64 + hf, o, 1.f);
    }
}
typedef float f32x16 __attribute__((ext_vector_type(16)));
typedef short s16x4 __attribute__((ext_vector_type(4)));
constexpr int FK_PITCH = 72, FV_PITCH = 68;
__device__ __forceinline__ int crow16(int i, int hh) { return (i & 3) + 8 * (i >> 2) + 4 * hh; }
template <int KIND>
__device__ __forceinline__ void flash_unit(const Params& p, int b, int h, int qb, char* smem, int tid) {
    bf16_t* Ks = (bf16_t*)smem;
    bf16_t* Vt = Ks + 2 * 64 * FK_PITCH;
    float* ckl = (float*)(Vt + 2 * 64 * FV_PITCH);
    const int lane = tid & 63, w = tid >> 6, r = lane & 31, hh = lane >> 5;
    const int QOFF = KIND == 0 ? PD : PB, YOFF = KIND == 0 ? 640 : 128;
    const int q0 = qb * 256, qw0 = q0 + 32 * w, tq = qw0 + r;
    const size_t tokb = (size_t)b * SEQ, tok = tokb + tq;
    const float L2E = 1.44269504089f, C1 = 0.125f * 1.44269504089f;
    bf16x8 qf[4];
#pragma unroll
    for (int ks = 0; ks < 4; ++ks) qf[ks] = *(const bf16x8*)(p.proj + tok * NPROJ + QOFF + h * 64 + 16 * ks + 8 * hh);
    float cql = 0.f; if (KIND == 0) cql = p.cum[tok * 4 + h] * L2E;
    const unsigned* mrow = p.maskb + tok * 256;
    f32x16 o0, o1;
#pragma unroll
    for (int i = 0; i < 16; ++i) { o0[i] = 0.f; o1[i] = 0.f; }
    float mrun = -INFINITY, lrun = 0.f;
    const int ntiles = 4 * (qb + 1);
    const int skey = tid >> 3, sch = tid & 7;
    const bf16_t* kg = p.proj + (tokb + skey) * NPROJ + QOFF + 256 + h * 64 + sch * 8;
    uint4 kreg = *(const uint4*)kg, vreg = *(const uint4*)(kg + 256);
    float creg = 0.f; if (KIND == 0 && tid < 64) creg = p.cum[(tokb + tid) * 4 + h] * L2E;
    uint2 mreg = make_uint2(0u, 0u); if (KIND == 1) mreg = *(const uint2*)(mrow);
#pragma unroll 1
    for (int j = 0; j < ntiles; ++j) {
        const int buf = j & 1;
        bf16_t* ksb = Ks + buf * 64 * FK_PITCH; bf16_t* vtb = Vt + buf * 64 * FV_PITCH; float* cb = ckl + buf * 64;
        *(uint4*)&ksb[skey * FK_PITCH + sch * 8] = kreg;
        {
            bf16_t* vd = vtb + (sch * 8) * FV_PITCH + skey;
            vd[0 * FV_PITCH] = (bf16_t)(vreg.x & 0xffffu); vd[1 * FV_PITCH] = (bf16_t)(vreg.x >> 16);
            vd[2 * FV_PITCH] = (bf16_t)(vreg.y & 0xffffu); vd[3 * FV_PITCH] = (bf16_t)(vreg.y >> 16);
            vd[4 * FV_PITCH] = (bf16_t)(vreg.z & 0xffffu); vd[5 * FV_PITCH] = (bf16_t)(vreg.z >> 16);
            vd[6 * FV_PITCH] = (bf16_t)(vreg.w & 0xffffu); vd[7 * FV_PITCH] = (bf16_t)(vreg.w >> 16);
        }
        if (KIND == 0 && tid < 64) cb[tid] = creg;
        const uint2 mw = mreg;
        __syncthreads();
        if (j + 1 < ntiles) {
            const bf16_t* kn = kg + (size_t)(j + 1) * 64 * NPROJ;
            kreg = *(const uint4*)kn; vreg = *(const uint4*)(kn + 256);
            if (KIND == 0 && tid < 64) creg = p.cum[(tokb + (j + 1) * 64 + tid) * 4 + h] * L2E;
            if (KIND == 1) mreg = *(const uint2*)(mrow + 2 * (j + 1));
        }
#pragma unroll
        for (int sub = 0; sub < 2; ++sub) {
            const int kb = 64 * j + 32 * sub;
            if (kb > qw0 + 31) continue;
            f32x16 x;
#pragma unroll
            for (int i = 0; i < 16; ++i) x[i] = 0.f;
#pragma unroll
            for (int ks = 0; ks < 4; ++ks) {
                const bf16x8 a = *(const bf16x8*)&ksb[(32 * sub + r) * FK_PITCH + 16 * ks + 8 * hh];
                x = __builtin_amdgcn_mfma_f32_32x32x16_bf16(a, qf[ks], x, 0, 0, 0);
            }
            float mt = -INFINITY;
            if (KIND == 0) {
                const bool diag = kb + 31 > qw0;
#pragma unroll
                for (int g = 0; g < 4; ++g) {
                    const f32x4 ck = *(const f32x4*)&cb[32 * sub + 8 * g + 4 * hh];
#pragma unroll
                    for (int e = 0; e < 4; ++e) {
                        float s = fmaf(x[4 * g + e], C1, cql - ck[e]);
                        if (diag && (kb + 8 * g + 4 * hh + e > tq)) s = -INFINITY;
                        x[4 * g + e] = s; mt = fmaxf(mt, s);
                    }
                }
            } else {
                const unsigned wbits = sub == 0 ? mw.x : mw.y;
#pragma unroll
                for (int i = 0; i < 16; ++i) {
                    float s = x[i] * C1;
                    if (!((wbits >> crow16(i, hh)) & 1u)) s = -INFINITY;
                    x[i] = s; mt = fmaxf(mt, s);
                }
            }
            mt = fmaxf(mt, __shfl_xor(mt, 32));
            const float mnew = fmaxf(mrun, mt), msafe = (mnew == -INFINITY) ? 0.f : mnew;
            const float alpha = __builtin_amdgcn_exp2f(mrun - msafe);
            float ps = 0.f;
#pragma unroll
            for (int i = 0; i < 16; ++i) { const float e = __builtin_amdgcn_exp2f(x[i] - msafe); x[i] = e; ps += e; }
            lrun = lrun * alpha + ps; mrun = mnew;
#pragma unroll
            for (int i = 0; i < 16; ++i) { o0[i] *= alpha; o1[i] *= alpha; }
            bf16x8 pf[2];
#pragma unroll
            for (int s = 0; s < 2; ++s) {
                unsigned pk[4];
#pragma unroll
                for (int e = 0; e < 4; ++e) pk[e] = (unsigned)f2bf(x[8 * s + 2 * e]) | ((unsigned)f2bf(x[8 * s + 2 * e + 1]) << 16);
                pf[s] = __builtin_bit_cast(bf16x8, (uint4){pk[0], pk[1], pk[2], pk[3]});
            }
#pragma unroll
            for (int s = 0; s < 2; ++s) {
#pragma unroll
                for (int dt = 0; dt < 2; ++dt) {
                    const bf16_t* vp = vtb + (32 * dt + r) * FV_PITCH + 32 * sub + 16 * s + 4 * hh;
                    const s16x4 lo = *(const s16x4*)vp, hi = *(const s16x4*)(vp + 8);
                    const bf16x8 vf = __builtin_shufflevector(lo, hi, 0, 1, 2, 3, 4, 5, 6, 7);
                    if (dt == 0) o0 = __builtin_amdgcn_mfma_f32_32x32x16_bf16(vf, pf[s], o0, 0, 0, 0);
                    else o1 = __builtin_amdgcn_mfma_f32_32x32x16_bf16(vf, pf[s], o1, 0, 0, 0);
                }
            }
        }
    }
    const float ltot = lrun + __shfl_xor(lrun, 32), inv = 1.f / ltot;
    bf16_t* yo = p.ybuf + tok * 896 + YOFF + h * 64;
#pragma unroll
    for (int g = 0; g < 4; ++g) {
        uint2 w0, w1;
        w0.x = (unsigned)f2bf(o0[4 * g] * inv) | ((unsigned)f2bf(o0[4 * g + 1] * inv) << 16); w0.y = (unsigned)f2bf(o0[4 * g + 2] * inv) | ((unsigned)f2bf(o0[4 * g + 3] * inv) << 16);
        w1.x = (unsigned)f2bf(o1[4 * g] * inv) | ((unsigned)f2bf(o1[4 * g + 1] * inv) << 16); w1.y = (unsigned)f2bf(o1[4 * g + 2] * inv) | ((unsigned)f2bf(o1[4 * g + 3] * inv) << 16);
        *(uint2*)(yo + 8 * g + 4 * hh) = w0; *(uint2*)(yo + 32 + 8 * g + 4 * hh) = w1;
    }
}
__device__ __forceinline__ void phase_flash(const Params& p, char* smem) {
    const int tid = otid();
    for (int it = blockIdx.x; it < 512; it += gridDim.x) {
        const int kind = it >> 8, c = it & 255, bh = c & 15, qs = c >> 4;
#pragma unroll 1
        for (int half = 0; half < 2; ++half) {
            const int qb = half ? 31 - qs : qs;
            __syncthreads();
            if (kind == 0) flash_unit<0>(p, bh >> 2, bh & 3, qb, smem, tid); else flash_unit<1>(p, bh >> 2, bh & 3, qb, smem, tid);
        }
    }
}
__device__ __forceinline__ void phase_scan(const Params& p, char* smem) {
    double* part = (double*)smem;
    const int tid = otid();
    for (int item = blockIdx.x; item < 16; item += gridDim.x) {
        const int b = item >> 2, h = item & 3;
        const float* lf = p.logf + ((size_t)b * SEQ + tid * 16) * 4 + h;
        double s = 0.0;
        for (int i = 0; i < 16; ++i) s += (double)lf[i * 4];
        __syncthreads();
        part[tid] = s;
        __syncthreads();
        if (tid == 0) { double r = 0.0; for (int i = 0; i < NTHR; ++i) { const double v = part[i]; part[i] = r; r += v; } }
        __syncthreads();
        double r = part[tid];
        float* cm = p.cum + ((size_t)b * SEQ + tid * 16) * 4 + h;
        for (int i = 0; i < 16; ++i) { r += (double)lf[i * 4]; cm[i * 4] = (float)r; }
    }
}
__device__ __forceinline__ unsigned f2key(float f) { const unsigned u = __float_as_uint(f); return (u & 0x80000000u) ? ~u : (u | 0x80000000u); }
__device__ __forceinline__ void phase_topk(const Params& p, char* smem) {
    float* sc = (float*)smem;
    float* qs = sc + 8192;
    unsigned* hist = (unsigned*)(qs + 256);
    unsigned* wsum = hist + 256;
    unsigned* misc = wsum + 8;
    const int tid = otid(), lane = tid & 63, wid = tid >> 6;
    for (int item = blockIdx.x; item < NTOK; item += gridDim.x) {
        const int tok = item, t = tok & (SEQ - 1), b = tok >> 13, n = t + 1;
        unsigned* mrow = p.maskb + (size_t)tok * 256;
        if (n <= 256) {
            if (tid < 256) { const int lo = tid * 32; mrow[tid] = (lo + 32 <= n) ? 0xffffffffu : (lo >= n ? 0u : ((1u << (n - lo)) - 1u)); }
            continue;
        }
        __syncthreads();
        if (tid < 256) qs[tid] = bf2f(p.proj[(size_t)tok * NPROJ + PIQ + tid]);
        const float w0 = p.iw[(size_t)tok * 4 + 0], w1 = p.iw[(size_t)tok * 4 + 1], w2 = p.iw[(size_t)tok * 4 + 2], w3 = p.iw[(size_t)tok * 4 + 3];
        __syncthreads();
        for (int s = tid; s < n; s += NTHR) {
            const uint4* kr = (const uint4*)(p.proj + ((size_t)b * SEQ + s) * NPROJ + PIK);
            float d0 = 0.f, d1 = 0.f, d2 = 0.f, d3 = 0.f;
#pragma unroll
            for (int c = 0; c < 8; ++c) {
                const uint4 kv = kr[c];
                const float kk[8] = {blo(kv.x), bhi(kv.x), blo(kv.y), bhi(kv.y), blo(kv.z), bhi(kv.z), blo(kv.w), bhi(kv.w)};
#pragma unroll
                for (int e = 0; e < 8; ++e) {
                    const int idx = c * 8 + e;
                    d0 = fmaf(qs[idx], kk[e], d0); d1 = fmaf(qs[64 + idx], kk[e], d1); d2 = fmaf(qs[128 + idx], kk[e], d2); d3 = fmaf(qs[192 + idx], kk[e], d3);
                }
            }
            float v = w0 * fmaxf(d0, 0.f);
            v = fmaf(w1, fmaxf(d1, 0.f), v); v = fmaf(w2, fmaxf(d2, 0.f), v); v = fmaf(w3, fmaxf(d3, 0.f), v);
            sc[s] = v + 0.0f;
        }
        __syncthreads();
        unsigned prefix = 0u, need = 256u;
#pragma unroll 1
        for (int pass = 3; pass >= 0; --pass) {
            if (tid < 256) hist[tid] = 0u;
            __syncthreads();
            for (int s = tid; s < n; s += NTHR) {
                const unsigned key = f2key(sc[s]);
                const bool match = (pass == 3) ? true : ((key >> (8 * (pass + 1))) == prefix);
                if (match) atomicAdd(&hist[(key >> (8 * pass)) & 255u], 1u);
            }
            __syncthreads();
            if (wid == 0) {
                const uint4 c4 = *(const uint4*)&hist[4 * lane];
                const unsigned mine = c4.x + c4.y + c4.z + c4.w;
                unsigned tot = mine;
#pragma unroll
                for (int o = 1; o < 64; o <<= 1) { const unsigned v = __shfl_down(tot, o); if (lane + o < 64) tot += v; }
                const unsigned excl = tot - mine;
                if (excl < need && tot >= need) {
                    unsigned cum = excl; int bsel;
                    if (cum + c4.w >= need) bsel = 3; else { cum += c4.w; if (cum + c4.z >= need) bsel = 2; else { cum += c4.z; if (cum + c4.y >= need) bsel = 1; else { cum += c4.y; bsel = 0; } } }
                    misc[0] = (prefix << 8) | (unsigned)(4 * lane + bsel); misc[1] = need - cum;
                }
            }
            __syncthreads();
            prefix = misc[0]; need = misc[1];
            __syncthreads();
        }
        const unsigned tau = prefix, r = need;
        const int s0 = tid * 16;
        unsigned gt = 0u, eq = 0u;
#pragma unroll
        for (int i = 0; i < 16; ++i) { const int s = s0 + i; if (s < n) { const unsigned key = f2key(sc[s]); gt |= (key > tau ? 1u : 0u) << i; eq |= (key == tau ? 1u : 0u) << i; } }
        const unsigned myties = __popc(eq);
        unsigned incl = myties;
#pragma unroll
        for (int o = 1; o < 64; o <<= 1) { const unsigned v = __shfl_up(incl, o); if (lane >= o) incl += v; }
        if (lane == 63) wsum[wid] = incl;
        __syncthreads();
        unsigned base = 0u;
#pragma unroll
        for (int q = 0; q < 8; ++q) base += (q < wid) ? wsum[q] : 0u;
        unsigned rank = base + incl - myties;
        unsigned bits = gt;
#pragma unroll
        for (int i = 0; i < 16; ++i) if ((eq >> i) & 1u) { if (rank < r) bits |= 1u << i; ++rank; }
        const unsigned hi16 = __shfl_down(bits, 1);
        if (!(tid & 1)) mrow[tid >> 1] = bits | (hi16 << 16);
    }
}

namespace pg8 {
#define PG8_LAS __attribute__((address_space(3)))
typedef unsigned short bf16_t;
typedef short bf16x8 __attribute__((ext_vector_type(8)));
typedef float f32x4 __attribute__((ext_vector_type(4)));
typedef unsigned u32x4 __attribute__((ext_vector_type(4)));
constexpr int BM = 256, BK = 64, HALF = 128, HTB = HALF * BK * 2  , STAGE_BYTES = 8 * HTB, NXCD = 8, WGM = 8;

__host__ __device__ __forceinline__ int lds_byte(int r, int c) { const int st = (r >> 4) * 2 + (c >> 5), rr = r & 15, cc = c & 31, ob = rr * 64 + cc * 2; return st * 1024 + (ob ^ (((ob >> 9) & 1) << 5)); }
__host__ __device__ __forceinline__ void stage_rc(int b, int& R, int& C) { const int st = b / 1024, sb = b % 1024, swz = sb ^ (((sb >> 9) & 1) << 5); R = (st >> 1) * 16 + swz / 64; C = (st & 1) * 32 + (swz % 64) / 2; }
__host__ __device__ __forceinline__ int perm32(int rho) { const int n = rho >> 4, i = rho & 15; return 8 * (i >> 2) + 4 * n + (i & 3); }

struct Unit { int pm, pn; };
struct Gemm { const bf16_t* A; const bf16_t* Bt; int M, N, K; };

struct StaticOrder {
    int nM, nN, nwg, G, c;
    __host__ __device__ void init(int M, int N, int G_, int c_) { nM = M / BM; nN = N / BM; nwg = nM * nN; G = G_; c = c_; }
    __host__ __device__ bool next(int i, Unit& u) const {
        const long L = (long)i * G + c; if (L >= nwg) return false;
        int wgid = (int)L; { const int q = nwg / NXCD, r = nwg % NXCD, xcd = wgid % NXCD, off = wgid / NXCD; wgid = (xcd < r ? xcd * (q + 1) : r * (q + 1) + (xcd - r) * q) + off; }
        const int nig = WGM * nN, gid = wgid / nig, fm = gid * WGM, gsz = (nM - fm) < WGM ? (nM - fm) : WGM;
        u.pm = fm + ((wgid % nig) % gsz); u.pn = (wgid % nig) / gsz; return true;
    }
    __device__ __forceinline__ void a_ready(const Unit&) const {}
    __device__ __forceinline__ void done(const Unit&) const {}
};

__device__ __forceinline__ unsigned cvt_pk_bf16(float lo, float hi) { unsigned r; asm volatile("v_cvt_pk_bf16_f32 %0, %1, %2" : "=v"(r) : "v"(lo), "v"(hi)); return r; }
__device__ __forceinline__ float silu_f(float g) { return g / (1.f + __expf(-g)); }
struct EpiSwiGLU {
    static constexpr bool PERM = true, AFTER_DRAIN = false;
    bf16_t* O;
    __device__ __forceinline__ void operator()(const f32x4 (&acc)[2][2][4][2], const Unit& u, int wr, int wc, int fr, int fq) const {
        const int row0 = u.pm * BM + wr * 64 + fr, col0 = u.pn * 128 + wc * 32 + 8 * fq;
#pragma unroll
        for (int ai = 0; ai < 2; ++ai)
#pragma unroll
            for (int m = 0; m < 4; ++m) {
                bf16_t* rowp = O + (size_t)(row0 + ai * HALF + m * 16) * 2816 + col0;
                const f32x4 g0 = acc[ai][0][m][0], g1 = acc[ai][0][m][1], u0 = acc[ai][1][m][0], u1 = acc[ai][1][m][1];
                u32x4 w;
                w.x = cvt_pk_bf16(silu_f(g0[0]) * u0[0], silu_f(g0[1]) * u0[1]); w.y = cvt_pk_bf16(silu_f(g0[2]) * u0[2], silu_f(g0[3]) * u0[3]);
                w.z = cvt_pk_bf16(silu_f(g1[0]) * u1[0], silu_f(g1[1]) * u1[1]); w.w = cvt_pk_bf16(silu_f(g1[2]) * u1[2], silu_f(g1[3]) * u1[3]);
                *(u32x4*)rowp = w;
            }
    }
};
struct EpiRes {
    static constexpr bool PERM = false, AFTER_DRAIN = false;
    const float* xres; float* out; const float* modl; int sub; float fac;
    __device__ __forceinline__ void operator()(const f32x4 (&acc)[2][2][4][2], const Unit& u, int wr, int wc, int fr, int fq) const {
        const int b = (u.pm * BM) >> 13;
        const float* gate = modl + (size_t)b * 9216 + sub * 3072 + 2048;
        const int col0 = u.pn * BM + wc * 32 + 4 * fq;
#pragma unroll
        for (int bj = 0; bj < 2; ++bj)
#pragma unroll
            for (int n = 0; n < 2; ++n) {
                const int col = col0 + bj * HALF + n * 16;
                f32x4 gm = *(const f32x4*)(gate + col); gm = (gm + 1.0f) * fac;
#pragma unroll
                for (int ai = 0; ai < 2; ++ai)
#pragma unroll
                    for (int m = 0; m < 4; ++m) {
                        const size_t off = (size_t)(u.pm * BM + ai * HALF + wr * 64 + m * 16 + fr) * 1024 + col;
                        const f32x4 xr = *(const f32x4*)(xres + off);
                        *(f32x4*)(out + off) = xr * 1.41421356237f + gm * acc[ai][bj][m][n];
                    }
            }
    }
};
struct EpiInproj {
    static constexpr bool PERM = true, AFTER_DRAIN = false;
    bf16_t* proj; const float* rope; float* iw; float* logf; const float* bfg;
    __device__ __forceinline__ void operator()(const f32x4 (&acc)[2][2][4][2], const Unit& u, int wr, int wc, int fr, int fq) const {
#pragma unroll
        for (int bj = 0; bj < 2; ++bj) {
            const int cb32 = u.pn * BM + bj * HALF + wc * 32;
            const bool rp = ((cb32 & 63) == 0) && (cb32 < 768 || (cb32 >= 1152 && cb32 < 1664) || (cb32 >= 1920 && cb32 < 2240));
#pragma unroll
            for (int ai = 0; ai < 2; ++ai)
#pragma unroll
                for (int m = 0; m < 4; ++m) {
                    const int row = u.pm * BM + ai * HALF + wr * 64 + m * 16 + fr;
                    f32x4 v0 = acc[ai][bj][m][0], v1 = acc[ai][bj][m][1];
                    if (rp) {
                        const int t = row & 8191;
                        const f32x4* rt = (const f32x4*)(rope + (size_t)t * 16);
                        const f32x4 r0 = rt[0], r1 = rt[1], r2 = rt[2], r3 = rt[3];
                        f32x4 p0, p1;
#pragma unroll
                        for (int j = 0; j < 4; ++j) { p0[j] = __shfl_xor(v0[j], 16); p1[j] = __shfl_xor(v1[j], 16); }
                        if (fq == 0) {
                            v0[0] = v0[0] * r0[0] - p0[0] * r0[1]; v0[1] = v0[1] * r0[2] - p0[1] * r0[3]; v0[2] = v0[2] * r1[0] - p0[2] * r1[1]; v0[3] = v0[3] * r1[2] - p0[3] * r1[3];
                            v1[0] = v1[0] * r2[0] - p1[0] * r2[1]; v1[1] = v1[1] * r2[2] - p1[1] * r2[3]; v1[2] = v1[2] * r3[0] - p1[2] * r3[1]; v1[3] = v1[3] * r3[2] - p1[3] * r3[3];
                        } else if (fq == 1) {
                            v0[0] = v0[0] * r0[0] + p0[0] * r0[1]; v0[1] = v0[1] * r0[2] + p0[1] * r0[3]; v0[2] = v0[2] * r1[0] + p0[2] * r1[1]; v0[3] = v0[3] * r1[2] + p0[3] * r1[3];
                            v1[0] = v1[0] * r2[0] + p1[0] * r2[1]; v1[1] = v1[1] * r2[2] + p1[1] * r2[3]; v1[2] = v1[2] * r3[0] + p1[2] * r3[1]; v1[3] = v1[3] * r3[2] + p1[3] * r3[3];
                        }
                    }
                    u32x4 w; w.x = cvt_pk_bf16(v0[0], v0[1]); w.y = cvt_pk_bf16(v0[2], v0[3]); w.z = cvt_pk_bf16(v1[0], v1[1]); w.w = cvt_pk_bf16(v1[2], v1[3]);
                    *(u32x4*)(proj + (size_t)row * 3840 + cb32 + 8 * fq) = w;
                    if (cb32 == 3776 && fq == 0) {
                        *(f32x4*)(iw + (size_t)row * 4) = v0;
                        f32x4 lf;
#pragma unroll
                        for (int j = 0; j < 4; ++j) { const float xx = v1[j] + bfg[j]; lf[j] = fminf(xx, 0.f) - log1pf(expf(-fabsf(xx))); }
                        *(f32x4*)(logf + (size_t)row * 4) = lf;
                    }
                }
        }
    }
};
template <class Epi, class Sched, bool ALIGN_EPI = false, bool SP2 = false>
__device__ __forceinline__ void gemm_phase(PG8_LAS unsigned char* lds, const Gemm g, const Sched& S, const Epi& E) {
    int tid_ = threadIdx.x; asm volatile("" : "+v"(tid_));
    const int tid = tid_, wid = __builtin_amdgcn_readfirstlane(tid >> 6), lane = tid & 63, wr = wid >> 2, wc = wid & 3, fr = lane & 15, fq = lane >> 4;
    const int K = g.K, nt = K / BK;
    unsigned voffA[2], voffB[2];
#pragma unroll
    for (int i = 0; i < 2; ++i) { int R, C; stage_rc(tid * 16 + i * 8192, R, C); const int Rb = Epi::PERM ? ((R & ~31) + perm32(R & 31)) : R;
        voffA[i] = (unsigned)(R * K + C) * 2u; voffB[i] = (unsigned)(Rb * K + C) * 2u; }
    const size_t kstep = (size_t)(BK * 2);
    const size_t hstep = (size_t)HALF * K * 2;
    const size_t tstep = 2 * hstep;
    const unsigned ldsw = (unsigned)wid * 1024u;
    const int aoff = lds_byte(wr * 64 + fr, fq * 8), boff = lds_byte(wc * 32 + fr, fq * 8);
#define PG8_SA(b, h) (((b) * 2 + (h)) * HTB)
#define PG8_SB(b, h) ((4 + (b) * 2 + (h)) * HTB)
#define PG8_STAGE(bufoff, gbase, voff) do { _Pragma("unroll") for (int _i = 0; _i < 2; ++_i) \
        __builtin_amdgcn_global_load_lds((const unsigned*)((const char*)(gbase) + (voff)[_i]), (PG8_LAS unsigned*)(lds + (bufoff) + ldsw + _i * 8192), 16, 0, 0); } while (0)
#define PG8_LDA(dst, b, h) do { _Pragma("unroll") for (int m = 0; m < 4; ++m) _Pragma("unroll") for (int k = 0; k < 2; ++k) dst[m][k] = *(const PG8_LAS bf16x8*)(lds + PG8_SA(b, h) + aoff + m * 2048 + k * 1024); } while (0)
#define PG8_LDB(dst, b, h) do { _Pragma("unroll") for (int n = 0; n < 2; ++n) _Pragma("unroll") for (int k = 0; k < 2; ++k) dst[n][k] = *(const PG8_LAS bf16x8*)(lds + PG8_SB(b, h) + boff + n * 2048 + k * 1024); } while (0)
#define PG8_MMA(ai, bj, At, Bt) do { __builtin_amdgcn_s_setprio(1); _Pragma("unroll") for (int m = 0; m < 4; ++m) _Pragma("unroll") for (int n = 0; n < 2; ++n) _Pragma("unroll") for (int k = 0; k < 2; ++k) \
        acc[ai][bj][m][n] = __builtin_amdgcn_mfma_f32_16x16x32_bf16(Bt[n][k], At[m][k], acc[ai][bj][m][n], 0, 0, 0); __builtin_amdgcn_s_setprio(0); } while (0)
#define PG8_WAIT_V(n) asm volatile("s_waitcnt vmcnt(" #n ")" ::: "memory")
#define PG8_WAIT_L(n) asm volatile("s_waitcnt lgkmcnt(" #n ")" ::: "memory")
#define PG8_BAR __builtin_amdgcn_s_barrier()
#define PG8_SCHED __builtin_amdgcn_sched_barrier(0)
    Unit cur, nxt; int ui = 0;
    if (!S.next(0, cur)) return;
    f32x4 acc[2][2][4][2];
#pragma unroll
    for (int a = 0; a < 2; ++a)
#pragma unroll
        for (int b = 0; b < 2; ++b)
#pragma unroll
            for (int m = 0; m < 4; ++m)
#pragma unroll
                for (int n = 0; n < 2; ++n) acc[a][b][m][n] = (f32x4){0.f, 0.f, 0.f, 0.f};
    bf16x8 At[4][2], B0[2][2], B1[2][2];
    const char* cA = (const char*)g.A + (size_t)cur.pm * tstep; const char* cB = (const char*)g.Bt + (size_t)cur.pn * tstep;
    S.a_ready(cur);
    if constexpr (SP2) {
        PG8_STAGE(PG8_SB(0, 0), cB, voffB); PG8_STAGE(PG8_SB(0, 1), cB + hstep, voffB); PG8_STAGE(PG8_SA(0, 0), cA, voffA); PG8_STAGE(PG8_SA(0, 1), cA + hstep, voffA);
        if (wr == 1) PG8_BAR;
        PG8_WAIT_V(2); PG8_BAR;
        PG8_STAGE(PG8_SB(1, 0), cB + kstep, voffB); PG8_STAGE(PG8_SA(1, 0), cA + kstep, voffA); PG8_STAGE(PG8_SB(1, 1), cB + hstep + kstep, voffB);
        PG8_WAIT_V(6); PG8_BAR;
    } else {
        PG8_STAGE(PG8_SB(0, 0), cB, voffB); PG8_STAGE(PG8_SA(0, 0), cA, voffA); PG8_STAGE(PG8_SB(0, 1), cB + hstep, voffB); PG8_STAGE(PG8_SA(0, 1), cA + hstep, voffA);
        if (wr == 1) PG8_BAR;
        PG8_WAIT_V(4); PG8_BAR;
        PG8_STAGE(PG8_SB(1, 0), cB + kstep, voffB); PG8_STAGE(PG8_SA(1, 0), cA + kstep, voffA); PG8_STAGE(PG8_SB(1, 1), cB + hstep + kstep, voffB);
        PG8_WAIT_V(6); PG8_BAR;
    }
    for (;;) {
        const bool has_next = S.next(ui + 1, nxt);
        const char* nA = has_next ? (const char*)g.A + (size_t)nxt.pm * tstep : cA; const char* nB = has_next ? (const char*)g.Bt + (size_t)nxt.pn * tstep : cB;
        for (int t = 0; t < nt; t += 2) {
            const bool last = (t == nt - 2);
            const char* a1 = cA + (size_t)(t + 1) * kstep;
            const char* a2 = last ? nA : cA + (size_t)(t + 2) * kstep; const char* b2 = last ? nB : cB + (size_t)(t + 2) * kstep;
            const char* a3 = a2 + kstep; const char* b3 = b2 + kstep;
            if (last && has_next) S.a_ready(nxt);
            if constexpr (SP2) {
            PG8_LDB(B0, 0, 0); PG8_LDB(B1, 0, 1); PG8_SCHED; PG8_LDA(At, 0, 0); PG8_STAGE(PG8_SA(1, 1), a1 + hstep, voffA);
            PG8_WAIT_V(8); PG8_WAIT_L(0); PG8_BAR; PG8_MMA(0, 0, At, B0); PG8_MMA(0, 1, At, B1); PG8_BAR; PG8_SCHED;
            PG8_LDA(At, 0, 1); PG8_STAGE(PG8_SB(0, 0), b2, voffB); PG8_STAGE(PG8_SB(0, 1), b2 + hstep, voffB); PG8_STAGE(PG8_SA(0, 0), a2, voffA);
            PG8_WAIT_V(8); PG8_WAIT_L(0); PG8_BAR; PG8_MMA(1, 0, At, B0); PG8_MMA(1, 1, At, B1); PG8_BAR; PG8_SCHED;
            PG8_LDB(B0, 1, 0); PG8_LDB(B1, 1, 1); PG8_SCHED; PG8_LDA(At, 1, 0); PG8_STAGE(PG8_SA(0, 1), a2 + hstep, voffA);
            PG8_WAIT_V(8); PG8_WAIT_L(0); PG8_BAR; PG8_MMA(0, 0, At, B0); PG8_MMA(0, 1, At, B1); PG8_BAR; PG8_SCHED;
            PG8_LDA(At, 1, 1); PG8_STAGE(PG8_SB(1, 0), b3, voffB); PG8_STAGE(PG8_SB(1, 1), b3 + hstep, voffB); PG8_STAGE(PG8_SA(1, 0), a3, voffA);
            PG8_WAIT_V(8); PG8_WAIT_L(0); PG8_BAR; PG8_MMA(1, 0, At, B0); PG8_MMA(1, 1, At, B1); PG8_BAR; PG8_SCHED;
            } else {
            PG8_LDB(B0, 0, 0); PG8_SCHED; PG8_LDA(At, 0, 0); PG8_STAGE(PG8_SA(1, 1), a1 + hstep, voffA);
            PG8_WAIT_L(8); PG8_BAR; PG8_WAIT_L(0); PG8_MMA(0, 0, At, B0); PG8_BAR; PG8_SCHED;
            PG8_LDB(B1, 0, 1); PG8_STAGE(PG8_SB(0, 0), b2, voffB);
            PG8_BAR; PG8_WAIT_L(0); PG8_MMA(0, 1, At, B1); PG8_BAR;
            PG8_LDA(At, 0, 1); PG8_STAGE(PG8_SA(0, 0), a2, voffA);
            PG8_BAR; PG8_WAIT_L(0); PG8_MMA(1, 0, At, B0); PG8_BAR; PG8_SCHED;
            PG8_STAGE(PG8_SB(0, 1), b2 + hstep, voffB);
            PG8_WAIT_V(6); PG8_BAR; PG8_MMA(1, 1, At, B1); PG8_BAR;
            PG8_LDB(B0, 1, 0); PG8_SCHED; PG8_LDA(At, 1, 0); PG8_STAGE(PG8_SA(0, 1), a2 + hstep, voffA);
            PG8_WAIT_L(8); PG8_BAR; PG8_WAIT_L(0); PG8_MMA(0, 0, At, B0); PG8_BAR; PG8_SCHED;
            PG8_LDB(B1, 1, 1); PG8_STAGE(PG8_SB(1, 0), b3, voffB);
            PG8_BAR; PG8_WAIT_L(0); PG8_MMA(0, 1, At, B1); PG8_BAR;
            PG8_LDA(At, 1, 1); PG8_STAGE(PG8_SA(1, 0), a3, voffA);
            PG8_BAR; PG8_WAIT_L(0); PG8_MMA(1, 0, At, B0); PG8_BAR; PG8_SCHED;
            PG8_STAGE(PG8_SB(1, 1), b3 + hstep, voffB);
            PG8_WAIT_V(6); PG8_BAR; PG8_MMA(1, 1, At, B1); PG8_BAR;
            }
        }
        if constexpr (ALIGN_EPI) { if (wr == 0) PG8_BAR; }
        if constexpr (!Epi::AFTER_DRAIN) { E(acc, cur, wr, wc, fr, fq); S.done(cur); }
        if (!has_next) break;
#pragma unroll
        for (int a = 0; a < 2; ++a)
#pragma unroll
            for (int b = 0; b < 2; ++b)
#pragma unroll
                for (int m = 0; m < 4; ++m)
#pragma unroll
                    for (int n = 0; n < 2; ++n) acc[a][b][m][n] = (f32x4){0.f, 0.f, 0.f, 0.f};
        cur = nxt; cA = nA; cB = nB; ++ui;
        if constexpr (ALIGN_EPI) { if (wr == 1) PG8_BAR; }
    }
    PG8_WAIT_V(0);
    if constexpr (!ALIGN_EPI) { if (wr == 0) PG8_BAR; }
    PG8_BAR;
    if constexpr (Epi::AFTER_DRAIN) { E.fused(acc, cur, wr, wc, fr, fq, lds, wid, lane); S.done(cur); }
#undef PG8_SA
#undef PG8_SB
#undef PG8_STAGE
#undef PG8_LDA
#undef PG8_LDB
#undef PG8_MMA
#undef PG8_WAIT_V
#undef PG8_WAIT_L
#undef PG8_BAR
#undef PG8_SCHED
}
}

template <class Epi>
__device__ __forceinline__ void run_gemm(PG8_LAS unsigned char* lds, const bf16_t* A, const bf16_t* Bt, int N, int K, const Epi& E) {
    pg8::Gemm g{A, Bt, NTOK, N, K}; pg8::StaticOrder S; S.init(NTOK, N, (int)gridDim.x, (int)blockIdx.x);
    pg8::gemm_phase<Epi, pg8::StaticOrder, true, true>(lds, g, S, E);
}

__global__ void __launch_bounds__(NTHR, 2) mega_kernel(Params p) {
    extern __shared__ __attribute__((aligned(16))) unsigned char lds_raw[];
    PG8_LAS unsigned char* lds = (PG8_LAS unsigned char*)lds_raw;
    char* smem = (char*)lds_raw;
    cg::grid_group grid = cg::this_grid();
    phase_prologue(p, smem);
    grid.sync();
    phase_u0(p);
    grid.sync();
#define LL(v) ({ int l_ = (v); asm volatile("" : "+s"(l_)); l_; })
#define WL(v) (p.wts + (size_t)(v) * WL_ELEMS)
#define ML(v) (p.mod + (size_t)(v) * 4 * 9216)
#pragma unroll 1
    for (int l = 0; l < 2; ++l) {
        { const int k = LL(l); run_gemm(lds, p.ubuf, WL(k) + W_FIN0, 5632, 1024, pg8::EpiSwiGLU{p.act}); }
        grid.sync();
        { const int k = LL(l); run_gemm(lds, p.act, WL(k) + W_FOUT0, 1024, DFF, pg8::EpiRes{k == 0 ? p.x : p.out, p.out, ML(k), 0, 0.5f}); }
        grid.sync();
        phase_ln(p, LL(l), 0, true);
        grid.sync();
        { const int k = LL(l); run_gemm(lds, p.ubuf, WL(k) + W_IN, NPROJ, 1024, pg8::EpiInproj{p.proj, p.rope, p.iw, p.logf, p.mix_b_forget + k * 4}); }
        grid.sync();
        phase_topk(p, smem); phase_scan(p, smem); phase_attn_a(p); phase_attn_c(p);
        grid.sync();
        phase_flash(p, smem);
        grid.sync();
        phase_merge(p, LL(l), smem);
        grid.sync();
        { const int k = LL(l); run_gemm(lds, p.merged, WL(k) + W_OUT, 1024, 1024, pg8::EpiRes{p.out, p.out, ML(k), 1, 1.0f}); }
        grid.sync();
        phase_ln(p, LL(l), 1, true);
        grid.sync();
        { const int k = LL(l); run_gemm(lds, p.ubuf, WL(k) + W_FIN1, 5632, 1024, pg8::EpiSwiGLU{p.act}); }
        grid.sync();
        { const int k = LL(l); run_gemm(lds, p.act, WL(k) + W_FOUT1, 1024, DFF, pg8::EpiRes{p.out, p.out, ML(k), 2, 0.5f}); }
        grid.sync();
        { const int k = LL(l); phase_ln(p, k, 2, k == 0); }
        if (l == 0) grid.sync();
    }
}

extern "C" void kernel_launch(void* const* d_in, const int* in_sizes, int n_in, void* d_out, int out_size, void* d_ws, size_t ws_size, hipStream_t stream) {
    Params p{};
    p.x = (const float*)d_in[0]; p.c = (const float*)d_in[1]; p.ada_w = (const float*)d_in[2]; p.ada_b = (const float*)d_in[3];
    p.ln_g = (const float*)d_in[4]; p.ln_b = (const float*)d_in[5]; p.ffn_w_in = (const float*)d_in[6]; p.ffn_w_out = (const float*)d_in[7];
    p.mix_w_in = (const float*)d_in[8]; p.mix_b_gate = (const float*)d_in[9]; p.mix_b_forget = (const float*)d_in[10];
    p.mix_w_branch = (const float*)d_in[11]; p.mix_w_out = (const float*)d_in[12];
    p.out = (float*)d_out;
    char* ws = (char*)d_ws; size_t off = 0;
    auto take = [&](size_t bytes) { char* r = ws + off; off += (bytes + 255) & ~(size_t)255; return r; };
    p.wts = (bf16_t*)take(2 * WL_ELEMS * 2);
    p.mod = (float*)take(2 * 4 * 9216 * 4);
    p.rope = (float*)take(SEQ * 16 * 4);
    p.ubuf = (bf16_t*)take((size_t)NTOK * 1024 * 2);
    p.act = (bf16_t*)(ws + off);
    p.proj = (bf16_t*)take((size_t)NTOK * NPROJ * 2);
    p.merged = p.proj;
    p.iw = (float*)take((size_t)NTOK * 16); p.logf = (float*)take((size_t)NTOK * 16); p.cum = (float*)take((size_t)NTOK * 16);
    p.maskb = (unsigned*)take((size_t)NTOK * 1024);
    p.ybuf = (bf16_t*)take((size_t)NTOK * 896 * 2);
    if (off > ws_size) { fprintf(stderr, "workspace too small: need %zu have %zu\n", off, ws_size); return; }
    static int grid_blocks = 0;
    if (!grid_blocks) {
        int dev = 0, cus = 0, per_cu = 0;
        (void)hipGetDevice(&dev);
        (void)hipDeviceGetAttribute(&cus, hipDeviceAttributeMultiprocessorCount, dev);
        (void)hipFuncSetAttribute((const void*)mega_kernel, hipFuncAttributeMaxDynamicSharedMemorySize, LDS_BYTES);
        (void)hipOccupancyMaxActiveBlocksPerMultiprocessor(&per_cu, mega_kernel, NTHR, LDS_BYTES);
        if (per_cu < 1) per_cu = 1;
        if (per_cu > 1) per_cu = 1;
        grid_blocks = cus * per_cu;
    }
    void* args[] = {&p};
    hipError_t e = hipLaunchCooperativeKernel((void*)mega_kernel, dim3(grid_blocks), dim3(NTHR), args, LDS_BYTES, stream);
    if (e != hipSuccess) fprintf(stderr, "cooperative launch failed: %s (grid %d)\n", hipGetErrorString(e), grid_blocks);
}
```

```cpp
#include <hip/hip_runtime.h>
#include <hip/hip_cooperative_groups.h>
#include <cstdio>
#include <cstdint>
namespace cg = cooperative_groups;

constexpr int NTHR = 512, NWV = 8;
constexpr int DM = 1024, SEQ = 8192, NTOK = 4 * 8192, DFF = 2816;
constexpr int NPROJ = 3840;
constexpr int PA = 0, PB = 1152, PIQ = 1920, PIK = 2176, PC = 2240, PD = 3008, PIW = 3776;
constexpr float ALPHA = 1.41421356237f;
constexpr size_t W_FIN0 = 0, W_FIN1 = 5767168, W_FOUT0 = 11534336, W_FOUT1 = 11534336 + 2883584, W_IN = 17301504,
                 W_GATE = 21233664, W_BR = 25427968, W_OUT = 26345472, WL_ELEMS = 27394048;
constexpr int LDS_BYTES = 160 * 1024;


typedef unsigned short bf16_t;
typedef short bf16x8 __attribute__((ext_vector_type(8)));
typedef float f32x4 __attribute__((ext_vector_type(4)));

struct Params {
    const float *x, *c, *ada_w, *ada_b, *ln_g, *ln_b, *ffn_w_in, *ffn_w_out, *mix_w_in, *mix_b_gate, *mix_b_forget, *mix_w_branch, *mix_w_out;
    float* out;
    bf16_t* wts; float* mod; float* rope; bf16_t* ubuf; bf16_t* act; bf16_t* proj; bf16_t* merged;
    float* iw; float* logf; float* cum; unsigned* maskb; bf16_t* ybuf;
};

__device__ __forceinline__ bf16_t f2bf(float f) { unsigned u = __float_as_uint(f); u += 0x7FFFu + ((u >> 16) & 1u); return (bf16_t)(u >> 16); }
__device__ __forceinline__ float bf2f(bf16_t h) { return __uint_as_float(((unsigned)h) << 16); }
__device__ __forceinline__ float blo(unsigned u) { return __uint_as_float(u << 16); }
__device__ __forceinline__ float bhi(unsigned u) { return __uint_as_float(u & 0xffff0000u); }
__device__ __forceinline__ int otid() { int t = threadIdx.x; asm volatile("" : "+v"(t)); return t; }
__device__ __forceinline__ float log_sigmoid(float x) { return fminf(x, 0.f) - log1pf(expf(-fabsf(x))); }

__device__ __forceinline__ int colmap(int mode, int n) {
    if (mode == 0) return n;
    if (mode == 1) { int q = n >> 8, r = n & 255; return r < 128 ? 128 * q + r : 2816 + 128 * q + (r - 128); }
    if (mode == 2) { if (n < 2240) return n; if (n < 3776) return n + 4; if (n < 3780) return 2240 + (n - 3776); if (n < 3784) return n; return -1; }
    return 3784 + n;
}
__device__ __forceinline__ void convert_job(const float* __restrict__ src, int K, int Nsrc, bf16_t* __restrict__ dst, int Ndst, int mode, char* smem) {
    float (*t)[33] = (float (*)[33])smem;
    const int tid = threadIdx.x, tx = tid & 31, ty = tid >> 5;
    const int kt_n = K / 64, ntiles = kt_n * (Ndst / 32);
    for (int tile = blockIdx.x; tile < ntiles; tile += gridDim.x) {
        const int k0 = (tile % kt_n) * 64, n0 = (tile / kt_n) * 32;
        const int sc = colmap(mode, n0 + tx);
        __syncthreads();
#pragma unroll
        for (int i = 0; i < 4; ++i) { const int k = ty + 16 * i; t[k][tx] = sc >= 0 ? src[(size_t)(k0 + k) * Nsrc + sc] : 0.f; }
        __syncthreads();
        const int kk = tid & 63, nb = tid >> 6;
#pragma unroll
        for (int i = 0; i < 4; ++i) { const int n = nb + 8 * i; dst[(size_t)(n0 + n) * K + k0 + kk] = f2bf(t[kk][n]); }
    }
}

__device__ __forceinline__ void phase_prologue(const Params& p, char* smem) {
    for (int l = 0; l < 2; ++l) {
        bf16_t* w = p.wts + (size_t)l * WL_ELEMS;
        convert_job(p.ffn_w_in + (size_t)(l * 2 + 0) * 1024 * 5632, 1024, 5632, w + W_FIN0, 5632, 1, smem);
        convert_job(p.ffn_w_in + (size_t)(l * 2 + 1) * 1024 * 5632, 1024, 5632, w + W_FIN1, 5632, 1, smem);
        convert_job(p.ffn_w_out + (size_t)(l * 2 + 0) * 2816 * 1024, 2816, 1024, w + W_FOUT0, 1024, 0, smem);
        convert_job(p.ffn_w_out + (size_t)(l * 2 + 1) * 2816 * 1024, 2816, 1024, w + W_FOUT1, 1024, 0, smem);
        convert_job(p.mix_w_in + (size_t)l * 1024 * 7880, 1024, 7880, w + W_IN, 3840, 2, smem);
        convert_job(p.mix_w_in + (size_t)l * 1024 * 7880, 1024, 7880, w + W_GATE, 4096, 3, smem);
        convert_job(p.mix_w_branch + (size_t)l * 896 * 1024, 896, 1024, w + W_BR, 1024, 0, smem);
        convert_job(p.mix_w_out + (size_t)l * 1024 * 1024, 1024, 1024, w + W_OUT, 1024, 0, smem);
    }
    for (int idx = blockIdx.x * NTHR + threadIdx.x; idx < SEQ * 8; idx += gridDim.x * NTHR) {
        const int t = idx >> 3, i = idx & 7;
        const float invf = powf(500000.0f, -(float)i * 0.125f);
        const float ang = (float)t * invf;
        p.rope[idx * 2 + 0] = cosf(ang);
        p.rope[idx * 2 + 1] = sinf(ang);
    }
    __syncthreads();
    float* scs = (float*)smem;
    float* red = scs + 4096;
    for (int i = threadIdx.x; i < 4096; i += NTHR) { const float v = p.c[i]; scs[i] = v / (1.f + expf(-v)); }
    __syncthreads();
    const int tid = threadIdx.x, cl = tid & 63, kq = tid >> 6;
    for (int item = blockIdx.x; item < 288; item += gridDim.x) {
        const int l = item / 144, col = (item % 144) * 64 + cl;
        float a0 = 0.f, a1 = 0.f, a2 = 0.f, a3 = 0.f;
        const float* wp = p.ada_w + ((size_t)l * 1024 + kq * 128) * 9216 + col;
#pragma unroll 8
        for (int k = 0; k < 128; ++k) {
            const float w = wp[(size_t)k * 9216]; const int kk = kq * 128 + k;
            a0 = fmaf(scs[kk], w, a0); a1 = fmaf(scs[1024 + kk], w, a1); a2 = fmaf(scs[2048 + kk], w, a2); a3 = fmaf(scs[3072 + kk], w, a3);
        }
        red[(kq * 4 + 0) * 64 + cl] = a0; red[(kq * 4 + 1) * 64 + cl] = a1; red[(kq * 4 + 2) * 64 + cl] = a2; red[(kq * 4 + 3) * 64 + cl] = a3;
        __syncthreads();
        if (kq < 4) {
            const int b = kq; float s = 0.f;
#pragma unroll
            for (int q = 0; q < 8; ++q) s += red[(q * 4 + b) * 64 + cl];
            p.mod[(size_t)(l * 4 + b) * 9216 + col] = s + p.ada_b[(size_t)l * 9216 + col];
        }
        __syncthreads();
    }
}

__device__ __forceinline__ void phase_u0(const Params& p) {
    const size_t n4 = (size_t)NTOK * 256;
    for (size_t i = (size_t)blockIdx.x * NTHR + threadIdx.x; i < n4; i += (size_t)gridDim.x * NTHR) {
        const size_t row = i >> 8; const int c4 = (int)(i & 255) * 4; const int b = (int)(row >> 13);
        const float4 v = *(const float4*)(p.x + row * 1024 + c4);
        const float* md = p.mod + (size_t)(0 * 4 + b) * 9216;
        const float4 sh = *(const float4*)(md + c4), sc = *(const float4*)(md + 1024 + c4);
        ushort4 o; o.x = f2bf(v.x * (1.f + sc.x) + sh.x); o.y = f2bf(v.y * (1.f + sc.y) + sh.y); o.z = f2bf(v.z * (1.f + sc.z) + sh.z); o.w = f2bf(v.w * (1.f + sc.w) + sh.w);
        *(ushort4*)(p.ubuf + row * 1024 + c4) = o;
    }
}

__device__ __forceinline__ void gemm_mainloop(f32x4 (&acc)[4][4], const bf16_t* __restrict__ A, int lda, const bf16_t* __restrict__ Bt, int ldb, int K, char* smem) {
    bf16_t* As = (bf16_t*)smem; bf16_t* Bs = As + 256 * 40;
    int tid_ = threadIdx.x; asm volatile("" : "+v"(tid_));
    const int tid = tid_, lane = tid & 63, wid = tid >> 6, wr = wid >> 1, wc = wid & 1;
    const int lr = tid >> 1, lk = (tid & 1) * 16;
    const int br = (tid & 255) >> 1;
    const bool ldB = tid < 256;
    const uint4* ga = (const uint4*)(A + (size_t)lr * lda + lk);
    const uint4* gb = (const uint4*)(Bt + (size_t)br * ldb + lk);
    uint4 ra0 = ga[0], ra1 = ga[1], rb0 = make_uint4(0, 0, 0, 0), rb1 = rb0;
    if (ldB) { rb0 = gb[0]; rb1 = gb[1]; }
    const int fr = lane & 15, fq = lane >> 4;
    for (int k0 = 0; k0 < K; k0 += 32) {
        __syncthreads();
        *(uint4*)&As[lr * 40 + lk] = ra0; *(uint4*)&As[lr * 40 + lk + 8] = ra1;
        if (ldB) { *(uint4*)&Bs[br * 40 + lk] = rb0; *(uint4*)&Bs[br * 40 + lk + 8] = rb1; }
        __syncthreads();
        if (k0 + 32 < K) { ga += 4; gb += 4; ra0 = ga[0]; ra1 = ga[1]; if (ldB) { rb0 = gb[0]; rb1 = gb[1]; } }
        bf16x8 a[4], b[4];
#pragma unroll
        for (int m = 0; m < 4; ++m) a[m] = *(const bf16x8*)&As[(wr * 64 + m * 16 + fr) * 40 + fq * 8];
#pragma unroll
        for (int n = 0; n < 4; ++n) b[n] = *(const bf16x8*)&Bs[(wc * 64 + n * 16 + fr) * 40 + fq * 8];
#pragma unroll
        for (int m = 0; m < 4; ++m)
#pragma unroll
            for (int n = 0; n < 4; ++n) acc[m][n] = __builtin_amdgcn_mfma_f32_16x16x32_bf16(a[m], b[n], acc[m][n], 0, 0, 0);
    }
}
__device__ __forceinline__ void zero_acc(f32x4 (&acc)[4][4]) {
#pragma unroll
    for (int m = 0; m < 4; ++m)
#pragma unroll
        for (int n = 0; n < 4; ++n) acc[m][n] = (f32x4){0.f, 0.f, 0.f, 0.f};
}
__device__ __forceinline__ void phase_merge(const Params& p, int l, char* smem) {
    const bf16_t* WG = p.wts + (size_t)l * WL_ELEMS + W_GATE; const bf16_t* WB = p.wts + (size_t)l * WL_ELEMS + W_BR;
    const int tid = otid(), lane = tid & 63, wid = tid >> 6, wr = wid >> 1, wc = wid & 1, fr = lane & 15, fq = lane >> 4;
    for (int tile = blockIdx.x; tile < 128 * 8; tile += gridDim.x) {
        const int pm = tile / 8, pn = tile % 8;
        f32x4 accM[4][4]; zero_acc(accM);
#pragma unroll 1
        for (int br = 0; br < 4; ++br) {
            const int koff = br == 0 ? 0 : 128 + (br - 1) * 256, kb = br == 0 ? 128 : 256;
            f32x4 accG[4][4]; zero_acc(accG);
            gemm_mainloop(accG, p.ubuf + (size_t)pm * 256 * 1024, 1024, WG + (size_t)(br * 1024 + pn * 128) * 1024, 1024, 1024, smem);
            const float* bg = p.mix_b_gate + (size_t)l * 4096 + br * 1024;
#pragma unroll
            for (int n = 0; n < 4; ++n) {
                const float bv = bg[pn * 128 + wc * 64 + n * 16 + fr];
#pragma unroll
                for (int m = 0; m < 4; ++m)
#pragma unroll
                    for (int j = 0; j < 4; ++j) accG[m][n][j] = 1.f / (1.f + expf(-(accG[m][n][j] + bv)));
            }
            unsigned* gst = (unsigned*)(smem + 32768) + tid;
#pragma unroll
            for (int m = 0; m < 4; ++m)
#pragma unroll
                for (int n = 0; n < 4; ++n) {
                    gst[((m * 4 + n) * 2 + 0) * NTHR] = (unsigned)f2bf(accG[m][n][0]) | ((unsigned)f2bf(accG[m][n][1]) << 16);
                    gst[((m * 4 + n) * 2 + 1) * NTHR] = (unsigned)f2bf(accG[m][n][2]) | ((unsigned)f2bf(accG[m][n][3]) << 16);
                }
            zero_acc(accG);
            gemm_mainloop(accG, p.ybuf + (size_t)pm * 256 * 896 + koff, 896, WB + (size_t)pn * 128 * 896 + koff, 896, kb, smem);
#pragma unroll
            for (int m = 0; m < 4; ++m)
#pragma unroll
                for (int n = 0; n < 4; ++n) {
                    const unsigned g01 = gst[((m * 4 + n) * 2 + 0) * NTHR], g23 = gst[((m * 4 + n) * 2 + 1) * NTHR];
                    accM[m][n][0] += blo(g01) * accG[m][n][0]; accM[m][n][1] += bhi(g01) * accG[m][n][1];
                    accM[m][n][2] += blo(g23) * accG[m][n][2]; accM[m][n][3] += bhi(g23) * accG[m][n][3];
                }
        }
#pragma unroll
        for (int m = 0; m < 4; ++m)
#pragma unroll
            for (int n = 0; n < 4; ++n)
#pragma unroll
                for (int j = 0; j < 4; ++j)
                    p.merged[(size_t)(pm * 256 + wr * 64 + m * 16 + fq * 4 + j) * 1024 + pn * 128 + wc * 64 + n * 16 + fr] = f2bf(accM[m][n][j]);
    }
}

__device__ __forceinline__ void phase_ln(const Params& p, int l, int s, bool has_next) {
    const int tid_ = otid(), lane = tid_ & 63, wid = tid_ >> 6;
    const float* g = p.ln_g + (size_t)(l * 3 + s) * 1024; const float* bb = p.ln_b + (size_t)(l * 3 + s) * 1024;
    const int nl = s < 2 ? l : l + 1, ns = s < 2 ? s + 1 : 0;
    for (int row = blockIdx.x * NWV + wid; row < NTOK; row += gridDim.x * NWV) {
        float* xr = p.out + (size_t)row * 1024;
        float4 v[4]; float sum = 0.f;
#pragma unroll
        for (int i = 0; i < 4; ++i) { v[i] = *(const float4*)(xr + lane * 4 + 256 * i); sum += (v[i].x + v[i].y) + (v[i].z + v[i].w); }
#pragma unroll
        for (int o = 32; o > 0; o >>= 1) sum += __shfl_xor(sum, o);
        const float mu = sum * (1.f / 1024.f); float q = 0.f;
#pragma unroll
        for (int i = 0; i < 4; ++i) { const float a = v[i].x - mu, b2 = v[i].y - mu, c = v[i].z - mu, d = v[i].w - mu; q += (a * a + b2 * b2) + (c * c + d * d); }
#pragma unroll
        for (int o = 32; o > 0; o >>= 1) q += __shfl_xor(q, o);
        const float rstd = 1.0f / sqrtf(q * (1.f / 1024.f) + 1e-5f);
        const int b = row >> 13;
        const float* md = p.mod + (size_t)(nl * 4 + b) * 9216 + ns * 3072;
#pragma unroll
        for (int i = 0; i < 4; ++i) {
            const int c4 = lane * 4 + 256 * i;
            const float4 gg = *(const float4*)(g + c4), be = *(const float4*)(bb + c4);
            float4 o; o.x = (v[i].x - mu) * rstd * gg.x + be.x; o.y = (v[i].y - mu) * rstd * gg.y + be.y; o.z = (v[i].z - mu) * rstd * gg.z + be.z; o.w = (v[i].w - mu) * rstd * gg.w + be.w;
            *(float4*)(xr + c4) = o;
            if (has_next) {
                const float4 sh = *(const float4*)(md + c4), sc = *(const float4*)(md + 1024 + c4);
                ushort4 u; u.x = f2bf(o.x * (1.f + sc.x) + sh.x); u.y = f2bf(o.y * (1.f + sc.y) + sh.y); u.z = f2bf(o.z * (1.f + sc.z) + sh.z); u.w = f2bf(o.w * (1.f + sc.w) + sh.w);
                *(ushort4*)(p.ubuf + (size_t)row * 1024 + c4) = u;
            }
        }
    }
}

__device__ __forceinline__ void load_row32(float (&q)[32], const bf16_t* row) {
    const uint4* r = (const uint4*)row;
#pragma unroll
    for (int c = 0; c < 4; ++c) { const uint4 v = r[c];
        q[c * 8 + 0] = blo(v.x); q[c * 8 + 1] = bhi(v.x); q[c * 8 + 2] = blo(v.y); q[c * 8 + 3] = bhi(v.y);
        q[c * 8 + 4] = blo(v.z); q[c * 8 + 5] = bhi(v.z); q[c * 8 + 6] = blo(v.w); q[c * 8 + 7] = bhi(v.w); }
}
__device__ __forceinline__ float dot32(const float (&q)[32], const bf16_t* row) {
    const uint4* r = (const uint4*)row; float a = 0.f;
#pragma unroll
    for (int c = 0; c < 4; ++c) { const uint4 v = r[c];
        a = fmaf(q[c * 8 + 0], blo(v.x), a); a = fmaf(q[c * 8 + 1], bhi(v.x), a); a = fmaf(q[c * 8 + 2], blo(v.y), a); a = fmaf(q[c * 8 + 3], bhi(v.y), a);
        a = fmaf(q[c * 8 + 4], blo(v.z), a); a = fmaf(q[c * 8 + 5], bhi(v.z), a); a = fmaf(q[c * 8 + 6], blo(v.w), a); a = fmaf(q[c * 8 + 7], bhi(v.w), a); }
    return a + __shfl_xor(a, 1);
}
__device__ __forceinline__ void axpy32(float (&o)[32], float sc, float pw, const bf16_t* row) {
    const uint4* r = (const uint4*)row;
#pragma unroll
    for (int c = 0; c < 4; ++c) { const uint4 v = r[c];
        o[c * 8 + 0] = fmaf(pw, blo(v.x), o[c * 8 + 0] * sc); o[c * 8 + 1] = fmaf(pw, bhi(v.x), o[c * 8 + 1] * sc);
        o[c * 8 + 2] = fmaf(pw, blo(v.y), o[c * 8 + 2] * sc); o[c * 8 + 3] = fmaf(pw, bhi(v.y), o[c * 8 + 3] * sc);
        o[c * 8 + 4] = fmaf(pw, blo(v.z), o[c * 8 + 4] * sc); o[c * 8 + 5] = fmaf(pw, bhi(v.z), o[c * 8 + 5] * sc);
        o[c * 8 + 6] = fmaf(pw, blo(v.w), o[c * 8 + 6] * sc); o[c * 8 + 7] = fmaf(pw, bhi(v.w), o[c * 8 + 7] * sc); }
}
__device__ __forceinline__ void store_row32(bf16_t* dst, const float (&o)[32], float sc) {
    uint4* r = (uint4*)dst;
#pragma unroll
    for (int c = 0; c < 4; ++c) { uint4 v;
        v.x = (unsigned)f2bf(o[c * 8 + 0] * sc) | ((unsigned)f2bf(o[c * 8 + 1] * sc) << 16); v.y = (unsigned)f2bf(o[c * 8 + 2] * sc) | ((unsigned)f2bf(o[c * 8 + 3] * sc) << 16);
        v.z = (unsigned)f2bf(o[c * 8 + 4] * sc) | ((unsigned)f2bf(o[c * 8 + 5] * sc) << 16); v.w = (unsigned)f2bf(o[c * 8 + 6] * sc) | ((unsigned)f2bf(o[c * 8 + 7] * sc) << 16);
        r[c] = v; }
}
__device__ __forceinline__ void zero32(float (&o)[32]) {
#pragma unroll
    for (int i = 0; i < 32; ++i) o[i] = 0.f;
}

__device__ __forceinline__ void phase_attn_a(const Params& p) {
    const int tid_ = otid(), lane = tid_ & 63, gw = blockIdx.x * NWV + (tid_ >> 6), nw = gridDim.x * NWV, hf = (lane & 1) * 32;
    for (int item = gw; item < 4 * 2 * 256; item += nw) {
        const int hp = item & 1, blk = (item >> 1) & 255, b = item >> 9;
        const int t = blk * 32 + (lane >> 1); const size_t tok = (size_t)b * SEQ + t;
        float o[32]; zero32(o); float mx = -INFINITY, lsum = 0.f;
#pragma unroll 1
        for (int g = 0; g < 3; ++g) {
            const int head = 2 * g + hp, dil = g == 0 ? 1 : (g == 1 ? 4 : 16);
            float q[32]; load_row32(q, p.proj + tok * NPROJ + PA + head * 64 + hf);
#pragma unroll 1
            for (int j = 0; j <= 128; ++j) {
                const int s = t - j * dil;
                if (s >= 0) {
                    const bf16_t* kr = p.proj + ((size_t)b * SEQ + s) * NPROJ + PA + 384 + head * 64 + hf;
                    const float x = dot32(q, kr) * 0.125f;
                    const float mn = fmaxf(mx, x), sc = expf(mx - mn), pw = expf(x - mn);
                    lsum = lsum * sc + pw; mx = mn;
                    axpy32(o, sc, pw, kr + 384);
                }
            }
        }
        store_row32(p.ybuf + tok * 896 + hp * 64 + hf, o, 1.f / lsum);
    }
}
__device__ __forceinline__ void phase_attn_c(const Params& p) {
    const int tid_ = otid(), lane = tid_ & 63, gw = blockIdx.x * NWV + (tid_ >> 6), nw = gridDim.x * NWV, hf = (lane & 1) * 32;
    for (int item = gw; item < 4 * 4 * 256; item += nw) {
        const int h = item & 3, blk = (item >> 2) & 255, b = item >> 10;
        const int t0 = blk * 32, t = t0 + (lane >> 1); const size_t tok = (size_t)b * SEQ + t;
        float q[32]; load_row32(q, p.proj + tok * NPROJ + PC + h * 64 + hf);
        float o[32]; zero32(o); float run = 0.f;
#pragma unroll 1
        for (int s = t0 + 30; s >= 0; --s) {
            if (s < t) {
                const bf16_t* kr = p.proj + ((size_t)b * SEQ + s) * NPROJ + PC + 256 + h * 64 + hf;
                const float z = dot32(q, kr) * 0.125f;
                const float lb = log_sigmoid(z);
                const float a = expf(lb + run);
                axpy32(o, 1.f, a, kr + 256);
                run += lb - z;
            }
            if (__all(run < -60.f)) break;
        }
        store_row32(p.ybuf + tok * 896 + 384 + h * 64 + hf, o, 1.f);
    }
}
typedef float f32x16 __attribute__((ext_vector_type(16)));
typedef short s16x4 __attribute__((ext_vector_type(4)));
constexpr int FK_PITCH = 72, FV_PITCH = 68;
__device__ __forceinline__ int crow16(int i, int hh) { return (i & 3) + 8 * (i >> 2) + 4 * hh; }
template <int KIND>
__device__ __forceinline__ void flash_unit(const Params& p, int b, int h, int qb, char* smem, int tid) {
    bf16_t* Ks = (bf16_t*)smem;
    bf16_t* Vt = Ks + 2 * 64 * FK_PITCH;
    float* ckl = (float*)(Vt + 2 * 64 * FV_PITCH);
    const int lane = tid & 63, w = tid >> 6, r = lane & 31, hh = lane >> 5;
    const int QOFF = KIND == 0 ? PD : PB, YOFF = KIND == 0 ? 640 : 128;
    const int q0 = qb * 256, qw0 = q0 + 32 * w, tq = qw0 + r;
    const size_t tokb = (size_t)b * SEQ, tok = tokb + tq;
    const float L2E = 1.44269504089f, C1 = 0.125f * 1.44269504089f;
    bf16x8 qf[4];
#pragma unroll
    for (int ks = 0; ks < 4; ++ks) qf[ks] = *(const bf16x8*)(p.proj + tok * NPROJ + QOFF + h * 64 + 16 * ks + 8 * hh);
    float cql = 0.f; if (KIND == 0) cql = p.cum[tok * 4 + h] * L2E;
    const unsigned* mrow = p.maskb + tok * 256;
    f32x16 o0, o1;
#pragma unroll
    for (int i = 0; i < 16; ++i) { o0[i] = 0.f; o1[i] = 0.f; }
    float mrun = -INFINITY, lrun = 0.f;
    const int ntiles = 4 * (qb + 1);
    const int skey = tid >> 3, sch = tid & 7;
    const bf16_t* kg = p.proj + (tokb + skey) * NPROJ + QOFF + 256 + h * 64 + sch * 8;
    uint4 kreg = *(const uint4*)kg, vreg = *(const uint4*)(kg + 256);
    float creg = 0.f; if (KIND == 0 && tid < 64) creg = p.cum[(tokb + tid) * 4 + h] * L2E;
    uint2 mreg = make_uint2(0u, 0u); if (KIND == 1) mreg = *(const uint2*)(mrow);
#pragma unroll 1
    for (int j = 0; j < ntiles; ++j) {
        const int buf = j & 1;
        bf16_t* ksb = Ks + buf * 64 * FK_PITCH; bf16_t* vtb = Vt + buf * 64 * FV_PITCH; float* cb = ckl + buf * 64;
        *(uint4*)&ksb[skey * FK_PITCH + sch * 8] = kreg;
        {
            bf16_t* vd = vtb + (sch * 8) * FV_PITCH + skey;
            vd[0 * FV_PITCH] = (bf16_t)(vreg.x & 0xffffu); vd[1 * FV_PITCH] = (bf16_t)(vreg.x >> 16);
            vd[2 * FV_PITCH] = (bf16_t)(vreg.y & 0xffffu); vd[3 * FV_PITCH] = (bf16_t)(vreg.y >> 16);
            vd[4 * FV_PITCH] = (bf16_t)(vreg.z & 0xffffu); vd[5 * FV_PITCH] = (bf16_t)(vreg.z >> 16);
            vd[6 * FV_PITCH] = (bf16_t)(vreg.w & 0xffffu); vd[7 * FV_PITCH] = (bf16_t)(vreg.w >> 16);
        }
        if (KIND == 0 && tid < 64) cb[tid] = creg;
        const uint2 mw = mreg;
        __syncthreads();
        if (j + 1 < ntiles) {
            const bf16_t* kn = kg + (size_t)(j + 1) * 64 * NPROJ;
            kreg = *(const uint4*)kn; vreg = *(const uint4*)(kn + 256);
            if (KIND == 0 && tid < 64) creg = p.cum[(tokb + (j + 1) * 64 + tid) * 4 + h] * L2E;
            if (KIND == 1) mreg = *(const uint2*)(mrow + 2 * (j + 1));
        }
#pragma unroll
        for (int sub = 0; sub < 2; ++sub) {
            const int kb = 64 * j + 32 * sub;
            if (kb > qw0 + 31) continue;
            f32x16 x;
#pragma unroll
            for (int i = 0; i < 16; ++i) x[i] = 0.f;
#pragma unroll
            for (int ks = 0; ks < 4; ++ks) {
                const bf16x8 a = *(const bf16x8*)&ksb[(32 * sub + r) * FK_PITCH + 16 * ks + 8 * hh];
                x = __builtin_amdgcn_mfma_f32_32x32x16_bf16(a, qf[ks], x, 0, 0, 0);
            }
            float mt = -INFINITY;
            if (KIND == 0) {
                const bool diag = kb + 31 > qw0;
#pragma unroll
                for (int g = 0; g < 4; ++g) {
                    const f32x4 ck = *(const f32x4*)&cb[32 * sub + 8 * g + 4 * hh];
#pragma unroll
                    for (int e = 0; e < 4; ++e) {
                        float s = fmaf(x[4 * g + e], C1, cql - ck[e]);
                        if (diag && (kb + 8 * g + 4 * hh + e > tq)) s = -INFINITY;
                        x[4 * g + e] = s; mt = fmaxf(mt, s);
                    }
                }
            } else {
                const unsigned wbits = sub == 0 ? mw.x : mw.y;
#pragma unroll
                for (int i = 0; i < 16; ++i) {
                    float s = x[i] * C1;
                    if (!((wbits >> crow16(i, hh)) & 1u)) s = -INFINITY;
                    x[i] = s; mt = fmaxf(mt, s);
                }
            }
            mt = fmaxf(mt, __shfl_xor(mt, 32));
            const float mnew = fmaxf(mrun, mt), msafe = (mnew == -INFINITY) ? 0.f : mnew;
            const float alpha = __builtin_amdgcn_exp2f(mrun - msafe);
            float ps = 0.f;
#pragma unroll
            for (int i = 0; i < 16; ++i) { const float e = __builtin_amdgcn_exp2f(x[i] - msafe); x[i] = e; ps += e; }
            lrun = lrun * alpha + ps; mrun = mnew;
#pragma unroll
            for (int i = 0; i < 16; ++i) { o0[i] *= alpha; o1[i] *= alpha; }
            bf16x8 pf[2];
#pragma unroll
            for (int s = 0; s < 2; ++s) {
                unsigned pk[4];
#pragma unroll
                for (int e = 0; e < 4; ++e) pk[e] = (unsigned)f2bf(x[8 * s + 2 * e]) | ((unsigned)f2bf(x[8 * s + 2 * e + 1]) << 16);
                pf[s] = __builtin_bit_cast(bf16x8, (uint4){pk[0], pk[1], pk[2], pk[3]});
            }
#pragma unroll
            for (int s = 0; s < 2; ++s) {
#pragma unroll
                for (int dt = 0; dt < 2; ++dt) {
                    const bf16_t* vp = vtb + (32 * dt + r) * FV_PITCH + 32 * sub + 16 * s + 4 * hh;
                    const s16x4 lo = *(const s16x4*)vp, hi = *(const s16x4*)(vp + 8);
                    const bf16x8 vf = __builtin_shufflevector(lo, hi, 0, 1, 2, 3, 4, 5, 6, 7);
                    if (dt == 0) o0 = __builtin_amdgcn_mfma_f32_32x32x16_bf16(vf, pf[s], o0, 0, 0, 0);
                    else o1 = __builtin_amdgcn_mfma_f32_32x32x16_bf16(vf, pf[s], o1, 0, 0, 0);
                }
            }
        }
    }
    const float ltot = lrun + __shfl_xor(lrun, 32), inv = 1.f / ltot;
    bf16_t* yo = p.ybuf + tok * 896 + YOFF + h * 64;
#pragma unroll
    for (int g = 0; g < 4; ++g) {
        uint2 w0, w1;
        w0.x = (unsigned)f2bf(o0[4 * g] * inv) | ((unsigned)f2bf(o0[4 * g + 1] * inv) << 16); w0.y = (unsigned)f2bf(o0[4 * g + 2] * inv) | ((unsigned)f2bf(o0[4 * g + 3] * inv) << 16);
        w1.x = (unsigned)f2bf(o1[4 * g] * inv) | ((unsigned)f2bf(o1[4 * g + 1] * inv) << 16); w1.y = (unsigned)f2bf(o1[4 * g + 2] * inv) | ((unsigned)f2bf(o1[4 * g + 3] * inv) << 16);
        *(uint2*)(yo + 8 * g + 4 * hh) = w0; *(uint2*)(yo + 32 + 8 * g + 4 * hh) = w1;
    }
}
__device__ __forceinline__ void phase_flash(const Params& p, char* smem) {
    const int tid = otid();
    for (int it = blockIdx.x; it < 512; it += gridDim.x) {
        const int kind = it >> 8, c = it & 255, bh = c & 15, qs = c >> 4;
#pragma unroll 1
        for (int half = 0; half < 2; ++half) {
            const int qb = half ? 31 - qs : qs;
            __syncthreads();
            if (kind == 0) flash_unit<0>(p, bh >> 2, bh & 3, qb, smem, tid); else flash_unit<1>(p, bh >> 2, bh & 3, qb, smem, tid);
        }
    }
}
__device__ __forceinline__ void phase_scan(const Params& p, char* smem) {
    double* part = (double*)smem;
    const int tid = otid();
    for (int item = blockIdx.x; item < 16; item += gridDim.x) {
        const int b = item >> 2, h = item & 3;
        const float* lf = p.logf + ((size_t)b * SEQ + tid * 16) * 4 + h;
        double s = 0.0;
        for (int i = 0; i < 16; ++i) s += (double)lf[i * 4];
        __syncthreads();
        part[tid] = s;
        __syncthreads();
        if (tid == 0) { double r = 0.0; for (int i = 0; i < NTHR; ++i) { const double v = part[i]; part[i] = r; r += v; } }
        __syncthreads();
        double r = part[tid];
        float* cm = p.cum + ((size_t)b * SEQ + tid * 16) * 4 + h;
        for (int i = 0; i < 16; ++i) { r += (double)lf[i * 4]; cm[i * 4] = (float)r; }
    }
}
__device__ __forceinline__ unsigned f2key(float f) { const unsigned u = __float_as_uint(f); return (u & 0x80000000u) ? ~u : (u | 0x80000000u); }
constexpr int HPITCH = 1028;
template <int PASS>
__device__ __forceinline__ void idx_pass(const Params& p, size_t tokb, int t0, int ktmax, const bf16x8 (&qf)[4][4], float w0, float w1, float w2, float w3,
                                         unsigned* hist, const unsigned* qpre, unsigned* gtb, unsigned* eqb, int lane, int w) {
    const int r = lane & 31, hh = lane >> 5, tq = t0 + r;
    unsigned pre = 0u; if (PASS >= 1) pre = qpre[r];
    unsigned* hrow = hist + r * HPITCH;
    const bf16_t* kbase = p.proj + (tokb + r) * NPROJ + PIK + 8 * hh;
    uint4 an[4];
    if (w <= ktmax) {
#pragma unroll
        for (int ks = 0; ks < 4; ++ks) an[ks] = *(const uint4*)(kbase + (size_t)w * 32 * NPROJ + 16 * ks);
    }
#pragma unroll 1
    for (int kt = w; kt <= ktmax; kt += 8) {
        bf16x8 a[4];
#pragma unroll
        for (int ks = 0; ks < 4; ++ks) a[ks] = __builtin_bit_cast(bf16x8, an[ks]);
        if (kt + 8 <= ktmax) {
#pragma unroll
            for (int ks = 0; ks < 4; ++ks) an[ks] = *(const uint4*)(kbase + (size_t)(kt + 8) * 32 * NPROJ + 16 * ks);
        }
        f32x16 x0, x1, x2, x3;
#pragma unroll
        for (int i = 0; i < 16; ++i) { x0[i] = 0.f; x1[i] = 0.f; x2[i] = 0.f; x3[i] = 0.f; }
#pragma unroll
        for (int ks = 0; ks < 4; ++ks) {
            x0 = __builtin_amdgcn_mfma_f32_32x32x16_bf16(a[ks], qf[0][ks], x0, 0, 0, 0);
            x1 = __builtin_amdgcn_mfma_f32_32x32x16_bf16(a[ks], qf[1][ks], x1, 0, 0, 0);
            x2 = __builtin_amdgcn_mfma_f32_32x32x16_bf16(a[ks], qf[2][ks], x2, 0, 0, 0);
            x3 = __builtin_amdgcn_mfma_f32_32x32x16_bf16(a[ks], qf[3][ks], x3, 0, 0, 0);
        }
        const int kb = kt * 32;
        const bool diag = (kt == ktmax);
        unsigned gw = 0u, ew = 0u;
#pragma unroll
        for (int i = 0; i < 16; ++i) {
            float v = w0 * fmaxf(x0[i], 0.f);
            v = fmaf(w1, fmaxf(x1[i], 0.f), v); v = fmaf(w2, fmaxf(x2[i], 0.f), v); v = fmaf(w3, fmaxf(x3[i], 0.f), v);
            v += 0.0f;
            const unsigned key = f2key(v);
            const int kr = crow16(i, hh);
            const bool valid = !diag || (kb + kr <= tq);
            if (PASS == 0) { if (valid) { const unsigned d = key >> 21; atomicAdd(&hrow[d >> 1], (d & 1u) ? 65536u : 1u); } }
            if (PASS == 1) { if (valid && (key >> 21) == pre) { const unsigned d = (key >> 10) & 2047u; atomicAdd(&hrow[d >> 1], (d & 1u) ? 65536u : 1u); } }
            if (PASS == 2) { if (valid && (key >> 10) == pre) { const unsigned d = key & 1023u; atomicAdd(&hrow[d >> 1], (d & 1u) ? 65536u : 1u); } }
            if (PASS == 3) { gw |= ((valid && key > pre) ? 1u : 0u) << kr; ew |= ((valid && key == pre) ? 1u : 0u) << kr; }
        }
        if (PASS == 3) {
            gw |= __shfl_xor(gw, 32); ew |= __shfl_xor(ew, 32);
            if (hh == 0) { gtb[r * 256 + kt] = gw; eqb[r * 256 + kt] = ew; }
        }
    }
}
__device__ __forceinline__ void idx_search(const unsigned* hist, unsigned* qpre, unsigned* qneed, int shift, int lane, int w) {
#pragma unroll 1
    for (int qi = 0; qi < 4; ++qi) {
        const int q = 4 * w + qi;
        const unsigned need = qneed[q];
        const uint4* hr = (const uint4*)(hist + q * HPITCH + 16 * lane);
        unsigned wr[16];
#pragma unroll
        for (int c = 0; c < 4; ++c) { const uint4 v = hr[c]; wr[4 * c] = v.x; wr[4 * c + 1] = v.y; wr[4 * c + 2] = v.z; wr[4 * c + 3] = v.w; }
        unsigned mine = 0u;
#pragma unroll
        for (int c = 0; c < 16; ++c) mine += (wr[c] & 0xffffu) + (wr[c] >> 16);
        unsigned tot = mine;
#pragma unroll
        for (int o = 1; o < 64; o <<= 1) { const unsigned v = __shfl_down(tot, o); if (lane + o < 64) tot += v; }
        const unsigned excl = tot - mine;
        if (excl < need && tot >= need) {
            unsigned cum = excl, nrem = 0u; int dsel = -1;
#pragma unroll
            for (int c = 15; c >= 0; --c) {
                const unsigned hi = wr[c] >> 16, lo = wr[c] & 0xffffu;
                if (dsel < 0) { if (cum + hi >= need) { dsel = 2 * (16 * lane + c) + 1; nrem = need - cum; } else cum += hi; }
                if (dsel < 0) { if (cum + lo >= need) { dsel = 2 * (16 * lane + c); nrem = need - cum; } else cum += lo; }
            }
            qpre[q] = (qpre[q] << shift) | (unsigned)dsel; qneed[q] = nrem;
        }
    }
}
__device__ __forceinline__ void phase_topk(const Params& p, char* smem) {
    unsigned* hist = (unsigned*)smem;
    unsigned* gtb = hist;
    unsigned* eqb = hist + 32 * 256;
    unsigned* qpre = hist + 32 * HPITCH;
    unsigned* qneed = qpre + 32;
    const int tid = otid(), lane = tid & 63, w = tid >> 6;
    for (int it = blockIdx.x; it < 256; it += gridDim.x) {
#pragma unroll 1
        for (int sub = 0; sub < 4; ++sub) {
            const int u = sub == 0 ? it : (sub == 1 ? 511 - it : (sub == 2 ? 512 + it : 1023 - it));
            const int b = u & 3, blk = u >> 2, t0 = blk * 32;
            const size_t tokb = (size_t)b * SEQ;
            if (t0 + 32 <= 256) {
                for (int i = tid; i < 32 * 256; i += NTHR) {
                    const int q = i >> 8, k = i & 255, n = t0 + q + 1, lo = k * 32;
                    p.maskb[(tokb + t0 + q) * 256 + k] = (lo + 32 <= n) ? 0xffffffffu : (lo >= n ? 0u : ((1u << (n - lo)) - 1u));
                }
                continue;
            }
            const int r = lane & 31, hh = lane >> 5;
            const size_t tok = tokb + t0 + r;
            bf16x8 qf[4][4];
#pragma unroll
            for (int h = 0; h < 4; ++h)
#pragma unroll
                for (int ks = 0; ks < 4; ++ks) qf[h][ks] = *(const bf16x8*)(p.proj + tok * NPROJ + PIQ + h * 64 + 16 * ks + 8 * hh);
            const f32x4 wv = *(const f32x4*)(p.iw + tok * 4);
            const int ktmax = blk;
            __syncthreads();
            if (tid < 32) { qpre[tid] = 0u; qneed[tid] = 256u; }
#pragma unroll 1
            for (int pass = 0; pass < 3; ++pass) {
                for (int i = tid; i < 32 * HPITCH / 4; i += NTHR) ((uint4*)hist)[i] = make_uint4(0u, 0u, 0u, 0u);
                __syncthreads();
                if (pass == 0) idx_pass<0>(p, tokb, t0, ktmax, qf, wv[0], wv[1], wv[2], wv[3], hist, qpre, gtb, eqb, lane, w);
                else if (pass == 1) idx_pass<1>(p, tokb, t0, ktmax, qf, wv[0], wv[1], wv[2], wv[3], hist, qpre, gtb, eqb, lane, w);
                else idx_pass<2>(p, tokb, t0, ktmax, qf, wv[0], wv[1], wv[2], wv[3], hist, qpre, gtb, eqb, lane, w);
                __syncthreads();
                idx_search(hist, qpre, qneed, pass == 2 ? 10 : 11, lane, w);
                __syncthreads();
            }
            for (int i = tid; i < 2 * 32 * 256 / 4; i += NTHR) ((uint4*)hist)[i] = make_uint4(0u, 0u, 0u, 0u);
            __syncthreads();
            idx_pass<3>(p, tokb, t0, ktmax, qf, wv[0], wv[1], wv[2], wv[3], hist, qpre, gtb, eqb, lane, w);
            __syncthreads();
#pragma unroll 1
            for (int qi = 0; qi < 4; ++qi) {
                const int q = 4 * w + qi; const unsigned rr = qneed[q];
                const uint4 g4 = *(const uint4*)&gtb[q * 256 + 4 * lane]; const uint4 e4 = *(const uint4*)&eqb[q * 256 + 4 * lane];
                unsigned ev[4] = {e4.x, e4.y, e4.z, e4.w}, gv[4] = {g4.x, g4.y, g4.z, g4.w};
                const unsigned mine = __popc(ev[0]) + __popc(ev[1]) + __popc(ev[2]) + __popc(ev[3]);
                unsigned incl = mine;
#pragma unroll
                for (int o = 1; o < 64; o <<= 1) { const unsigned v = __shfl_up(incl, o); if (lane >= o) incl += v; }
                unsigned rank = incl - mine;
#pragma unroll
                for (int c = 0; c < 4; ++c) {
                    unsigned e = ev[c]; const unsigned pc = __popc(e);
                    if (rank + pc > rr) {
                        unsigned keep = rank < rr ? rr - rank : 0u, sel = 0u;
                        while (keep > 0u) { const unsigned low = e & (0u - e); sel |= low; e ^= low; --keep; }
                        e = sel;
                    }
                    gv[c] |= e; rank += pc;
                }
                *(uint4*)&p.maskb[(tokb + t0 + q) * 256 + 4 * lane] = make_uint4(gv[0], gv[1], gv[2], gv[3]);
            }
        }
    }
}

namespace pg8 {
#define PG8_LAS __attribute__((address_space(3)))
typedef unsigned short bf16_t;
typedef short bf16x8 __attribute__((ext_vector_type(8)));
typedef float f32x4 __attribute__((ext_vector_type(4)));
typedef unsigned u32x4 __attribute__((ext_vector_type(4)));
constexpr int BM = 256, BK = 64, HALF = 128, HTB = HALF * BK * 2  , STAGE_BYTES = 8 * HTB, NXCD = 8, WGM = 8;

__host__ __device__ __forceinline__ int lds_byte(int r, int c) { const int st = (r >> 4) * 2 + (c >> 5), rr = r & 15, cc = c & 31, ob = rr * 64 + cc * 2; return st * 1024 + (ob ^ (((ob >> 9) & 1) << 5)); }
__host__ __device__ __forceinline__ void stage_rc(int b, int& R, int& C) { const int st = b / 1024, sb = b % 1024, swz = sb ^ (((sb >> 9) & 1) << 5); R = (st >> 1) * 16 + swz / 64; C = (st & 1) * 32 + (swz % 64) / 2; }
__host__ __device__ __forceinline__ int perm32(int rho) { const int n = rho >> 4, i = rho & 15; return 8 * (i >> 2) + 4 * n + (i & 3); }

struct Unit { int pm, pn; };
struct Gemm { const bf16_t* A; const bf16_t* Bt; int M, N, K; };

struct StaticOrder {
    int nM, nN, nwg, G, c;
    __host__ __device__ void init(int M, int N, int G_, int c_) { nM = M / BM; nN = N / BM; nwg = nM * nN; G = G_; c = c_; }
    __host__ __device__ bool next(int i, Unit& u) const {
        const long L = (long)i * G + c; if (L >= nwg) return false;
        int wgid = (int)L; { const int q = nwg / NXCD, r = nwg % NXCD, xcd = wgid % NXCD, off = wgid / NXCD; wgid = (xcd < r ? xcd * (q + 1) : r * (q + 1) + (xcd - r) * q) + off; }
        const int nig = WGM * nN, gid = wgid / nig, fm = gid * WGM, gsz = (nM - fm) < WGM ? (nM - fm) : WGM;
        u.pm = fm + ((wgid % nig) % gsz); u.pn = (wgid % nig) / gsz; return true;
    }
    __device__ __forceinline__ void a_ready(const Unit&) const {}
    __device__ __forceinline__ void done(const Unit&) const {}
};

__device__ __forceinline__ unsigned cvt_pk_bf16(float lo, float hi) { unsigned r; asm volatile("v_cvt_pk_bf16_f32 %0, %1, %2" : "=v"(r) : "v"(lo), "v"(hi)); return r; }
__device__ __forceinline__ float silu_f(float g) { return g / (1.f + __expf(-g)); }
struct EpiSwiGLU {
    static constexpr bool PERM = true, AFTER_DRAIN = false;
    bf16_t* O;
    __device__ __forceinline__ void operator()(const f32x4 (&acc)[2][2][4][2], const Unit& u, int wr, int wc, int fr, int fq) const {
        const int row0 = u.pm * BM + wr * 64 + fr, col0 = u.pn * 128 + wc * 32 + 8 * fq;
#pragma unroll
        for (int ai = 0; ai < 2; ++ai)
#pragma unroll
            for (int m = 0; m < 4; ++m) {
                bf16_t* rowp = O + (size_t)(row0 + ai * HALF + m * 16) * 2816 + col0;
                const f32x4 g0 = acc[ai][0][m][0], g1 = acc[ai][0][m][1], u0 = acc[ai][1][m][0], u1 = acc[ai][1][m][1];
                u32x4 w;
                w.x = cvt_pk_bf16(silu_f(g0[0]) * u0[0], silu_f(g0[1]) * u0[1]); w.y = cvt_pk_bf16(silu_f(g0[2]) * u0[2], silu_f(g0[3]) * u0[3]);
                w.z = cvt_pk_bf16(silu_f(g1[0]) * u1[0], silu_f(g1[1]) * u1[1]); w.w = cvt_pk_bf16(silu_f(g1[2]) * u1[2], silu_f(g1[3]) * u1[3]);
                *(u32x4*)rowp = w;
            }
    }
};
struct EpiRes {
    static constexpr bool PERM = false, AFTER_DRAIN = false;
    const float* xres; float* out; const float* modl; int sub; float fac;
    __device__ __forceinline__ void operator()(const f32x4 (&acc)[2][2][4][2], const Unit& u, int wr, int wc, int fr, int fq) const {
        const int b = (u.pm * BM) >> 13;
        const float* gate = modl + (size_t)b * 9216 + sub * 3072 + 2048;
        const int col0 = u.pn * BM + wc * 32 + 4 * fq;
#pragma unroll
        for (int bj = 0; bj < 2; ++bj)
#pragma unroll
            for (int n = 0; n < 2; ++n) {
                const int col = col0 + bj * HALF + n * 16;
                f32x4 gm = *(const f32x4*)(gate + col); gm = (gm + 1.0f) * fac;
#pragma unroll
                for (int ai = 0; ai < 2; ++ai)
#pragma unroll
                    for (int m = 0; m < 4; ++m) {
                        const size_t off = (size_t)(u.pm * BM + ai * HALF + wr * 64 + m * 16 + fr) * 1024 + col;
                        const f32x4 xr = *(const f32x4*)(xres + off);
                        *(f32x4*)(out + off) = xr * 1.41421356237f + gm * acc[ai][bj][m][n];
                    }
            }
    }
};
struct EpiInproj {
    static constexpr bool PERM = true, AFTER_DRAIN = false;
    bf16_t* proj; const float* rope; float* iw; float* logf; const float* bfg;
    __device__ __forceinline__ void operator()(const f32x4 (&acc)[2][2][4][2], const Unit& u, int wr, int wc, int fr, int fq) const {
#pragma unroll
        for (int bj = 0; bj < 2; ++bj) {
            const int cb32 = u.pn * BM + bj * HALF + wc * 32;
            const bool rp = ((cb32 & 63) == 0) && (cb32 < 768 || (cb32 >= 1152 && cb32 < 1664) || (cb32 >= 1920 && cb32 < 2240));
#pragma unroll
            for (int ai = 0; ai < 2; ++ai)
#pragma unroll
                for (int m = 0; m < 4; ++m) {
                    const int row = u.pm * BM + ai * HALF + wr * 64 + m * 16 + fr;
                    f32x4 v0 = acc[ai][bj][m][0], v1 = acc[ai][bj][m][1];
                    if (rp) {
                        const int t = row & 8191;
                        const f32x4* rt = (const f32x4*)(rope + (size_t)t * 16);
                        const f32x4 r0 = rt[0], r1 = rt[1], r2 = rt[2], r3 = rt[3];
                        f32x4 p0, p1;
#pragma unroll
                        for (int j = 0; j < 4; ++j) { p0[j] = __shfl_xor(v0[j], 16); p1[j] = __shfl_xor(v1[j], 16); }
                        if (fq == 0) {
                            v0[0] = v0[0] * r0[0] - p0[0] * r0[1]; v0[1] = v0[1] * r0[2] - p0[1] * r0[3]; v0[2] = v0[2] * r1[0] - p0[2] * r1[1]; v0[3] = v0[3] * r1[2] - p0[3] * r1[3];
                            v1[0] = v1[0] * r2[0] - p1[0] * r2[1]; v1[1] = v1[1] * r2[2] - p1[1] * r2[3]; v1[2] = v1[2] * r3[0] - p1[2] * r3[1]; v1[3] = v1[3] * r3[2] - p1[3] * r3[3];
                        } else if (fq == 1) {
                            v0[0] = v0[0] * r0[0] + p0[0] * r0[1]; v0[1] = v0[1] * r0[2] + p0[1] * r0[3]; v0[2] = v0[2] * r1[0] + p0[2] * r1[1]; v0[3] = v0[3] * r1[2] + p0[3] * r1[3];
                            v1[0] = v1[0] * r2[0] + p1[0] * r2[1]; v1[1] = v1[1] * r2[2] + p1[1] * r2[3]; v1[2] = v1[2] * r3[0] + p1[2] * r3[1]; v1[3] = v1[3] * r3[2] + p1[3] * r3[3];
                        }
                    }
                    u32x4 w; w.x = cvt_pk_bf16(v0[0], v0[1]); w.y = cvt_pk_bf16(v0[2], v0[3]); w.z = cvt_pk_bf16(v1[0], v1[1]); w.w = cvt_pk_bf16(v1[2], v1[3]);
                    *(u32x4*)(proj + (size_t)row * 3840 + cb32 + 8 * fq) = w;
                    if (cb32 == 3776 && fq == 0) {
                        *(f32x4*)(iw + (size_t)row * 4) = v0;
                        f32x4 lf;
#pragma unroll
                        for (int j = 0; j < 4; ++j) { const float xx = v1[j] + bfg[j]; lf[j] = fminf(xx, 0.f) - log1pf(expf(-fabsf(xx))); }
                        *(f32x4*)(logf + (size_t)row * 4) = lf;
                    }
                }
        }
    }
};
template <class Epi, class Sched, bool ALIGN_EPI = false, bool SP2 = false>
__device__ __forceinline__ void gemm_phase(PG8_LAS unsigned char* lds, const Gemm g, const Sched& S, const Epi& E) {
    int tid_ = threadIdx.x; asm volatile("" : "+v"(tid_));
    const int tid = tid_, wid = __builtin_amdgcn_readfirstlane(tid >> 6), lane = tid & 63, wr = wid >> 2, wc = wid & 3, fr = lane & 15, fq = lane >> 4;
    const int K = g.K, nt = K / BK;
    unsigned voffA[2], voffB[2];
#pragma unroll
    for (int i = 0; i < 2; ++i) { int R, C; stage_rc(tid * 16 + i * 8192, R, C); const int Rb = Epi::PERM ? ((R & ~31) + perm32(R & 31)) : R;
        voffA[i] = (unsigned)(R * K + C) * 2u; voffB[i] = (unsigned)(Rb * K + C) * 2u; }
    const size_t kstep = (size_t)(BK * 2);
    const size_t hstep = (size_t)HALF * K * 2;
    const size_t tstep = 2 * hstep;
    const unsigned ldsw = (unsigned)wid * 1024u;
    const int aoff = lds_byte(wr * 64 + fr, fq * 8), boff = lds_byte(wc * 32 + fr, fq * 8);
#define PG8_SA(b, h) (((b) * 2 + (h)) * HTB)
#define PG8_SB(b, h) ((4 + (b) * 2 + (h)) * HTB)
#define PG8_STAGE(bufoff, gbase, voff) do { _Pragma("unroll") for (int _i = 0; _i < 2; ++_i) \
        __builtin_amdgcn_global_load_lds((const unsigned*)((const char*)(gbase) + (voff)[_i]), (PG8_LAS unsigned*)(lds + (bufoff) + ldsw + _i * 8192), 16, 0, 0); } while (0)
#define PG8_LDA(dst, b, h) do { _Pragma("unroll") for (int m = 0; m < 4; ++m) _Pragma("unroll") for (int k = 0; k < 2; ++k) dst[m][k] = *(const PG8_LAS bf16x8*)(lds + PG8_SA(b, h) + aoff + m * 2048 + k * 1024); } while (0)
#define PG8_LDB(dst, b, h) do { _Pragma("unroll") for (int n = 0; n < 2; ++n) _Pragma("unroll") for (int k = 0; k < 2; ++k) dst[n][k] = *(const PG8_LAS bf16x8*)(lds + PG8_SB(b, h) + boff + n * 2048 + k * 1024); } while (0)
#define PG8_MMA(ai, bj, At, Bt) do { __builtin_amdgcn_s_setprio(1); _Pragma("unroll") for (int m = 0; m < 4; ++m) _Pragma("unroll") for (int n = 0; n < 2; ++n) _Pragma("unroll") for (int k = 0; k < 2; ++k) \
        acc[ai][bj][m][n] = __builtin_amdgcn_mfma_f32_16x16x32_bf16(Bt[n][k], At[m][k], acc[ai][bj][m][n], 0, 0, 0); __builtin_amdgcn_s_setprio(0); } while (0)
#define PG8_WAIT_V(n) asm volatile("s_waitcnt vmcnt(" #n ")" ::: "memory")
#define PG8_WAIT_L(n) asm volatile("s_waitcnt lgkmcnt(" #n ")" ::: "memory")
#define PG8_BAR __builtin_amdgcn_s_barrier()
#define PG8_SCHED __builtin_amdgcn_sched_barrier(0)
    Unit cur, nxt; int ui = 0;
    if (!S.next(0, cur)) return;
    f32x4 acc[2][2][4][2];
#pragma unroll
    for (int a = 0; a < 2; ++a)
#pragma unroll
        for (int b = 0; b < 2; ++b)
#pragma unroll
            for (int m = 0; m < 4; ++m)
#pragma unroll
                for (int n = 0; n < 2; ++n) acc[a][b][m][n] = (f32x4){0.f, 0.f, 0.f, 0.f};
    bf16x8 At[4][2], B0[2][2], B1[2][2];
    const char* cA = (const char*)g.A + (size_t)cur.pm * tstep; const char* cB = (const char*)g.Bt + (size_t)cur.pn * tstep;
    S.a_ready(cur);
    if constexpr (SP2) {
        PG8_STAGE(PG8_SB(0, 0), cB, voffB); PG8_STAGE(PG8_SB(0, 1), cB + hstep, voffB); PG8_STAGE(PG8_SA(0, 0), cA, voffA); PG8_STAGE(PG8_SA(0, 1), cA + hstep, voffA);
        if (wr == 1) PG8_BAR;
        PG8_WAIT_V(2); PG8_BAR;
        PG8_STAGE(PG8_SB(1, 0), cB + kstep, voffB); PG8_STAGE(PG8_SA(1, 0), cA + kstep, voffA); PG8_STAGE(PG8_SB(1, 1), cB + hstep + kstep, voffB);
        PG8_WAIT_V(6); PG8_BAR;
    } else {
        PG8_STAGE(PG8_SB(0, 0), cB, voffB); PG8_STAGE(PG8_SA(0, 0), cA, voffA); PG8_STAGE(PG8_SB(0, 1), cB + hstep, voffB); PG8_STAGE(PG8_SA(0, 1), cA + hstep, voffA);
        if (wr == 1) PG8_BAR;
        PG8_WAIT_V(4); PG8_BAR;
        PG8_STAGE(PG8_SB(1, 0), cB + kstep, voffB); PG8_STAGE(PG8_SA(1, 0), cA + kstep, voffA); PG8_STAGE(PG8_SB(1, 1), cB + hstep + kstep, voffB);
        PG8_WAIT_V(6); PG8_BAR;
    }
    for (;;) {
        const bool has_next = S.next(ui + 1, nxt);
        const char* nA = has_next ? (const char*)g.A + (size_t)nxt.pm * tstep : cA; const char* nB = has_next ? (const char*)g.Bt + (size_t)nxt.pn * tstep : cB;
        for (int t = 0; t < nt; t += 2) {
            const bool last = (t == nt - 2);
            const char* a1 = cA + (size_t)(t + 1) * kstep;
            const char* a2 = last ? nA : cA + (size_t)(t + 2) * kstep; const char* b2 = last ? nB : cB + (size_t)(t + 2) * kstep;
            const char* a3 = a2 + kstep; const char* b3 = b2 + kstep;
            if (last && has_next) S.a_ready(nxt);
            if constexpr (SP2) {
            PG8_LDB(B0, 0, 0); PG8_LDB(B1, 0, 1); PG8_SCHED; PG8_LDA(At, 0, 0); PG8_STAGE(PG8_SA(1, 1), a1 + hstep, voffA);
            PG8_WAIT_V(8); PG8_WAIT_L(0); PG8_BAR; PG8_MMA(0, 0, At, B0); PG8_MMA(0, 1, At, B1); PG8_BAR; PG8_SCHED;
            PG8_LDA(At, 0, 1); PG8_STAGE(PG8_SB(0, 0), b2, voffB); PG8_STAGE(PG8_SB(0, 1), b2 + hstep, voffB); PG8_STAGE(PG8_SA(0, 0), a2, voffA);
            PG8_WAIT_V(8); PG8_WAIT_L(0); PG8_BAR; PG8_MMA(1, 0, At, B0); PG8_MMA(1, 1, At, B1); PG8_BAR; PG8_SCHED;
            PG8_LDB(B0, 1, 0); PG8_LDB(B1, 1, 1); PG8_SCHED; PG8_LDA(At, 1, 0); PG8_STAGE(PG8_SA(0, 1), a2 + hstep, voffA);
            PG8_WAIT_V(8); PG8_WAIT_L(0); PG8_BAR; PG8_MMA(0, 0, At, B0); PG8_MMA(0, 1, At, B1); PG8_BAR; PG8_SCHED;
            PG8_LDA(At, 1, 1); PG8_STAGE(PG8_SB(1, 0), b3, voffB); PG8_STAGE(PG8_SB(1, 1), b3 + hstep, voffB); PG8_STAGE(PG8_SA(1, 0), a3, voffA);
            PG8_WAIT_V(8); PG8_WAIT_L(0); PG8_BAR; PG8_MMA(1, 0, At, B0); PG8_MMA(1, 1, At, B1); PG8_BAR; PG8_SCHED;
            } else {
            PG8_LDB(B0, 0, 0); PG8_SCHED; PG8_LDA(At, 0, 0); PG8_STAGE(PG8_SA(1, 1), a1 + hstep, voffA);
            PG8_WAIT_L(8); PG8_BAR; PG8_WAIT_L(0); PG8_MMA(0, 0, At, B0); PG8_BAR; PG8_SCHED;
            PG8_LDB(B1, 0, 1); PG8_STAGE(PG8_SB(0, 0), b2, voffB);
            PG8_BAR; PG8_WAIT_L(0); PG8_MMA(0, 1, At, B1); PG8_BAR;
            PG8_LDA(At, 0, 1); PG8_STAGE(PG8_SA(0, 0), a2, voffA);
            PG8_BAR; PG8_WAIT_L(0); PG8_MMA(1, 0, At, B0); PG8_BAR; PG8_SCHED;
            PG8_STAGE(PG8_SB(0, 1), b2 + hstep, voffB);
            PG8_WAIT_V(6); PG8_BAR; PG8_MMA(1, 1, At, B1); PG8_BAR;
            PG8_LDB(B0, 1, 0); PG8_SCHED; PG8_LDA(At, 1, 0); PG8_STAGE(PG8_SA(0, 1), a2 + hstep, voffA);
            PG8_WAIT_L(8); PG8_BAR; PG8_WAIT_L(0); PG8_MMA(0, 0, At, B0); PG8_BAR; PG8_SCHED;
            PG8_LDB(B1, 1, 1); PG8_STAGE(PG8_SB(1, 0), b3, voffB);
            PG8_BAR; PG8_WAIT_L(0); PG8_MMA(0, 1, At, B1); PG8_BAR;
            PG8_LDA(At, 1, 1); PG8_STAGE(PG8_SA(1, 0), a3, voffA);
            PG8_BAR; PG8_WAIT_L(0); PG8_MMA(1, 0, At, B0); PG8_BAR; PG8_SCHED;
            PG8_STAGE(PG8_SB(1, 1), b3 + hstep, voffB);
            PG8_WAIT_V(6); PG8_BAR; PG8_MMA(1, 1, At, B1); PG8_BAR;
            }
        }
        if constexpr (ALIGN_EPI) { if (wr == 0) PG8_BAR; }
        if constexpr (!Epi::AFTER_DRAIN) { E(acc, cur, wr, wc, fr, fq); S.done(cur); }
        if (!has_next) break;
#pragma unroll
        for (int a = 0; a < 2; ++a)
#pragma unroll
            for (int b = 0; b < 2; ++b)
#pragma unroll
                for (int m = 0; m < 4; ++m)
#pragma unroll
                    for (int n = 0; n < 2; ++n) acc[a][b][m][n] = (f32x4){0.f, 0.f, 0.f, 0.f};
        cur = nxt; cA = nA; cB = nB; ++ui;
        if constexpr (ALIGN_EPI) { if (wr == 1) PG8_BAR; }
    }
    PG8_WAIT_V(0);
    if constexpr (!ALIGN_EPI) { if (wr == 0) PG8_BAR; }
    PG8_BAR;
    if constexpr (Epi::AFTER_DRAIN) { E.fused(acc, cur, wr, wc, fr, fq, lds, wid, lane); S.done(cur); }
#undef PG8_SA
#undef PG8_SB
#undef PG8_STAGE
#undef PG8_LDA
#undef PG8_LDB
#undef PG8_MMA
#undef PG8_WAIT_V
#undef PG8_WAIT_L
#undef PG8_BAR
#undef PG8_SCHED
}
}

template <class Epi>
__device__ __forceinline__ void run_gemm(PG8_LAS unsigned char* lds, const bf16_t* A, const bf16_t* Bt, int N, int K, const Epi& E) {
    pg8::Gemm g{A, Bt, NTOK, N, K}; pg8::StaticOrder S; S.init(NTOK, N, (int)gridDim.x, (int)blockIdx.x);
    pg8::gemm_phase<Epi, pg8::StaticOrder, true, true>(lds, g, S, E);
}

__global__ void __launch_bounds__(NTHR, 2) mega_kernel(Params p) {
    extern __shared__ __attribute__((aligned(16))) unsigned char lds_raw[];
    PG8_LAS unsigned char* lds = (PG8_LAS unsigned char*)lds_raw;
    char* smem = (char*)lds_raw;
    cg::grid_group grid = cg::this_grid();
    phase_prologue(p, smem);
    grid.sync();
    phase_u0(p);
    grid.sync();
#define LL(v) ({ int l_ = (v); asm volatile("" : "+s"(l_)); l_; })
#define WL(v) (p.wts + (size_t)(v) * WL_ELEMS)
#define ML(v) (p.mod + (size_t)(v) * 4 * 9216)
#pragma unroll 1
    for (int l = 0; l < 2; ++l) {
        { const int k = LL(l); run_gemm(lds, p.ubuf, WL(k) + W_FIN0, 5632, 1024, pg8::EpiSwiGLU{p.act}); }
        grid.sync();
        { const int k = LL(l); run_gemm(lds, p.act, WL(k) + W_FOUT0, 1024, DFF, pg8::EpiRes{k == 0 ? p.x : p.out, p.out, ML(k), 0, 0.5f}); }
        grid.sync();
        phase_ln(p, LL(l), 0, true);
        grid.sync();
        { const int k = LL(l); run_gemm(lds, p.ubuf, WL(k) + W_IN, NPROJ, 1024, pg8::EpiInproj{p.proj, p.rope, p.iw, p.logf, p.mix_b_forget + k * 4}); }
        grid.sync();
        phase_topk(p, smem); phase_scan(p, smem); phase_attn_a(p); phase_attn_c(p);
        grid.sync();
        phase_flash(p, smem);
        grid.sync();
        phase_merge(p, LL(l), smem);
        grid.sync();
        { const int k = LL(l); run_gemm(lds, p.merged, WL(k) + W_OUT, 1024, 1024, pg8::EpiRes{p.out, p.out, ML(k), 1, 1.0f}); }
        grid.sync();
        phase_ln(p, LL(l), 1, true);
        grid.sync();
        { const int k = LL(l); run_gemm(lds, p.ubuf, WL(k) + W_FIN1, 5632, 1024, pg8::EpiSwiGLU{p.act}); }
        grid.sync();
        { const int k = LL(l); run_gemm(lds, p.act, WL(k) + W_FOUT1, 1024, DFF, pg8::EpiRes{p.out, p.out, ML(k), 2, 0.5f}); }
        grid.sync();
        { const int k = LL(l); phase_ln(p, k, 2, k == 0); }
        if (l == 0) grid.sync();
    }
}

extern "C" void kernel_launch(void* const* d_in, const int* in_sizes, int n_in, void* d_out, int out_size, void* d_ws, size_t ws_size, hipStream_t stream) {
    Params p{};
    p.x = (const float*)d_in[0]; p.c = (const float*)d_in[1]; p.ada_w = (const float*)d_in[2]; p.ada_b = (const float*)d_in[3];
    p.ln_g = (const float*)d_in[4]; p.ln_b = (const float*)d_in[5]; p.ffn_w_in = (const float*)d_in[6]; p.ffn_w_out = (const float*)d_in[7];
    p.mix_w_in = (const float*)d_in[8]; p.mix_b_gate = (const float*)d_in[9]; p.mix_b_forget = (const float*)d_in[10];
    p.mix_w_branch = (const float*)d_in[11]; p.mix_w_out = (const float*)d_in[12];
    p.out = (float*)d_out;
    char* ws = (char*)d_ws; size_t off = 0;
    auto take = [&](size_t bytes) { char* r = ws + off; off += (bytes + 255) & ~(size_t)255; return r; };
    p.wts = (bf16_t*)take(2 * WL_ELEMS * 2);
    p.mod = (float*)take(2 * 4 * 9216 * 4);
    p.rope = (float*)take(SEQ * 16 * 4);
    p.ubuf = (bf16_t*)take((size_t)NTOK * 1024 * 2);
    p.act = (bf16_t*)(ws + off);
    p.proj = (bf16_t*)take((size_t)NTOK * NPROJ * 2);
    p.merged = p.proj;
    p.iw = (float*)take((size_t)NTOK * 16); p.logf = (float*)take((size_t)NTOK * 16); p.cum = (float*)take((size_t)NTOK * 16);
    p.maskb = (unsigned*)take((size_t)NTOK * 1024);
    p.ybuf = (bf16_t*)take((size_t)NTOK * 896 * 2);
    if (off > ws_size) { fprintf(stderr, "workspace too small: need %zu have %zu\n", off, ws_size); return; }
    static int grid_blocks = 0;
    if (!grid_blocks) {
        int dev = 0, cus = 0, per_cu = 0;
        (void)hipGetDevice(&dev);
        (void)hipDeviceGetAttribute(&cus, hipDeviceAttributeMultiprocessorCount, dev);
        (void)hipFuncSetAttribute((const void*)mega_kernel, hipFuncAttributeMaxDynamicSharedMemorySize, LDS_BYTES);
        (void)hipOccupancyMaxActiveBlocksPerMultiprocessor(&per_cu, mega_kernel, NTHR, LDS_BYTES);
        if (per_cu < 1) per_cu = 1;
        if (per_cu > 1) per_cu = 1;
        grid_blocks = cus * per_cu;
    }
    void* args[] = {&p};
    hipError_t e = hipLaunchCooperativeKernel((void*)mega_kernel, dim3(grid_blocks), dim3(NTHR), args, LDS_BYTES, stream);
    if (e != hipSuccess) fprintf(stderr, "cooperative launch failed: %s (grid %d)\n", hipGetErrorString(e), grid_blocks);
}
```

```cpp
#include <hip/hip_runtime.h>
#include <hip/hip_cooperative_groups.h>
#include <cstdio>
#include <cstdint>
namespace cg = cooperative_groups;

#define REP_TOPK 1
#define REP_AC 1
#define REP_FLASH 1
#define REP_MERGE 1
constexpr int NTHR = 512, NWV = 8;
constexpr int DM = 1024, SEQ = 8192, NTOK = 4 * 8192, DFF = 2816;
constexpr int NPROJ = 3840;
constexpr int PA = 0, PB = 1152, PIQ = 1920, PIK = 2176, PC = 2240, PD = 3008, PIW = 3776;
constexpr float ALPHA = 1.41421356237f;
constexpr size_t W_FIN0 = 0, W_FIN1 = 5767168, W_FOUT0 = 11534336, W_FOUT1 = 11534336 + 2883584, W_IN = 17301504,
                 W_GATE = 21233664, W_BR = 25427968, W_OUT = 26345472, WL_ELEMS = 27394048;
constexpr int LDS_BYTES = 144 * 1024;


typedef unsigned short bf16_t;
typedef short bf16x8 __attribute__((ext_vector_type(8)));
typedef float f32x4 __attribute__((ext_vector_type(4)));

struct Params {
    const float *x, *c, *ada_w, *ada_b, *ln_g, *ln_b, *ffn_w_in, *ffn_w_out, *mix_w_in, *mix_b_gate, *mix_b_forget, *mix_w_branch, *mix_w_out;
    float* out;
    bf16_t* wts; float* mod; float* rope; bf16_t* ubuf; bf16_t* act; bf16_t* proj; bf16_t* merged;
    float* iw; float* logf; float* cum; unsigned* maskb; bf16_t* ybuf;
};

__device__ __forceinline__ bf16_t f2bf(float f) { unsigned u = __float_as_uint(f); u += 0x7FFFu + ((u >> 16) & 1u); return (bf16_t)(u >> 16); }
__device__ __forceinline__ float bf2f(bf16_t h) { return __uint_as_float(((unsigned)h) << 16); }
__device__ __forceinline__ float blo(unsigned u) { return __uint_as_float(u << 16); }
__device__ __forceinline__ float bhi(unsigned u) { return __uint_as_float(u & 0xffff0000u); }
__device__ __forceinline__ int otid() { int t = threadIdx.x; asm volatile("" : "+v"(t)); return t; }
__device__ __forceinline__ float log_sigmoid(float x) { return fminf(x, 0.f) - log1pf(expf(-fabsf(x))); }

__device__ __forceinline__ int colmap(int mode, int n) {
    if (mode == 0) return n;
    if (mode == 1) { int q = n >> 8, r = n & 255; return r < 128 ? 128 * q + r : 2816 + 128 * q + (r - 128); }
    if (mode == 2) { if (n < 2240) return n; if (n < 3776) return n + 4; if (n < 3780) return 2240 + (n - 3776); if (n < 3784) return n; return -1; }
    return 3784 + n;
}
__device__ __forceinline__ void convert_job(const float* __restrict__ src, int K, int Nsrc, bf16_t* __restrict__ dst, int Ndst, int mode, char* smem) {
    float (*t)[33] = (float (*)[33])smem;
    const int tid = threadIdx.x, tx = tid & 31, ty = tid >> 5;
    const int kt_n = K / 64, ntiles = kt_n * (Ndst / 32);
    for (int tile = blockIdx.x; tile < ntiles; tile += gridDim.x) {
        const int k0 = (tile % kt_n) * 64, n0 = (tile / kt_n) * 32;
        const int sc = colmap(mode, n0 + tx);
        __syncthreads();
#pragma unroll
        for (int i = 0; i < 4; ++i) { const int k = ty + 16 * i; t[k][tx] = sc >= 0 ? src[(size_t)(k0 + k) * Nsrc + sc] : 0.f; }
        __syncthreads();
        const int kk = tid & 63, nb = tid >> 6;
#pragma unroll
        for (int i = 0; i < 4; ++i) { const int n = nb + 8 * i; dst[(size_t)(n0 + n) * K + k0 + kk] = f2bf(t[kk][n]); }
    }
}

__device__ __forceinline__ void phase_prologue(const Params& p, char* smem) {
    for (int l = 0; l < 2; ++l) {
        bf16_t* w = p.wts + (size_t)l * WL_ELEMS;
        convert_job(p.ffn_w_in + (size_t)(l * 2 + 0) * 1024 * 5632, 1024, 5632, w + W_FIN0, 5632, 1, smem);
        convert_job(p.ffn_w_in + (size_t)(l * 2 + 1) * 1024 * 5632, 1024, 5632, w + W_FIN1, 5632, 1, smem);
        convert_job(p.ffn_w_out + (size_t)(l * 2 + 0) * 2816 * 1024, 2816, 1024, w + W_FOUT0, 1024, 0, smem);
        convert_job(p.ffn_w_out + (size_t)(l * 2 + 1) * 2816 * 1024, 2816, 1024, w + W_FOUT1, 1024, 0, smem);
        convert_job(p.mix_w_in + (size_t)l * 1024 * 7880, 1024, 7880, w + W_IN, 3840, 2, smem);
        convert_job(p.mix_w_in + (size_t)l * 1024 * 7880, 1024, 7880, w + W_GATE, 4096, 3, smem);
        convert_job(p.mix_w_branch + (size_t)l * 896 * 1024, 896, 1024, w + W_BR, 1024, 0, smem);
        convert_job(p.mix_w_out + (size_t)l * 1024 * 1024, 1024, 1024, w + W_OUT, 1024, 0, smem);
    }
    for (int idx = blockIdx.x * NTHR + threadIdx.x; idx < SEQ * 8; idx += gridDim.x * NTHR) {
        const int t = idx >> 3, i = idx & 7;
        const float invf = powf(500000.0f, -(float)i * 0.125f);
        const float ang = (float)t * invf;
        p.rope[idx * 2 + 0] = cosf(ang);
        p.rope[idx * 2 + 1] = sinf(ang);
    }
    __syncthreads();
    float* scs = (float*)smem;
    float* red = scs + 4096;
    for (int i = threadIdx.x; i < 4096; i += NTHR) { const float v = p.c[i]; scs[i] = v / (1.f + expf(-v)); }
    __syncthreads();
    const int tid = threadIdx.x, cl = tid & 63, kq = tid >> 6;
    for (int item = blockIdx.x; item < 288; item += gridDim.x) {
        const int l = item / 144, col = (item % 144) * 64 + cl;
        float a0 = 0.f, a1 = 0.f, a2 = 0.f, a3 = 0.f;
        const float* wp = p.ada_w + ((size_t)l * 1024 + kq * 128) * 9216 + col;
#pragma unroll 8
        for (int k = 0; k < 128; ++k) {
            const float w = wp[(size_t)k * 9216]; const int kk = kq * 128 + k;
            a0 = fmaf(scs[kk], w, a0); a1 = fmaf(scs[1024 + kk], w, a1); a2 = fmaf(scs[2048 + kk], w, a2); a3 = fmaf(scs[3072 + kk], w, a3);
        }
        red[(kq * 4 + 0) * 64 + cl] = a0; red[(kq * 4 + 1) * 64 + cl] = a1; red[(kq * 4 + 2) * 64 + cl] = a2; red[(kq * 4 + 3) * 64 + cl] = a3;
        __syncthreads();
        if (kq < 4) {
            const int b = kq; float s = 0.f;
#pragma unroll
            for (int q = 0; q < 8; ++q) s += red[(q * 4 + b) * 64 + cl];
            p.mod[(size_t)(l * 4 + b) * 9216 + col] = s + p.ada_b[(size_t)l * 9216 + col];
        }
        __syncthreads();
    }
}

__device__ __forceinline__ void phase_u0(const Params& p) {
    const size_t n4 = (size_t)NTOK * 256;
    for (size_t i = (size_t)blockIdx.x * NTHR + threadIdx.x; i < n4; i += (size_t)gridDim.x * NTHR) {
        const size_t row = i >> 8; const int c4 = (int)(i & 255) * 4; const int b = (int)(row >> 13);
        const float4 v = *(const float4*)(p.x + row * 1024 + c4);
        const float* md = p.mod + (size_t)(0 * 4 + b) * 9216;
        const float4 sh = *(const float4*)(md + c4), sc = *(const float4*)(md + 1024 + c4);
        ushort4 o; o.x = f2bf(v.x * (1.f + sc.x) + sh.x); o.y = f2bf(v.y * (1.f + sc.y) + sh.y); o.z = f2bf(v.z * (1.f + sc.z) + sh.z); o.w = f2bf(v.w * (1.f + sc.w) + sh.w);
        *(ushort4*)(p.ubuf + row * 1024 + c4) = o;
    }
}

__device__ __forceinline__ void gemm_mainloop(f32x4 (&acc)[4][4], const bf16_t* __restrict__ A, int lda, const bf16_t* __restrict__ Bt, int ldb, int K, char* smem) {
    bf16_t* As = (bf16_t*)smem; bf16_t* Bs = As + 256 * 40;
    int tid_ = threadIdx.x; asm volatile("" : "+v"(tid_));
    const int tid = tid_, lane = tid & 63, wid = tid >> 6, wr = wid >> 1, wc = wid & 1;
    const int lr = tid >> 1, lk = (tid & 1) * 16;
    const int br = (tid & 255) >> 1;
    const bool ldB = tid < 256;
    const uint4* ga = (const uint4*)(A + (size_t)lr * lda + lk);
    const uint4* gb = (const uint4*)(Bt + (size_t)br * ldb + lk);
    uint4 ra0 = ga[0], ra1 = ga[1], rb0 = make_uint4(0, 0, 0, 0), rb1 = rb0;
    if (ldB) { rb0 = gb[0]; rb1 = gb[1]; }
    const int fr = lane & 15, fq = lane >> 4;
    for (int k0 = 0; k0 < K; k0 += 32) {
        __syncthreads();
        *(uint4*)&As[lr * 40 + lk] = ra0; *(uint4*)&As[lr * 40 + lk + 8] = ra1;
        if (ldB) { *(uint4*)&Bs[br * 40 + lk] = rb0; *(uint4*)&Bs[br * 40 + lk + 8] = rb1; }
        __syncthreads();
        if (k0 + 32 < K) { ga += 4; gb += 4; ra0 = ga[0]; ra1 = ga[1]; if (ldB) { rb0 = gb[0]; rb1 = gb[1]; } }
        bf16x8 a[4], b[4];
#pragma unroll
        for (int m = 0; m < 4; ++m) a[m] = *(const bf16x8*)&As[(wr * 64 + m * 16 + fr) * 40 + fq * 8];
#pragma unroll
        for (int n = 0; n < 4; ++n) b[n] = *(const bf16x8*)&Bs[(wc * 64 + n * 16 + fr) * 40 + fq * 8];
#pragma unroll
        for (int m = 0; m < 4; ++m)
#pragma unroll
            for (int n = 0; n < 4; ++n) acc[m][n] = __builtin_amdgcn_mfma_f32_16x16x32_bf16(a[m], b[n], acc[m][n], 0, 0, 0);
    }
}
__device__ __forceinline__ void zero_acc(f32x4 (&acc)[4][4]) {
#pragma unroll
    for (int m = 0; m < 4; ++m)
#pragma unroll
        for (int n = 0; n < 4; ++n) acc[m][n] = (f32x4){0.f, 0.f, 0.f, 0.f};
}
__device__ __forceinline__ void phase_merge(const Params& p, int l, char* smem) {
    const bf16_t* WG = p.wts + (size_t)l * WL_ELEMS + W_GATE; const bf16_t* WB = p.wts + (size_t)l * WL_ELEMS + W_BR;
    const int tid = otid(), lane = tid & 63, wid = tid >> 6, wr = wid >> 1, wc = wid & 1, fr = lane & 15, fq = lane >> 4;
    for (int tile = blockIdx.x; tile < 128 * 8; tile += gridDim.x) {
        const int pm = tile / 8, pn = tile % 8;
        f32x4 accM[4][4]; zero_acc(accM);
#pragma unroll 1
        for (int br = 0; br < 4; ++br) {
            const int koff = br == 0 ? 0 : 128 + (br - 1) * 256, kb = br == 0 ? 128 : 256;
            f32x4 accG[4][4]; zero_acc(accG);
            gemm_mainloop(accG, p.ubuf + (size_t)pm * 256 * 1024, 1024, WG + (size_t)(br * 1024 + pn * 128) * 1024, 1024, 1024, smem);
            const float* bg = p.mix_b_gate + (size_t)l * 4096 + br * 1024;
#pragma unroll
            for (int n = 0; n < 4; ++n) {
                const float bv = bg[pn * 128 + wc * 64 + n * 16 + fr];
#pragma unroll
                for (int m = 0; m < 4; ++m)
#pragma unroll
                    for (int j = 0; j < 4; ++j) accG[m][n][j] = 1.f / (1.f + expf(-(accG[m][n][j] + bv)));
            }
            unsigned* gst = (unsigned*)(smem + 32768) + tid;
#pragma unroll
            for (int m = 0; m < 4; ++m)
#pragma unroll
                for (int n = 0; n < 4; ++n) {
                    gst[((m * 4 + n) * 2 + 0) * NTHR] = (unsigned)f2bf(accG[m][n][0]) | ((unsigned)f2bf(accG[m][n][1]) << 16);
                    gst[((m * 4 + n) * 2 + 1) * NTHR] = (unsigned)f2bf(accG[m][n][2]) | ((unsigned)f2bf(accG[m][n][3]) << 16);
                }
            zero_acc(accG);
            gemm_mainloop(accG, p.ybuf + (size_t)pm * 256 * 896 + koff, 896, WB + (size_t)pn * 128 * 896 + koff, 896, kb, smem);
#pragma unroll
            for (int m = 0; m < 4; ++m)
#pragma unroll
                for (int n = 0; n < 4; ++n) {
                    const unsigned g01 = gst[((m * 4 + n) * 2 + 0) * NTHR], g23 = gst[((m * 4 + n) * 2 + 1) * NTHR];
                    accM[m][n][0] += blo(g01) * accG[m][n][0]; accM[m][n][1] += bhi(g01) * accG[m][n][1];
                    accM[m][n][2] += blo(g23) * accG[m][n][2]; accM[m][n][3] += bhi(g23) * accG[m][n][3];
                }
        }
#pragma unroll
        for (int m = 0; m < 4; ++m)
#pragma unroll
            for (int n = 0; n < 4; ++n)
#pragma unroll
                for (int j = 0; j < 4; ++j)
                    p.merged[(size_t)(pm * 256 + wr * 64 + m * 16 + fq * 4 + j) * 1024 + pn * 128 + wc * 64 + n * 16 + fr] = f2bf(accM[m][n][j]);
    }
}

__device__ __forceinline__ void phase_ln(const Params& p, int l, int s, bool has_next) {
    const int tid_ = otid(), lane = tid_ & 63, wid = tid_ >> 6;
    const float* g = p.ln_g + (size_t)(l * 3 + s) * 1024; const float* bb = p.ln_b + (size_t)(l * 3 + s) * 1024;
    const int nl = s < 2 ? l : l + 1, ns = s < 2 ? s + 1 : 0;
    for (int row = blockIdx.x * NWV + wid; row < NTOK; row += gridDim.x * NWV) {
        float* xr = p.out + (size_t)row * 1024;
        float4 v[4]; float sum = 0.f;
#pragma unroll
        for (int i = 0; i < 4; ++i) { v[i] = *(const float4*)(xr + lane * 4 + 256 * i); sum += (v[i].x + v[i].y) + (v[i].z + v[i].w); }
#pragma unroll
        for (int o = 32; o > 0; o >>= 1) sum += __shfl_xor(sum, o);
        const float mu = sum * (1.f / 1024.f); float q = 0.f;
#pragma unroll
        for (int i = 0; i < 4; ++i) { const float a = v[i].x - mu, b2 = v[i].y - mu, c = v[i].z - mu, d = v[i].w - mu; q += (a * a + b2 * b2) + (c * c + d * d); }
#pragma unroll
        for (int o = 32; o > 0; o >>= 1) q += __shfl_xor(q, o);
        const float rstd = 1.0f / sqrtf(q * (1.f / 1024.f) + 1e-5f);
        const int b = row >> 13;
        const float* md = p.mod + (size_t)(nl * 4 + b) * 9216 + ns * 3072;
#pragma unroll
        for (int i = 0; i < 4; ++i) {
            const int c4 = lane * 4 + 256 * i;
            const float4 gg = *(const float4*)(g + c4), be = *(const float4*)(bb + c4);
            float4 o; o.x = (v[i].x - mu) * rstd * gg.x + be.x; o.y = (v[i].y - mu) * rstd * gg.y + be.y; o.z = (v[i].z - mu) * rstd * gg.z + be.z; o.w = (v[i].w - mu) * rstd * gg.w + be.w;
            *(float4*)(xr + c4) = o;
            if (has_next) {
                const float4 sh = *(const float4*)(md + c4), sc = *(const float4*)(md + 1024 + c4);
                ushort4 u; u.x = f2bf(o.x * (1.f + sc.x) + sh.x); u.y = f2bf(o.y * (1.f + sc.y) + sh.y); u.z = f2bf(o.z * (1.f + sc.z) + sh.z); u.w = f2bf(o.w * (1.f + sc.w) + sh.w);
                *(ushort4*)(p.ubuf + (size_t)row * 1024 + c4) = u;
            }
        }
    }
}

__device__ __forceinline__ void load_row32(float (&q)[32], const bf16_t* row) {
    const uint4* r = (const uint4*)row;
#pragma unroll
    for (int c = 0; c < 4; ++c) { const uint4 v = r[c];
        q[c * 8 + 0] = blo(v.x); q[c * 8 + 1] = bhi(v.x); q[c * 8 + 2] = blo(v.y); q[c * 8 + 3] = bhi(v.y);
        q[c * 8 + 4] = blo(v.z); q[c * 8 + 5] = bhi(v.z); q[c * 8 + 6] = blo(v.w); q[c * 8 + 7] = bhi(v.w); }
}
__device__ __forceinline__ float dot32(const float (&q)[32], const bf16_t* row) {
    const uint4* r = (const uint4*)row; float a = 0.f;
#pragma unroll
    for (int c = 0; c < 4; ++c) { const uint4 v = r[c];
        a = fmaf(q[c * 8 + 0], blo(v.x), a); a = fmaf(q[c * 8 + 1], bhi(v.x), a); a = fmaf(q[c * 8 + 2], blo(v.y), a); a = fmaf(q[c * 8 + 3], bhi(v.y), a);
        a = fmaf(q[c * 8 + 4], blo(v.z), a); a = fmaf(q[c * 8 + 5], bhi(v.z), a); a = fmaf(q[c * 8 + 6], blo(v.w), a); a = fmaf(q[c * 8 + 7], bhi(v.w), a); }
    return a + __shfl_xor(a, 1);
}
__device__ __forceinline__ void axpy32(float (&o)[32], float sc, float pw, const bf16_t* row) {
    const uint4* r = (const uint4*)row;
#pragma unroll
    for (int c = 0; c < 4; ++c) { const uint4 v = r[c];
        o[c * 8 + 0] = fmaf(pw, blo(v.x), o[c * 8 + 0] * sc); o[c * 8 + 1] = fmaf(pw, bhi(v.x), o[c * 8 + 1] * sc);
        o[c * 8 + 2] = fmaf(pw, blo(v.y), o[c * 8 + 2] * sc); o[c * 8 + 3] = fmaf(pw, bhi(v.y), o[c * 8 + 3] * sc);
        o[c * 8 + 4] = fmaf(pw, blo(v.z), o[c * 8 + 4] * sc); o[c * 8 + 5] = fmaf(pw, bhi(v.z), o[c * 8 + 5] * sc);
        o[c * 8 + 6] = fmaf(pw, blo(v.w), o[c * 8 + 6] * sc); o[c * 8 + 7] = fmaf(pw, bhi(v.w), o[c * 8 + 7] * sc); }
}
__device__ __forceinline__ void store_row32(bf16_t* dst, const float (&o)[32], float sc) {
    uint4* r = (uint4*)dst;
#pragma unroll
    for (int c = 0; c < 4; ++c) { uint4 v;
        v.x = (unsigned)f2bf(o[c * 8 + 0] * sc) | ((unsigned)f2bf(o[c * 8 + 1] * sc) << 16); v.y = (unsigned)f2bf(o[c * 8 + 2] * sc) | ((unsigned)f2bf(o[c * 8 + 3] * sc) << 16);
        v.z = (unsigned)f2bf(o[c * 8 + 4] * sc) | ((unsigned)f2bf(o[c * 8 + 5] * sc) << 16); v.w = (unsigned)f2bf(o[c * 8 + 6] * sc) | ((unsigned)f2bf(o[c * 8 + 7] * sc) << 16);
        r[c] = v; }
}
__device__ __forceinline__ void zero32(float (&o)[32]) {
#pragma unroll
    for (int i = 0; i < 32; ++i) o[i] = 0.f;
}

typedef float f32x16 __attribute__((ext_vector_type(16)));
typedef short s16x4 __attribute__((ext_vector_type(4)));
constexpr int FK_PITCH = 72, FV_PITCH = 68;
__device__ __forceinline__ int crow16(int i, int hh) { return (i & 3) + 8 * (i >> 2) + 4 * hh; }
template <int KIND>
__device__ __forceinline__ void flash_unit(const Params& p, int b, int h, int qb, char* smem, int tid) {
    bf16_t* Ks = (bf16_t*)smem;
    bf16_t* Vt = Ks + 2 * 64 * FK_PITCH;
    float* ckl = (float*)(Vt + 2 * 64 * FV_PITCH);
    const int lane = tid & 63, w = tid >> 6, r = lane & 31, hh = lane >> 5;
    const int QOFF = KIND == 0 ? PD : (KIND == 1 ? PB : PC), YOFF = KIND == 0 ? 640 : (KIND == 1 ? 128 : 384);
    const int q0 = qb * 256, qw0 = q0 + 32 * w, tq = qw0 + r;
    const size_t tokb = (size_t)b * SEQ, tok = tokb + tq;
    const float L2E = 1.44269504089f, C1 = 0.125f * 1.44269504089f;
    bf16x8 qf[4];
#pragma unroll
    for (int ks = 0; ks < 4; ++ks) qf[ks] = *(const bf16x8*)(p.proj + tok * NPROJ + QOFF + h * 64 + 16 * ks + 8 * hh);
    float cql = 0.f; if (KIND == 0) cql = p.cum[tok * 4 + h] * L2E;
    const unsigned* mrow = p.maskb + tok * 256;
    f32x16 o0, o1;
#pragma unroll
    for (int i = 0; i < 16; ++i) { o0[i] = 0.f; o1[i] = 0.f; }
    float mrun = -INFINITY, lrun = 0.f;
    const int ntiles = 4 * (qb + 1);
    const int skey = tid >> 3, sch = tid & 7;
    const bf16_t* kg = p.proj + (tokb + skey) * NPROJ + QOFF + 256 + h * 64 + sch * 8;
    const int jfirst = KIND == 2 ? ntiles - 1 : 0;
    uint4 kreg = *(const uint4*)(kg + (size_t)jfirst * 64 * NPROJ), vreg = *(const uint4*)(kg + (size_t)jfirst * 64 * NPROJ + 256);
    float creg = 0.f; if (KIND == 0 && tid < 64) creg = p.cum[(tokb + tid) * 4 + h] * L2E;
    uint2 mreg = make_uint2(0u, 0u); if (KIND == 1) mreg = *(const uint2*)(mrow);
    float run = 0.f;
#pragma unroll 1
    for (int jj = 0; jj < ntiles; ++jj) {
        const int j = KIND == 2 ? ntiles - 1 - jj : jj;
        const int buf = jj & 1;
        bf16_t* ksb = Ks + buf * 64 * FK_PITCH; bf16_t* vtb = Vt + buf * 64 * FV_PITCH; float* cb = ckl + buf * 64;
        *(uint4*)&ksb[skey * FK_PITCH + sch * 8] = kreg;
        {
            bf16_t* vd = vtb + (sch * 8) * FV_PITCH + skey;
            vd[0 * FV_PITCH] = (bf16_t)(vreg.x & 0xffffu); vd[1 * FV_PITCH] = (bf16_t)(vreg.x >> 16);
            vd[2 * FV_PITCH] = (bf16_t)(vreg.y & 0xffffu); vd[3 * FV_PITCH] = (bf16_t)(vreg.y >> 16);
            vd[4 * FV_PITCH] = (bf16_t)(vreg.z & 0xffffu); vd[5 * FV_PITCH] = (bf16_t)(vreg.z >> 16);
            vd[6 * FV_PITCH] = (bf16_t)(vreg.w & 0xffffu); vd[7 * FV_PITCH] = (bf16_t)(vreg.w >> 16);
        }
        if (KIND == 0 && tid < 64) cb[tid] = creg;
        const uint2 mw = mreg;
        if (KIND == 2) { if (__syncthreads_and(run < -60.f)) break; }
        else __syncthreads();
        if (jj + 1 < ntiles) {
            const int jn = KIND == 2 ? j - 1 : j + 1;
            const bf16_t* kn = kg + (size_t)jn * 64 * NPROJ;
            kreg = *(const uint4*)kn; vreg = *(const uint4*)(kn + 256);
            if (KIND == 0 && tid < 64) creg = p.cum[(tokb + jn * 64 + tid) * 4 + h] * L2E;
            if (KIND == 1) mreg = *(const uint2*)(mrow + 2 * jn);
        }
#pragma unroll
        for (int sb = 0; sb < 2; ++sb) {
            const int sub = KIND == 2 ? 1 - sb : sb;
            const int kb = 64 * j + 32 * sub;
            if (KIND == 2 ? (kb > qw0) : (kb > qw0 + 31)) continue;
            f32x16 x;
#pragma unroll
            for (int i = 0; i < 16; ++i) x[i] = 0.f;
#pragma unroll
            for (int ks = 0; ks < 4; ++ks) {
                const bf16x8 a = *(const bf16x8*)&ksb[(32 * sub + r) * FK_PITCH + 16 * ks + 8 * hh];
                x = __builtin_amdgcn_mfma_f32_32x32x16_bf16(a, qf[ks], x, 0, 0, 0);
            }
            if (KIND == 2) {
                const bool diag = (kb == qw0);
                float lk[16], sg[4];
#pragma unroll
                for (int g = 0; g < 4; ++g) {
                    float acc = 0.f;
#pragma unroll
                    for (int e = 0; e < 4; ++e) {
                        const float z = x[4 * g + e] * 0.125f;
                        float lb = fminf(z, 0.f) - 0.69314718056f * __builtin_amdgcn_logf(1.f + __builtin_amdgcn_exp2f(-fabsf(z) * L2E));
                        float l1 = lb - z;
                        if (diag && (kb + 8 * g + 4 * hh + e >= tq)) { lb = -INFINITY; l1 = 0.f; }
                        x[4 * g + e] = lb; lk[4 * g + e] = l1; acc += l1;
                    }
                    sg[g] = acc;
                }
                float sp[4];
#pragma unroll
                for (int g = 0; g < 4; ++g) sp[g] = __shfl_xor(sg[g], 32);
                float after = 0.f;
#pragma unroll
                for (int g = 3; g >= 0; --g) {
                    const float aft = run + after + (hh == 0 ? sp[g] : 0.f);
                    float suf = 0.f;
#pragma unroll
                    for (int e = 3; e >= 0; --e) { const float lb = x[4 * g + e]; x[4 * g + e] = __builtin_amdgcn_exp2f((lb + aft + suf) * L2E); suf += lk[4 * g + e]; }
                    after += sg[g] + sp[g];
                }
                run += after;
            }
            float mt = -INFINITY;
            if (KIND == 0) {
                const bool diag = kb + 31 > qw0;
#pragma unroll
                for (int g = 0; g < 4; ++g) {
                    const f32x4 ck = *(const f32x4*)&cb[32 * sub + 8 * g + 4 * hh];
#pragma unroll
                    for (int e = 0; e < 4; ++e) {
                        float s = fmaf(x[4 * g + e], C1, cql - ck[e]);
                        if (diag && (kb + 8 * g + 4 * hh + e > tq)) s = -INFINITY;
                        x[4 * g + e] = s; mt = fmaxf(mt, s);
                    }
                }
            } else if (KIND == 1) {
                const unsigned wbits = sub == 0 ? mw.x : mw.y;
#pragma unroll
                for (int i = 0; i < 16; ++i) {
                    float s = x[i] * C1;
                    if (!((wbits >> crow16(i, hh)) & 1u)) s = -INFINITY;
                    x[i] = s; mt = fmaxf(mt, s);
                }
            }
            if (KIND != 2) {
            mt = fmaxf(mt, __shfl_xor(mt, 32));
            const float mnew = fmaxf(mrun, mt), msafe = (mnew == -INFINITY) ? 0.f : mnew;
            const float alpha = __builtin_amdgcn_exp2f(mrun - msafe);
            float ps = 0.f;
#pragma unroll
            for (int i = 0; i < 16; ++i) { const float e = __builtin_amdgcn_exp2f(x[i] - msafe); x[i] = e; ps += e; }
            lrun = lrun * alpha + ps; mrun = mnew;
#pragma unroll
            for (int i = 0; i < 16; ++i) { o0[i] *= alpha; o1[i] *= alpha; }
            }
            bf16x8 pf[2];
#pragma unroll
            for (int s = 0; s < 2; ++s) {
                unsigned pk[4];
#pragma unroll
                for (int e = 0; e < 4; ++e) pk[e] = (unsigned)f2bf(x[8 * s + 2 * e]) | ((unsigned)f2bf(x[8 * s + 2 * e + 1]) << 16);
                pf[s] = __builtin_bit_cast(bf16x8, (uint4){pk[0], pk[1], pk[2], pk[3]});
            }
#pragma unroll
            for (int s = 0; s < 2; ++s) {
#pragma unroll
                for (int dt = 0; dt < 2; ++dt) {
                    const bf16_t* vp = vtb + (32 * dt + r) * FV_PITCH + 32 * sub + 16 * s + 4 * hh;
                    const s16x4 lo = *(const s16x4*)vp, hi = *(const s16x4*)(vp + 8);
                    const bf16x8 vf = __builtin_shufflevector(lo, hi, 0, 1, 2, 3, 4, 5, 6, 7);
                    if (dt == 0) o0 = __builtin_amdgcn_mfma_f32_32x32x16_bf16(vf, pf[s], o0, 0, 0, 0);
                    else o1 = __builtin_amdgcn_mfma_f32_32x32x16_bf16(vf, pf[s], o1, 0, 0, 0);
                }
            }
        }
    }
    const float ltot = lrun + __shfl_xor(lrun, 32), inv = KIND == 2 ? 1.f : 1.f / ltot;
    bf16_t* yo = p.ybuf + tok * 896 + YOFF + h * 64;
#pragma unroll
    for (int g = 0; g < 4; ++g) {
        uint2 w0, w1;
        w0.x = (unsigned)f2bf(o0[4 * g] * inv) | ((unsigned)f2bf(o0[4 * g + 1] * inv) << 16); w0.y = (unsigned)f2bf(o0[4 * g + 2] * inv) | ((unsigned)f2bf(o0[4 * g + 3] * inv) << 16);
        w1.x = (unsigned)f2bf(o1[4 * g] * inv) | ((unsigned)f2bf(o1[4 * g + 1] * inv) << 16); w1.y = (unsigned)f2bf(o1[4 * g + 2] * inv) | ((unsigned)f2bf(o1[4 * g + 3] * inv) << 16);
        *(uint2*)(yo + 8 * g + 4 * hh) = w0; *(uint2*)(yo + 32 + 8 * g + 4 * hh) = w1;
    }
}
__device__ __forceinline__ void phase_attn_a(const Params& p, char* smem) {
    const int tid = otid(), lane = tid & 63, w = tid >> 6, r = lane & 31, hh = lane >> 5;
    bf16_t* vt = (bf16_t*)smem + w * (64 * 36);
    const float C1 = 0.125f * 1.44269504089f;
    __syncthreads();
    for (int item = blockIdx.x * NWV + w; item < 2048; item += gridDim.x * NWV) {
        const int hp = item & 1, rho = (item >> 1) & 15, m = (item >> 5) & 15, b = item >> 9;
        const size_t tokb = (size_t)b * SEQ;
        const int tq = 512 * m + rho + 16 * r;
        f32x16 o0, o1;
#pragma unroll
        for (int i = 0; i < 16; ++i) { o0[i] = 0.f; o1[i] = 0.f; }
        float mrun = -INFINITY, lrun = 0.f;
#pragma unroll 1
        for (int g = 0; g < 3; ++g) {
            const int d = g == 0 ? 1 : (g == 1 ? 4 : 16), c = 16 / d, head = 2 * g + hp, nsub = g == 0 ? 20 : (g == 1 ? 8 : 5);
            const int res = rho & (d - 1), n0 = (512 * m + rho - res) / d, nq = n0 + c * r, nmax = n0 + 31 * c, ks0 = n0 - 128;
            bf16x8 qf[4];
#pragma unroll
            for (int ks = 0; ks < 4; ++ks) qf[ks] = *(const bf16x8*)(p.proj + (tokb + tq) * NPROJ + PA + head * 64 + 16 * ks + 8 * hh);
            const bf16_t* kcol = p.proj + tokb * NPROJ + PA + 384 + head * 64;
#pragma unroll 1
            for (int st = 0; st < nsub; ++st) {
                const int kbase = ks0 + 32 * st;
                if (kbase + 31 < 0) continue;
                int kk = kbase + r; kk = kk < 0 ? 0 : (kk > nmax ? nmax : kk);
                const bf16_t* krow = kcol + (size_t)(kk * d + res) * NPROJ + 8 * hh;
                bf16x8 a[4];
#pragma unroll
                for (int ks = 0; ks < 4; ++ks) a[ks] = *(const bf16x8*)(krow + 16 * ks);
                int kv = kbase + (lane >> 1); kv = kv < 0 ? 0 : (kv > nmax ? nmax : kv);
                const uint4* vrow = (const uint4*)(kcol + (size_t)(kv * d + res) * NPROJ + 384 + (lane & 1) * 32);
                uint4 vv[4];
#pragma unroll
                for (int q = 0; q < 4; ++q) vv[q] = vrow[q];
                f32x16 x;
#pragma unroll
                for (int i = 0; i < 16; ++i) x[i] = 0.f;
#pragma unroll
                for (int ks = 0; ks < 4; ++ks) x = __builtin_amdgcn_mfma_f32_32x32x16_bf16(a[ks], qf[ks], x, 0, 0, 0);
                {
                    bf16_t* vd = vt + ((lane & 1) * 32) * 36 + (lane >> 1);
#pragma unroll
                    for (int q = 0; q < 4; ++q) {
                        vd[(8 * q + 0) * 36] = (bf16_t)(vv[q].x & 0xffffu); vd[(8 * q + 1) * 36] = (bf16_t)(vv[q].x >> 16);
                        vd[(8 * q + 2) * 36] = (bf16_t)(vv[q].y & 0xffffu); vd[(8 * q + 3) * 36] = (bf16_t)(vv[q].y >> 16);
                        vd[(8 * q + 4) * 36] = (bf16_t)(vv[q].z & 0xffffu); vd[(8 * q + 5) * 36] = (bf16_t)(vv[q].z >> 16);
                        vd[(8 * q + 6) * 36] = (bf16_t)(vv[q].w & 0xffffu); vd[(8 * q + 7) * 36] = (bf16_t)(vv[q].w >> 16);
                    }
                }
                float mt = -INFINITY;
#pragma unroll
                for (int i = 0; i < 16; ++i) {
                    const int ki = kbase + crow16(i, hh), dist = nq - ki;
                    float s = x[i] * C1;
                    if (ki < 0 || dist < 0 || dist > 128) s = -INFINITY;
                    x[i] = s; mt = fmaxf(mt, s);
                }
                mt = fmaxf(mt, __shfl_xor(mt, 32));
                const float mnew = fmaxf(mrun, mt), msafe = (mnew == -INFINITY) ? 0.f : mnew;
                const float alpha = __builtin_amdgcn_exp2f(mrun - msafe);
                float ps = 0.f;
#pragma unroll
                for (int i = 0; i < 16; ++i) { const float e = __builtin_amdgcn_exp2f(x[i] - msafe); x[i] = e; ps += e; }
                lrun = lrun * alpha + ps; mrun = mnew;
#pragma unroll
                for (int i = 0; i < 16; ++i) { o0[i] *= alpha; o1[i] *= alpha; }
                bf16x8 pf[2];
#pragma unroll
                for (int s = 0; s < 2; ++s) {
                    unsigned pk[4];
#pragma unroll
                    for (int e = 0; e < 4; ++e) pk[e] = (unsigned)f2bf(x[8 * s + 2 * e]) | ((unsigned)f2bf(x[8 * s + 2 * e + 1]) << 16);
                    pf[s] = __builtin_bit_cast(bf16x8, (uint4){pk[0], pk[1], pk[2], pk[3]});
                }
                asm volatile("s_waitcnt lgkmcnt(0)" ::: "memory");
#pragma unroll
                for (int s = 0; s < 2; ++s) {
#pragma unroll
                    for (int dt = 0; dt < 2; ++dt) {
                        const bf16_t* vp = vt + (32 * dt + r) * 36 + 16 * s + 4 * hh;
                        const s16x4 lo = *(const s16x4*)vp, hi = *(const s16x4*)(vp + 8);
                        const bf16x8 vf = __builtin_shufflevector(lo, hi, 0, 1, 2, 3, 4, 5, 6, 7);
                        if (dt == 0) o0 = __builtin_amdgcn_mfma_f32_32x32x16_bf16(vf, pf[s], o0, 0, 0, 0);
                        else o1 = __builtin_amdgcn_mfma_f32_32x32x16_bf16(vf, pf[s], o1, 0, 0, 0);
                    }
                }
                asm volatile("s_waitcnt lgkmcnt(0)" ::: "memory");
            }
        }
        const float ltot = lrun + __shfl_xor(lrun, 32), inv = 1.f / ltot;
        bf16_t* yo = p.ybuf + (tokb + tq) * 896 + hp * 64;
#pragma unroll
        for (int g = 0; g < 4; ++g) {
            uint2 w0, w1;
            w0.x = (unsigned)f2bf(o0[4 * g] * inv) | ((unsigned)f2bf(o0[4 * g + 1] * inv) << 16); w0.y = (unsigned)f2bf(o0[4 * g + 2] * inv) | ((unsigned)f2bf(o0[4 * g + 3] * inv) << 16);
            w1.x = (unsigned)f2bf(o1[4 * g] * inv) | ((unsigned)f2bf(o1[4 * g + 1] * inv) << 16); w1.y = (unsigned)f2bf(o1[4 * g + 2] * inv) | ((unsigned)f2bf(o1[4 * g + 3] * inv) << 16);
            *(uint2*)(yo + 8 * g + 4 * hh) = w0; *(uint2*)(yo + 32 + 8 * g + 4 * hh) = w1;
        }
    }
}
__device__ __forceinline__ void phase_flash(const Params& p, char* smem) {
    const int tid = otid();
    for (int it = blockIdx.x; it < 768; it += gridDim.x) {
        const int kind = it >> 8, c = it & 255, bh = c & 15, qs = c >> 4;
#pragma unroll 1
        for (int half = 0; half < 2; ++half) {
            const int qb = half ? 31 - qs : qs;
            __syncthreads();
            if (kind == 0) flash_unit<0>(p, bh >> 2, bh & 3, qb, smem, tid);
            else if (kind == 1) flash_unit<1>(p, bh >> 2, bh & 3, qb, smem, tid);
            else flash_unit<2>(p, bh >> 2, bh & 3, qb, smem, tid);
        }
    }
}
__device__ __forceinline__ void phase_scan(const Params& p, char* smem) {
    double* part = (double*)smem;
    const int tid = otid();
    for (int item = blockIdx.x; item < 16; item += gridDim.x) {
        const int b = item >> 2, h = item & 3;
        const float* lf = p.logf + ((size_t)b * SEQ + tid * 16) * 4 + h;
        double s = 0.0;
        for (int i = 0; i < 16; ++i) s += (double)lf[i * 4];
        __syncthreads();
        part[tid] = s;
        __syncthreads();
        if (tid == 0) { double r = 0.0; for (int i = 0; i < NTHR; ++i) { const double v = part[i]; part[i] = r; r += v; } }
        __syncthreads();
        double r = part[tid];
        float* cm = p.cum + ((size_t)b * SEQ + tid * 16) * 4 + h;
        for (int i = 0; i < 16; ++i) { r += (double)lf[i * 4]; cm[i * 4] = (float)r; }
    }
}
__device__ __forceinline__ unsigned f2key(float f) { const unsigned u = __float_as_uint(f); return (u & 0x80000000u) ? ~u : (u | 0x80000000u); }
constexpr int HPITCH = 1028;
template <int PASS>
__device__ __forceinline__ void idx_pass(const Params& p, size_t tokb, int t0, int ktmax, const bf16x8 (&qf)[4][4], float w0, float w1, float w2, float w3,
                                         unsigned* hist, const unsigned* qpre, unsigned* gtb, unsigned* eqb, int lane, int w) {
    const int r = lane & 31, hh = lane >> 5, tq = t0 + r;
    unsigned pre = 0u; if (PASS >= 1) pre = qpre[r];
    unsigned* hrow = hist + r * HPITCH;
    const bf16_t* kbase = p.proj + (tokb + r) * NPROJ + PIK + 8 * hh;
    uint4 an[4];
    if (w <= ktmax) {
#pragma unroll
        for (int ks = 0; ks < 4; ++ks) an[ks] = *(const uint4*)(kbase + (size_t)w * 32 * NPROJ + 16 * ks);
    }
#pragma unroll 1
    for (int kt = w; kt <= ktmax; kt += 8) {
        bf16x8 a[4];
#pragma unroll
        for (int ks = 0; ks < 4; ++ks) a[ks] = __builtin_bit_cast(bf16x8, an[ks]);
        if (kt + 8 <= ktmax) {
#pragma unroll
            for (int ks = 0; ks < 4; ++ks) an[ks] = *(const uint4*)(kbase + (size_t)(kt + 8) * 32 * NPROJ + 16 * ks);
        }
        f32x16 x0, x1, x2, x3;
#pragma unroll
        for (int i = 0; i < 16; ++i) { x0[i] = 0.f; x1[i] = 0.f; x2[i] = 0.f; x3[i] = 0.f; }
#pragma unroll
        for (int ks = 0; ks < 4; ++ks) {
            x0 = __builtin_amdgcn_mfma_f32_32x32x16_bf16(a[ks], qf[0][ks], x0, 0, 0, 0);
            x1 = __builtin_amdgcn_mfma_f32_32x32x16_bf16(a[ks], qf[1][ks], x1, 0, 0, 0);
            x2 = __builtin_amdgcn_mfma_f32_32x32x16_bf16(a[ks], qf[2][ks], x2, 0, 0, 0);
            x3 = __builtin_amdgcn_mfma_f32_32x32x16_bf16(a[ks], qf[3][ks], x3, 0, 0, 0);
        }
        const int kb = kt * 32;
        const bool diag = (kt == ktmax);
        unsigned gw = 0u, ew = 0u;
#pragma unroll
        for (int i = 0; i < 16; ++i) {
            float v = w0 * fmaxf(x0[i], 0.f);
            v = fmaf(w1, fmaxf(x1[i], 0.f), v); v = fmaf(w2, fmaxf(x2[i], 0.f), v); v = fmaf(w3, fmaxf(x3[i], 0.f), v);
            v += 0.0f;
            const unsigned key = f2key(v);
            const int kr = crow16(i, hh);
            const bool valid = !diag || (kb + kr <= tq);
            if (PASS == 0) { if (valid) { const unsigned d = key >> 21; atomicAdd(&hrow[d >> 1], (d & 1u) ? 65536u : 1u); } }
            if (PASS == 1) { if (valid && (key >> 21) == pre) { const unsigned d = (key >> 10) & 2047u; atomicAdd(&hrow[d >> 1], (d & 1u) ? 65536u : 1u); } }
            if (PASS == 2) { if (valid && (key >> 10) == pre) { const unsigned d = key & 1023u; atomicAdd(&hrow[d >> 1], (d & 1u) ? 65536u : 1u); } }
            if (PASS == 3) { gw |= ((valid && key > pre) ? 1u : 0u) << kr; ew |= ((valid && key == pre) ? 1u : 0u) << kr; }
        }
        if (PASS == 3) {
            gw |= __shfl_xor(gw, 32); ew |= __shfl_xor(ew, 32);
            if (hh == 0) { gtb[r * 256 + kt] = gw; eqb[r * 256 + kt] = ew; }
        }
    }
}
__device__ __forceinline__ void idx_search(const unsigned* hist, unsigned* qpre, unsigned* qneed, int shift, int lane, int w) {
#pragma unroll 1
    for (int qi = 0; qi < 4; ++qi) {
        const int q = 4 * w + qi;
        const unsigned need = qneed[q];
        const uint4* hr = (const uint4*)(hist + q * HPITCH + 16 * lane);
        unsigned wr[16];
#pragma unroll
        for (int c = 0; c < 4; ++c) { const uint4 v = hr[c]; wr[4 * c] = v.x; wr[4 * c + 1] = v.y; wr[4 * c + 2] = v.z; wr[4 * c + 3] = v.w; }
        unsigned mine = 0u;
#pragma unroll
        for (int c = 0; c < 16; ++c) mine += (wr[c] & 0xffffu) + (wr[c] >> 16);
        unsigned tot = mine;
#pragma unroll
        for (int o = 1; o < 64; o <<= 1) { const unsigned v = __shfl_down(tot, o); if (lane + o < 64) tot += v; }
        const unsigned excl = tot - mine;
        if (excl < need && tot >= need) {
            unsigned cum = excl, nrem = 0u; int dsel = -1;
#pragma unroll
            for (int c = 15; c >= 0; --c) {
                const unsigned hi = wr[c] >> 16, lo = wr[c] & 0xffffu;
                if (dsel < 0) { if (cum + hi >= need) { dsel = 2 * (16 * lane + c) + 1; nrem = need - cum; } else cum += hi; }
                if (dsel < 0) { if (cum + lo >= need) { dsel = 2 * (16 * lane + c); nrem = need - cum; } else cum += lo; }
            }
            qpre[q] = (qpre[q] << shift) | (unsigned)dsel; qneed[q] = nrem;
        }
    }
}
__device__ __forceinline__ void phase_topk(const Params& p, char* smem) {
    unsigned* hist = (unsigned*)smem;
    unsigned* gtb = hist;
    unsigned* eqb = hist + 32 * 256;
    unsigned* qpre = hist + 32 * HPITCH;
    unsigned* qneed = qpre + 32;
    const int tid = otid(), lane = tid & 63, w = tid >> 6;
    for (int it = blockIdx.x; it < 256; it += gridDim.x) {
#pragma unroll 1
        for (int sub = 0; sub < 4; ++sub) {
            const int u = sub == 0 ? it : (sub == 1 ? 511 - it : (sub == 2 ? 512 + it : 1023 - it));
            const int b = u & 3, blk = u >> 2, t0 = blk * 32;
            const size_t tokb = (size_t)b * SEQ;
            if (t0 + 32 <= 256) {
                for (int i = tid; i < 32 * 256; i += NTHR) {
                    const int q = i >> 8, k = i & 255, n = t0 + q + 1, lo = k * 32;
                    p.maskb[(tokb + t0 + q) * 256 + k] = (lo + 32 <= n) ? 0xffffffffu : (lo >= n ? 0u : ((1u << (n - lo)) - 1u));
                }
                continue;
            }
            const int r = lane & 31, hh = lane >> 5;
            const size_t tok = tokb + t0 + r;
            bf16x8 qf[4][4];
#pragma unroll
            for (int h = 0; h < 4; ++h)
#pragma unroll
                for (int ks = 0; ks < 4; ++ks) qf[h][ks] = *(const bf16x8*)(p.proj + tok * NPROJ + PIQ + h * 64 + 16 * ks + 8 * hh);
            const f32x4 wv = *(const f32x4*)(p.iw + tok * 4);
            const int ktmax = blk;
            __syncthreads();
            if (tid < 32) { qpre[tid] = 0u; qneed[tid] = 256u; }
#pragma unroll 1
            for (int pass = 0; pass < 3; ++pass) {
                for (int i = tid; i < 32 * HPITCH / 4; i += NTHR) ((uint4*)hist)[i] = make_uint4(0u, 0u, 0u, 0u);
                __syncthreads();
                if (pass == 0) idx_pass<0>(p, tokb, t0, ktmax, qf, wv[0], wv[1], wv[2], wv[3], hist, qpre, gtb, eqb, lane, w);
                else if (pass == 1) idx_pass<1>(p, tokb, t0, ktmax, qf, wv[0], wv[1], wv[2], wv[3], hist, qpre, gtb, eqb, lane, w);
                else idx_pass<2>(p, tokb, t0, ktmax, qf, wv[0], wv[1], wv[2], wv[3], hist, qpre, gtb, eqb, lane, w);
                __syncthreads();
                idx_search(hist, qpre, qneed, pass == 2 ? 10 : 11, lane, w);
                __syncthreads();
            }
            for (int i = tid; i < 2 * 32 * 256 / 4; i += NTHR) ((uint4*)hist)[i] = make_uint4(0u, 0u, 0u, 0u);
            __syncthreads();
            idx_pass<3>(p, tokb, t0, ktmax, qf, wv[0], wv[1], wv[2], wv[3], hist, qpre, gtb, eqb, lane, w);
            __syncthreads();
#pragma unroll 1
            for (int qi = 0; qi < 4; ++qi) {
                const int q = 4 * w + qi; const unsigned rr = qneed[q];
                const uint4 g4 = *(const uint4*)&gtb[q * 256 + 4 * lane]; const uint4 e4 = *(const uint4*)&eqb[q * 256 + 4 * lane];
                unsigned ev[4] = {e4.x, e4.y, e4.z, e4.w}, gv[4] = {g4.x, g4.y, g4.z, g4.w};
                const unsigned mine = __popc(ev[0]) + __popc(ev[1]) + __popc(ev[2]) + __popc(ev[3]);
                unsigned incl = mine;
#pragma unroll
                for (int o = 1; o < 64; o <<= 1) { const unsigned v = __shfl_up(incl, o); if (lane >= o) incl += v; }
                unsigned rank = incl - mine;
#pragma unroll
                for (int c = 0; c < 4; ++c) {
                    unsigned e = ev[c]; const unsigned pc = __popc(e);
                    if (rank + pc > rr) {
                        unsigned keep = rank < rr ? rr - rank : 0u, sel = 0u;
                        while (keep > 0u) { const unsigned low = e & (0u - e); sel |= low; e ^= low; --keep; }
                        e = sel;
                    }
                    gv[c] |= e; rank += pc;
                }
                *(uint4*)&p.maskb[(tokb + t0 + q) * 256 + 4 * lane] = make_uint4(gv[0], gv[1], gv[2], gv[3]);
            }
        }
    }
}

namespace pg8 {
#define PG8_LAS __attribute__((address_space(3)))
typedef unsigned short bf16_t;
typedef short bf16x8 __attribute__((ext_vector_type(8)));
typedef float f32x4 __attribute__((ext_vector_type(4)));
typedef unsigned u32x4 __attribute__((ext_vector_type(4)));
constexpr int BM = 256, BK = 64, HALF = 128, HTB = HALF * BK * 2  , STAGE_BYTES = 8 * HTB, NXCD = 8, WGM = 8;

__host__ __device__ __forceinline__ int lds_byte(int r, int c) { const int st = (r >> 4) * 2 + (c >> 5), rr = r & 15, cc = c & 31, ob = rr * 64 + cc * 2; return st * 1024 + (ob ^ (((ob >> 9) & 1) << 5)); }
__host__ __device__ __forceinline__ void stage_rc(int b, int& R, int& C) { const int st = b / 1024, sb = b % 1024, swz = sb ^ (((sb >> 9) & 1) << 5); R = (st >> 1) * 16 + swz / 64; C = (st & 1) * 32 + (swz % 64) / 2; }
__host__ __device__ __forceinline__ int perm32(int rho) { const int n = rho >> 4, i = rho & 15; return 8 * (i >> 2) + 4 * n + (i & 3); }

struct Unit { int pm, pn; };
struct Gemm { const bf16_t* A; const bf16_t* Bt; int M, N, K; };

struct StaticOrder {
    int nM, nN, nwg, G, c;
    __host__ __device__ void init(int M, int N, int G_, int c_) { nM = M / BM; nN = N / BM; nwg = nM * nN; G = G_; c = c_; }
    __host__ __device__ bool next(int i, Unit& u) const {
        const long L = (long)i * G + c; if (L >= nwg) return false;
        int wgid = (int)L; { const int q = nwg / NXCD, r = nwg % NXCD, xcd = wgid % NXCD, off = wgid / NXCD; wgid = (xcd < r ? xcd * (q + 1) : r * (q + 1) + (xcd - r) * q) + off; }
        const int nig = WGM * nN, gid = wgid / nig, fm = gid * WGM, gsz = (nM - fm) < WGM ? (nM - fm) : WGM;
        u.pm = fm + ((wgid % nig) % gsz); u.pn = (wgid % nig) / gsz; return true;
    }
    __device__ __forceinline__ void a_ready(const Unit&) const {}
    __device__ __forceinline__ void done(const Unit&) const {}
};

__device__ __forceinline__ unsigned cvt_pk_bf16(float lo, float hi) { unsigned r; asm volatile("v_cvt_pk_bf16_f32 %0, %1, %2" : "=v"(r) : "v"(lo), "v"(hi)); return r; }
__device__ __forceinline__ float silu_f(float g) { return g / (1.f + __expf(-g)); }
struct EpiSwiGLU {
    static constexpr bool PERM = true, AFTER_DRAIN = false;
    bf16_t* O;
    __device__ __forceinline__ void operator()(const f32x4 (&acc)[2][2][4][2], const Unit& u, int wr, int wc, int fr, int fq) const {
        const int row0 = u.pm * BM + wr * 64 + fr, col0 = u.pn * 128 + wc * 32 + 8 * fq;
#pragma unroll
        for (int ai = 0; ai < 2; ++ai)
#pragma unroll
            for (int m = 0; m < 4; ++m) {
                bf16_t* rowp = O + (size_t)(row0 + ai * HALF + m * 16) * 2816 + col0;
                const f32x4 g0 = acc[ai][0][m][0], g1 = acc[ai][0][m][1], u0 = acc[ai][1][m][0], u1 = acc[ai][1][m][1];
                u32x4 w;
                w.x = cvt_pk_bf16(silu_f(g0[0]) * u0[0], silu_f(g0[1]) * u0[1]); w.y = cvt_pk_bf16(silu_f(g0[2]) * u0[2], silu_f(g0[3]) * u0[3]);
                w.z = cvt_pk_bf16(silu_f(g1[0]) * u1[0], silu_f(g1[1]) * u1[1]); w.w = cvt_pk_bf16(silu_f(g1[2]) * u1[2], silu_f(g1[3]) * u1[3]);
                *(u32x4*)rowp = w;
            }
    }
};
struct EpiRes {
    static constexpr bool PERM = false, AFTER_DRAIN = false;
    const float* xres; float* out; const float* modl; int sub; float fac;
    __device__ __forceinline__ void operator()(const f32x4 (&acc)[2][2][4][2], const Unit& u, int wr, int wc, int fr, int fq) const {
        const int b = (u.pm * BM) >> 13;
        const float* gate = modl + (size_t)b * 9216 + sub * 3072 + 2048;
        const int col0 = u.pn * BM + wc * 32 + 4 * fq;
#pragma unroll
        for (int bj = 0; bj < 2; ++bj)
#pragma unroll
            for (int n = 0; n < 2; ++n) {
                const int col = col0 + bj * HALF + n * 16;
                f32x4 gm = *(const f32x4*)(gate + col); gm = (gm + 1.0f) * fac;
#pragma unroll
                for (int ai = 0; ai < 2; ++ai)
#pragma unroll
                    for (int m = 0; m < 4; ++m) {
                        const size_t off = (size_t)(u.pm * BM + ai * HALF + wr * 64 + m * 16 + fr) * 1024 + col;
                        const f32x4 xr = *(const f32x4*)(xres + off);
                        *(f32x4*)(out + off) = xr * 1.41421356237f + gm * acc[ai][bj][m][n];
                    }
            }
    }
};
struct EpiInproj {
    static constexpr bool PERM = true, AFTER_DRAIN = false;
    bf16_t* proj; const float* rope; float* iw; float* logf; const float* bfg;
    __device__ __forceinline__ void operator()(const f32x4 (&acc)[2][2][4][2], const Unit& u, int wr, int wc, int fr, int fq) const {
#pragma unroll
        for (int bj = 0; bj < 2; ++bj) {
            const int cb32 = u.pn * BM + bj * HALF + wc * 32;
            const bool rp = ((cb32 & 63) == 0) && (cb32 < 768 || (cb32 >= 1152 && cb32 < 1664) || (cb32 >= 1920 && cb32 < 2240));
#pragma unroll
            for (int ai = 0; ai < 2; ++ai)
#pragma unroll
                for (int m = 0; m < 4; ++m) {
                    const int row = u.pm * BM + ai * HALF + wr * 64 + m * 16 + fr;
                    f32x4 v0 = acc[ai][bj][m][0], v1 = acc[ai][bj][m][1];
                    if (rp) {
                        const int t = row & 8191;
                        const f32x4* rt = (const f32x4*)(rope + (size_t)t * 16);
                        const f32x4 r0 = rt[0], r1 = rt[1], r2 = rt[2], r3 = rt[3];
                        f32x4 p0, p1;
#pragma unroll
                        for (int j = 0; j < 4; ++j) { p0[j] = __shfl_xor(v0[j], 16); p1[j] = __shfl_xor(v1[j], 16); }
                        if (fq == 0) {
                            v0[0] = v0[0] * r0[0] - p0[0] * r0[1]; v0[1] = v0[1] * r0[2] - p0[1] * r0[3]; v0[2] = v0[2] * r1[0] - p0[2] * r1[1]; v0[3] = v0[3] * r1[2] - p0[3] * r1[3];
                            v1[0] = v1[0] * r2[0] - p1[0] * r2[1]; v1[1] = v1[1] * r2[2] - p1[1] * r2[3]; v1[2] = v1[2] * r3[0] - p1[2] * r3[1]; v1[3] = v1[3] * r3[2] - p1[3] * r3[3];
                        } else if (fq == 1) {
                            v0[0] = v0[0] * r0[0] + p0[0] * r0[1]; v0[1] = v0[1] * r0[2] + p0[1] * r0[3]; v0[2] = v0[2] * r1[0] + p0[2] * r1[1]; v0[3] = v0[3] * r1[2] + p0[3] * r1[3];
                            v1[0] = v1[0] * r2[0] + p1[0] * r2[1]; v1[1] = v1[1] * r2[2] + p1[1] * r2[3]; v1[2] = v1[2] * r3[0] + p1[2] * r3[1]; v1[3] = v1[3] * r3[2] + p1[3] * r3[3];
                        }
                    }
                    u32x4 w; w.x = cvt_pk_bf16(v0[0], v0[1]); w.y = cvt_pk_bf16(v0[2], v0[3]); w.z = cvt_pk_bf16(v1[0], v1[1]); w.w = cvt_pk_bf16(v1[2], v1[3]);
                    *(u32x4*)(proj + (size_t)row * 3840 + cb32 + 8 * fq) = w;
                    if (cb32 == 3776 && fq == 0) {
                        *(f32x4*)(iw + (size_t)row * 4) = v0;
                        f32x4 lf;
#pragma unroll
                        for (int j = 0; j < 4; ++j) { const float xx = v1[j] + bfg[j]; lf[j] = fminf(xx, 0.f) - log1pf(expf(-fabsf(xx))); }
                        *(f32x4*)(logf + (size_t)row * 4) = lf;
                    }
                }
        }
    }
};
template <class Epi, class Sched, bool ALIGN_EPI = false, bool SP2 = false>
__device__ __forceinline__ void gemm_phase(PG8_LAS unsigned char* lds, const Gemm g, const Sched& S, const Epi& E) {
    int tid_ = threadIdx.x; asm volatile("" : "+v"(tid_));
    const int tid = tid_, wid = __builtin_amdgcn_readfirstlane(tid >> 6), lane = tid & 63, wr = wid >> 2, wc = wid & 3, fr = lane & 15, fq = lane >> 4;
    const int K = g.K, nt = K / BK;
    unsigned voffA[2], voffB[2];
#pragma unroll
    for (int i = 0; i < 2; ++i) { int R, C; stage_rc(tid * 16 + i * 8192, R, C); const int Rb = Epi::PERM ? ((R & ~31) + perm32(R & 31)) : R;
        voffA[i] = (unsigned)(R * K + C) * 2u; voffB[i] = (unsigned)(Rb * K + C) * 2u; }
    const size_t kstep = (size_t)(BK * 2);
    const size_t hstep = (size_t)HALF * K * 2;
    const size_t tstep = 2 * hstep;
    const unsigned ldsw = (unsigned)wid * 1024u;
    const int aoff = lds_byte(wr * 64 + fr, fq * 8), boff = lds_byte(wc * 32 + fr, fq * 8);
#define PG8_SA(b, h) (((b) * 2 + (h)) * HTB)
#define PG8_SB(b, h) ((4 + (b) * 2 + (h)) * HTB)
#define PG8_STAGE(bufoff, gbase, voff) do { _Pragma("unroll") for (int _i = 0; _i < 2; ++_i) \
        __builtin_amdgcn_global_load_lds((const unsigned*)((const char*)(gbase) + (voff)[_i]), (PG8_LAS unsigned*)(lds + (bufoff) + ldsw + _i * 8192), 16, 0, 0); } while (0)
#define PG8_LDA(dst, b, h) do { _Pragma("unroll") for (int m = 0; m < 4; ++m) _Pragma("unroll") for (int k = 0; k < 2; ++k) dst[m][k] = *(const PG8_LAS bf16x8*)(lds + PG8_SA(b, h) + aoff + m * 2048 + k * 1024); } while (0)
#define PG8_LDB(dst, b, h) do { _Pragma("unroll") for (int n = 0; n < 2; ++n) _Pragma("unroll") for (int k = 0; k < 2; ++k) dst[n][k] = *(const PG8_LAS bf16x8*)(lds + PG8_SB(b, h) + boff + n * 2048 + k * 1024); } while (0)
#define PG8_MMA(ai, bj, At, Bt) do { __builtin_amdgcn_s_setprio(1); _Pragma("unroll") for (int m = 0; m < 4; ++m) _Pragma("unroll") for (int n = 0; n < 2; ++n) _Pragma("unroll") for (int k = 0; k < 2; ++k) \
        acc[ai][bj][m][n] = __builtin_amdgcn_mfma_f32_16x16x32_bf16(Bt[n][k], At[m][k], acc[ai][bj][m][n], 0, 0, 0); __builtin_amdgcn_s_setprio(0); } while (0)
#define PG8_WAIT_V(n) asm volatile("s_waitcnt vmcnt(" #n ")" ::: "memory")
#define PG8_WAIT_L(n) asm volatile("s_waitcnt lgkmcnt(" #n ")" ::: "memory")
#define PG8_BAR __builtin_amdgcn_s_barrier()
#define PG8_SCHED __builtin_amdgcn_sched_barrier(0)
    Unit cur, nxt; int ui = 0;
    if (!S.next(0, cur)) return;
    f32x4 acc[2][2][4][2];
#pragma unroll
    for (int a = 0; a < 2; ++a)
#pragma unroll
        for (int b = 0; b < 2; ++b)
#pragma unroll
            for (int m = 0; m < 4; ++m)
#pragma unroll
                for (int n = 0; n < 2; ++n) acc[a][b][m][n] = (f32x4){0.f, 0.f, 0.f, 0.f};
    bf16x8 At[4][2], B0[2][2], B1[2][2];
    const char* cA = (const char*)g.A + (size_t)cur.pm * tstep; const char* cB = (const char*)g.Bt + (size_t)cur.pn * tstep;
    S.a_ready(cur);
    if constexpr (SP2) {
        PG8_STAGE(PG8_SB(0, 0), cB, voffB); PG8_STAGE(PG8_SB(0, 1), cB + hstep, voffB); PG8_STAGE(PG8_SA(0, 0), cA, voffA); PG8_STAGE(PG8_SA(0, 1), cA + hstep, voffA);
        if (wr == 1) PG8_BAR;
        PG8_WAIT_V(2); PG8_BAR;
        PG8_STAGE(PG8_SB(1, 0), cB + kstep, voffB); PG8_STAGE(PG8_SA(1, 0), cA + kstep, voffA); PG8_STAGE(PG8_SB(1, 1), cB + hstep + kstep, voffB);
        PG8_WAIT_V(6); PG8_BAR;
    } else {
        PG8_STAGE(PG8_SB(0, 0), cB, voffB); PG8_STAGE(PG8_SA(0, 0), cA, voffA); PG8_STAGE(PG8_SB(0, 1), cB + hstep, voffB); PG8_STAGE(PG8_SA(0, 1), cA + hstep, voffA);
        if (wr == 1) PG8_BAR;
        PG8_WAIT_V(4); PG8_BAR;
        PG8_STAGE(PG8_SB(1, 0), cB + kstep, voffB); PG8_STAGE(PG8_SA(1, 0), cA + kstep, voffA); PG8_STAGE(PG8_SB(1, 1), cB + hstep + kstep, voffB);
        PG8_WAIT_V(6); PG8_BAR;
    }
    for (;;) {
        const bool has_next = S.next(ui + 1, nxt);
        const char* nA = has_next ? (const char*)g.A + (size_t)nxt.pm * tstep : cA; const char* nB = has_next ? (const char*)g.Bt + (size_t)nxt.pn * tstep : cB;
        for (int t = 0; t < nt; t += 2) {
            const bool last = (t == nt - 2);
            const char* a1 = cA + (size_t)(t + 1) * kstep;
            const char* a2 = last ? nA : cA + (size_t)(t + 2) * kstep; const char* b2 = last ? nB : cB + (size_t)(t + 2) * kstep;
            const char* a3 = a2 + kstep; const char* b3 = b2 + kstep;
            if (last && has_next) S.a_ready(nxt);
            if constexpr (SP2) {
            PG8_LDB(B0, 0, 0); PG8_LDB(B1, 0, 1); PG8_SCHED; PG8_LDA(At, 0, 0); PG8_STAGE(PG8_SA(1, 1), a1 + hstep, voffA);
            PG8_WAIT_V(8); PG8_WAIT_L(0); PG8_BAR; PG8_MMA(0, 0, At, B0); PG8_MMA(0, 1, At, B1); PG8_BAR; PG8_SCHED;
            PG8_LDA(At, 0, 1); PG8_STAGE(PG8_SB(0, 0), b2, voffB); PG8_STAGE(PG8_SB(0, 1), b2 + hstep, voffB); PG8_STAGE(PG8_SA(0, 0), a2, voffA);
            PG8_WAIT_V(8); PG8_WAIT_L(0); PG8_BAR; PG8_MMA(1, 0, At, B0); PG8_MMA(1, 1, At, B1); PG8_BAR; PG8_SCHED;
            PG8_LDB(B0, 1, 0); PG8_LDB(B1, 1, 1); PG8_SCHED; PG8_LDA(At, 1, 0); PG8_STAGE(PG8_SA(0, 1), a2 + hstep, voffA);
            PG8_WAIT_V(8); PG8_WAIT_L(0); PG8_BAR; PG8_MMA(0, 0, At, B0); PG8_MMA(0, 1, At, B1); PG8_BAR; PG8_SCHED;
            PG8_LDA(At, 1, 1); PG8_STAGE(PG8_SB(1, 0), b3, voffB); PG8_STAGE(PG8_SB(1, 1), b3 + hstep, voffB); PG8_STAGE(PG8_SA(1, 0), a3, voffA);
            PG8_WAIT_V(8); PG8_WAIT_L(0); PG8_BAR; PG8_MMA(1, 0, At, B0); PG8_MMA(1, 1, At, B1); PG8_BAR; PG8_SCHED;
            } else {
            PG8_LDB(B0, 0, 0); PG8_SCHED; PG8_LDA(At, 0, 0); PG8_STAGE(PG8_SA(1, 1), a1 + hstep, voffA);
            PG8_WAIT_L(8); PG8_BAR; PG8_WAIT_L(0); PG8_MMA(0, 0, At, B0); PG8_BAR; PG8_SCHED;
            PG8_LDB(B1, 0, 1); PG8_STAGE(PG8_SB(0, 0), b2, voffB);
            PG8_BAR; PG8_WAIT_L(0); PG8_MMA(0, 1, At, B1); PG8_BAR;
            PG8_LDA(At, 0, 1); PG8_STAGE(PG8_SA(0, 0), a2, voffA);
            PG8_BAR; PG8_WAIT_L(0); PG8_MMA(1, 0, At, B0); PG8_BAR; PG8_SCHED;
            PG8_STAGE(PG8_SB(0, 1), b2 + hstep, voffB);
            PG8_WAIT_V(6); PG8_BAR; PG8_MMA(1, 1, At, B1); PG8_BAR;
            PG8_LDB(B0, 1, 0); PG8_SCHED; PG8_LDA(At, 1, 0); PG8_STAGE(PG8_SA(0, 1), a2 + hstep, voffA);
            PG8_WAIT_L(8); PG8_BAR; PG8_WAIT_L(0); PG8_MMA(0, 0, At, B0); PG8_BAR; PG8_SCHED;
            PG8_LDB(B1, 1, 1); PG8_STAGE(PG8_SB(1, 0), b3, voffB);
            PG8_BAR; PG8_WAIT_L(0); PG8_MMA(0, 1, At, B1); PG8_BAR;
            PG8_LDA(At, 1, 1); PG8_STAGE(PG8_SA(1, 0), a3, voffA);
            PG8_BAR; PG8_WAIT_L(0); PG8_MMA(1, 0, At, B0); PG8_BAR; PG8_SCHED;
            PG8_STAGE(PG8_SB(1, 1), b3 + hstep, voffB);
            PG8_WAIT_V(6); PG8_BAR; PG8_MMA(1, 1, At, B1); PG8_BAR;
            }
        }
        if constexpr (ALIGN_EPI) { if (wr == 0) PG8_BAR; }
        if constexpr (!Epi::AFTER_DRAIN) { E(acc, cur, wr, wc, fr, fq); S.done(cur); }
        if (!has_next) break;
#pragma unroll
        for (int a = 0; a < 2; ++a)
#pragma unroll
            for (int b = 0; b < 2; ++b)
#pragma unroll
                for (int m = 0; m < 4; ++m)
#pragma unroll
                    for (int n = 0; n < 2; ++n) acc[a][b][m][n] = (f32x4){0.f, 0.f, 0.f, 0.f};
        cur = nxt; cA = nA; cB = nB; ++ui;
        if constexpr (ALIGN_EPI) { if (wr == 1) PG8_BAR; }
    }
    PG8_WAIT_V(0);
    if constexpr (!ALIGN_EPI) { if (wr == 0) PG8_BAR; }
    PG8_BAR;
    if constexpr (Epi::AFTER_DRAIN) { E.fused(acc, cur, wr, wc, fr, fq, lds, wid, lane); S.done(cur); }
#undef PG8_SA
#undef PG8_SB
#undef PG8_STAGE
#undef PG8_LDA
#undef PG8_LDB
#undef PG8_MMA
#undef PG8_WAIT_V
#undef PG8_WAIT_L
#undef PG8_BAR
#undef PG8_SCHED
}
}

template <class Epi>
__device__ __forceinline__ void run_gemm(PG8_LAS unsigned char* lds, const bf16_t* A, const bf16_t* Bt, int N, int K, const Epi& E) {
    pg8::Gemm g{A, Bt, NTOK, N, K}; pg8::StaticOrder S; S.init(NTOK, N, (int)gridDim.x, (int)blockIdx.x);
    pg8::gemm_phase<Epi, pg8::StaticOrder, true, true>(lds, g, S, E);
}

__global__ void __launch_bounds__(NTHR, 2) mega_kernel(Params p) {
    extern __shared__ __attribute__((aligned(16))) unsigned char lds_raw[];
    PG8_LAS unsigned char* lds = (PG8_LAS unsigned char*)lds_raw;
    char* smem = (char*)lds_raw;
    cg::grid_group grid = cg::this_grid();
    phase_prologue(p, smem);
    grid.sync();
    phase_u0(p);
    grid.sync();
#define LL(v) ({ int l_ = (v); asm volatile("" : "+s"(l_)); l_; })
#define WL(v) (p.wts + (size_t)(v) * WL_ELEMS)
#define ML(v) (p.mod + (size_t)(v) * 4 * 9216)
#pragma unroll 1
    for (int l = 0; l < 2; ++l) {
        { const int k = LL(l); run_gemm(lds, p.ubuf, WL(k) + W_FIN0, 5632, 1024, pg8::EpiSwiGLU{p.act}); }
        grid.sync();
        { const int k = LL(l); run_gemm(lds, p.act, WL(k) + W_FOUT0, 1024, DFF, pg8::EpiRes{k == 0 ? p.x : p.out, p.out, ML(k), 0, 0.5f}); }
        grid.sync();
        phase_ln(p, LL(l), 0, true);
        grid.sync();
        { const int k = LL(l); run_gemm(lds, p.ubuf, WL(k) + W_IN, NPROJ, 1024, pg8::EpiInproj{p.proj, p.rope, p.iw, p.logf, p.mix_b_forget + k * 4}); }
        grid.sync();
        for (int rep = 0; rep < REP_TOPK; ++rep) phase_topk(p, smem);
        phase_scan(p, smem);
        for (int rep = 0; rep < REP_AC; ++rep) phase_attn_a(p, smem);
        grid.sync();
        for (int rep = 0; rep < REP_FLASH; ++rep) phase_flash(p, smem);
        grid.sync();
        for (int rep = 0; rep < REP_MERGE; ++rep) phase_merge(p, LL(l), smem);
        grid.sync();
        { const int k = LL(l); run_gemm(lds, p.merged, WL(k) + W_OUT, 1024, 1024, pg8::EpiRes{p.out, p.out, ML(k), 1, 1.0f}); }
        grid.sync();
        phase_ln(p, LL(l), 1, true);
        grid.sync();
        { const int k = LL(l); run_gemm(lds, p.ubuf, WL(k) + W_FIN1, 5632, 1024, pg8::EpiSwiGLU{p.act}); }
        grid.sync();
        { const int k = LL(l); run_gemm(lds, p.act, WL(k) + W_FOUT1, 1024, DFF, pg8::EpiRes{p.out, p.out, ML(k), 2, 0.5f}); }
        grid.sync();
        { const int k = LL(l); phase_ln(p, k, 2, k == 0); }
        if (l == 0) grid.sync();
    }
}

extern "C" void kernel_launch(void* const* d_in, const int* in_sizes, int n_in, void* d_out, int out_size, void* d_ws, size_t ws_size, hipStream_t stream) {
    Params p{};
    p.x = (const float*)d_in[0]; p.c = (const float*)d_in[1]; p.ada_w = (const float*)d_in[2]; p.ada_b = (const float*)d_in[3];
    p.ln_g = (const float*)d_in[4]; p.ln_b = (const float*)d_in[5]; p.ffn_w_in = (const float*)d_in[6]; p.ffn_w_out = (const float*)d_in[7];
    p.mix_w_in = (const float*)d_in[8]; p.mix_b_gate = (const float*)d_in[9]; p.mix_b_forget = (const float*)d_in[10];
    p.mix_w_branch = (const float*)d_in[11]; p.mix_w_out = (const float*)d_in[12];
    p.out = (float*)d_out;
    char* ws = (char*)d_ws; size_t off = 0;
    auto take = [&](size_t bytes) { char* r = ws + off; off += (bytes + 255) & ~(size_t)255; return r; };
    p.wts = (bf16_t*)take(2 * WL_ELEMS * 2);
    p.mod = (float*)take(2 * 4 * 9216 * 4);
    p.rope = (float*)take(SEQ * 16 * 4);
    p.ubuf = (bf16_t*)take((size_t)NTOK * 1024 * 2);
    p.act = (bf16_t*)(ws + off);
    p.proj = (bf16_t*)take((size_t)NTOK * NPROJ * 2);
    p.merged = p.proj;
    p.iw = (float*)take((size_t)NTOK * 16); p.logf = (float*)take((size_t)NTOK * 16); p.cum = (float*)take((size_t)NTOK * 16);
    p.maskb = (unsigned*)take((size_t)NTOK * 1024);
    p.ybuf = (bf16_t*)take((size_t)NTOK * 896 * 2);
    if (off > ws_size) { fprintf(stderr, "workspace too small: need %zu have %zu\n", off, ws_size); return; }
    static int grid_blocks = 0;
    if (!grid_blocks) {
        int dev = 0, cus = 0, per_cu = 0;
        (void)hipGetDevice(&dev);
        (void)hipDeviceGetAttribute(&cus, hipDeviceAttributeMultiprocessorCount, dev);
        (void)hipFuncSetAttribute((const void*)mega_kernel, hipFuncAttributeMaxDynamicSharedMemorySize, LDS_BYTES);
        (void)hipOccupancyMaxActiveBlocksPerMultiprocessor(&per_cu, mega_kernel, NTHR, LDS_BYTES);
        if (per_cu < 1) per_cu = 1;
        if (per_cu > 1) per_cu = 1;
        grid_blocks = cus * per_cu;
    }
    void* args[] = {&p};
    hipError_t e = hipLaunchCooperativeKernel((void*)mega_kernel, dim3(grid_blocks), dim3(NTHR), args, LDS_BYTES, stream);
    if (e != hipSuccess) fprintf(stderr, "cooperative launch failed: %s (grid %d)\n", hipGetErrorString(e), grid_blocks);
}
```

```cpp
#include <hip/hip_runtime.h>
#include <hip/hip_cooperative_groups.h>
#include <cstdio>
#include <cstdint>
namespace cg = cooperative_groups;

#define REP_TOPK 1
#define REP_AC 1
#define REP_FLASH 1
#define REP_MERGE 1
constexpr int NTHR = 512, NWV = 8;
constexpr int DM = 1024, SEQ = 8192, NTOK = 4 * 8192, DFF = 2816;
constexpr int NPROJ = 3840;
constexpr int PA = 0, PB = 1152, PIQ = 1920, PIK = 2176, PC = 2240, PD = 3008, PIW = 3776;
constexpr float ALPHA = 1.41421356237f;
constexpr size_t W_FIN0 = 0, W_FIN1 = 5767168, W_FOUT0 = 11534336, W_FOUT1 = 11534336 + 2883584, W_IN = 17301504,
                 W_GATE = 21233664, W_BR = 25427968, W_OUT = 26345472, WL_ELEMS = 27394048;
constexpr int LDS_BYTES = 144 * 1024;


typedef unsigned short bf16_t;
typedef short bf16x8 __attribute__((ext_vector_type(8)));
typedef float f32x4 __attribute__((ext_vector_type(4)));

struct Params {
    const float *x, *c, *ada_w, *ada_b, *ln_g, *ln_b, *ffn_w_in, *ffn_w_out, *mix_w_in, *mix_b_gate, *mix_b_forget, *mix_w_branch, *mix_w_out;
    float* out;
    bf16_t* wts; float* mod; float* rope; bf16_t* ubuf; bf16_t* act; bf16_t* proj; bf16_t* merged;
    float* iw; float* logf; float* cum; unsigned* maskb; bf16_t* ybuf;
    unsigned* bar;
};

__device__ __forceinline__ bf16_t f2bf(float f) { unsigned u = __float_as_uint(f); u += 0x7FFFu + ((u >> 16) & 1u); return (bf16_t)(u >> 16); }
__device__ __forceinline__ float bf2f(bf16_t h) { return __uint_as_float(((unsigned)h) << 16); }
__device__ __forceinline__ float blo(unsigned u) { return __uint_as_float(u << 16); }
__device__ __forceinline__ float bhi(unsigned u) { return __uint_as_float(u & 0xffff0000u); }
__device__ __forceinline__ int otid() { int t = threadIdx.x; asm volatile("" : "+v"(t)); return t; }
__device__ __forceinline__ float log_sigmoid(float x) { return fminf(x, 0.f) - log1pf(expf(-fabsf(x))); }

__device__ __forceinline__ int colmap(int mode, int n) {
    if (mode == 0) return n;
    if (mode == 1) { int q = n >> 8, r = n & 255; return r < 128 ? 128 * q + r : 2816 + 128 * q + (r - 128); }
    if (mode == 2) { if (n < 2240) return n; if (n < 3776) return n + 4; if (n < 3780) return 2240 + (n - 3776); if (n < 3784) return n; return -1; }
    return 3784 + n;
}
__device__ __forceinline__ void convert_job(const float* __restrict__ src, int K, int Nsrc, bf16_t* __restrict__ dst, int Ndst, int mode, char* smem) {
    float (*t)[33] = (float (*)[33])smem;
    const int tid = threadIdx.x, tx = tid & 31, ty = tid >> 5;
    const int kt_n = K / 64, ntiles = kt_n * (Ndst / 32);
    for (int tile = blockIdx.x; tile < ntiles; tile += gridDim.x) {
        const int k0 = (tile % kt_n) * 64, n0 = (tile / kt_n) * 32;
        const int sc = colmap(mode, n0 + tx);
        __syncthreads();
#pragma unroll
        for (int i = 0; i < 4; ++i) { const int k = ty + 16 * i; t[k][tx] = sc >= 0 ? src[(size_t)(k0 + k) * Nsrc + sc] : 0.f; }
        __syncthreads();
        const int kk = tid & 63, nb = tid >> 6;
#pragma unroll
        for (int i = 0; i < 4; ++i) { const int n = nb + 8 * i; dst[(size_t)(n0 + n) * K + k0 + kk] = f2bf(t[kk][n]); }
    }
}

__device__ __forceinline__ void phase_prologue(const Params& p, char* smem) {
    for (int l = 0; l < 2; ++l) {
        bf16_t* w = p.wts + (size_t)l * WL_ELEMS;
        convert_job(p.ffn_w_in + (size_t)(l * 2 + 0) * 1024 * 5632, 1024, 5632, w + W_FIN0, 5632, 1, smem);
        convert_job(p.ffn_w_in + (size_t)(l * 2 + 1) * 1024 * 5632, 1024, 5632, w + W_FIN1, 5632, 1, smem);
        convert_job(p.ffn_w_out + (size_t)(l * 2 + 0) * 2816 * 1024, 2816, 1024, w + W_FOUT0, 1024, 0, smem);
        convert_job(p.ffn_w_out + (size_t)(l * 2 + 1) * 2816 * 1024, 2816, 1024, w + W_FOUT1, 1024, 0, smem);
        convert_job(p.mix_w_in + (size_t)l * 1024 * 7880, 1024, 7880, w + W_IN, 3840, 2, smem);
        convert_job(p.mix_w_in + (size_t)l * 1024 * 7880, 1024, 7880, w + W_GATE, 4096, 3, smem);
        convert_job(p.mix_w_branch + (size_t)l * 896 * 1024, 896, 1024, w + W_BR, 1024, 0, smem);
        convert_job(p.mix_w_out + (size_t)l * 1024 * 1024, 1024, 1024, w + W_OUT, 1024, 0, smem);
    }
    for (int idx = blockIdx.x * NTHR + threadIdx.x; idx < SEQ * 8; idx += gridDim.x * NTHR) {
        const int t = idx >> 3, i = idx & 7;
        const float invf = powf(500000.0f, -(float)i * 0.125f);
        const float ang = (float)t * invf;
        p.rope[idx * 2 + 0] = cosf(ang);
        p.rope[idx * 2 + 1] = sinf(ang);
    }
    __syncthreads();
    float* scs = (float*)smem;
    float* red = scs + 4096;
    for (int i = threadIdx.x; i < 4096; i += NTHR) { const float v = p.c[i]; scs[i] = v / (1.f + expf(-v)); }
    __syncthreads();
    const int tid = threadIdx.x, cl = tid & 63, kq = tid >> 6;
    for (int item = blockIdx.x; item < 288; item += gridDim.x) {
        const int l = item / 144, col = (item % 144) * 64 + cl;
        float a0 = 0.f, a1 = 0.f, a2 = 0.f, a3 = 0.f;
        const float* wp = p.ada_w + ((size_t)l * 1024 + kq * 128) * 9216 + col;
#pragma unroll 8
        for (int k = 0; k < 128; ++k) {
            const float w = wp[(size_t)k * 9216]; const int kk = kq * 128 + k;
            a0 = fmaf(scs[kk], w, a0); a1 = fmaf(scs[1024 + kk], w, a1); a2 = fmaf(scs[2048 + kk], w, a2); a3 = fmaf(scs[3072 + kk], w, a3);
        }
        red[(kq * 4 + 0) * 64 + cl] = a0; red[(kq * 4 + 1) * 64 + cl] = a1; red[(kq * 4 + 2) * 64 + cl] = a2; red[(kq * 4 + 3) * 64 + cl] = a3;
        __syncthreads();
        if (kq < 4) {
            const int b = kq; float s = 0.f;
#pragma unroll
            for (int q = 0; q < 8; ++q) s += red[(q * 4 + b) * 64 + cl];
            p.mod[(size_t)(l * 4 + b) * 9216 + col] = s + p.ada_b[(size_t)l * 9216 + col];
        }
        __syncthreads();
    }
}

__device__ __forceinline__ void phase_u0(const Params& p) {
    const size_t n4 = (size_t)NTOK * 256;
    for (size_t i = (size_t)blockIdx.x * NTHR + threadIdx.x; i < n4; i += (size_t)gridDim.x * NTHR) {
        const size_t row = i >> 8; const int c4 = (int)(i & 255) * 4; const int b = (int)(row >> 13);
        const float4 v = *(const float4*)(p.x + row * 1024 + c4);
        const float* md = p.mod + (size_t)(0 * 4 + b) * 9216;
        const float4 sh = *(const float4*)(md + c4), sc = *(const float4*)(md + 1024 + c4);
        ushort4 o; o.x = f2bf(v.x * (1.f + sc.x) + sh.x); o.y = f2bf(v.y * (1.f + sc.y) + sh.y); o.z = f2bf(v.z * (1.f + sc.z) + sh.z); o.w = f2bf(v.w * (1.f + sc.w) + sh.w);
        *(ushort4*)(p.ubuf + row * 1024 + c4) = o;
    }
}

__device__ __forceinline__ void gemm_mainloop(f32x4 (&acc)[4][4], const bf16_t* __restrict__ A, int lda, const bf16_t* __restrict__ Bt, int ldb, int K, char* smem) {
    bf16_t* As = (bf16_t*)smem; bf16_t* Bs = As + 256 * 40;
    int tid_ = threadIdx.x; asm volatile("" : "+v"(tid_));
    const int tid = tid_, lane = tid & 63, wid = tid >> 6, wr = wid >> 1, wc = wid & 1;
    const int lr = tid >> 1, lk = (tid & 1) * 16;
    const int br = (tid & 255) >> 1;
    const bool ldB = tid < 256;
    const uint4* ga = (const uint4*)(A + (size_t)lr * lda + lk);
    const uint4* gb = (const uint4*)(Bt + (size_t)br * ldb + lk);
    uint4 ra0 = ga[0], ra1 = ga[1], rb0 = make_uint4(0, 0, 0, 0), rb1 = rb0;
    if (ldB) { rb0 = gb[0]; rb1 = gb[1]; }
    const int fr = lane & 15, fq = lane >> 4;
    for (int k0 = 0; k0 < K; k0 += 32) {
        __syncthreads();
        *(uint4*)&As[lr * 40 + lk] = ra0; *(uint4*)&As[lr * 40 + lk + 8] = ra1;
        if (ldB) { *(uint4*)&Bs[br * 40 + lk] = rb0; *(uint4*)&Bs[br * 40 + lk + 8] = rb1; }
        __syncthreads();
        if (k0 + 32 < K) { ga += 4; gb += 4; ra0 = ga[0]; ra1 = ga[1]; if (ldB) { rb0 = gb[0]; rb1 = gb[1]; } }
        bf16x8 a[4], b[4];
#pragma unroll
        for (int m = 0; m < 4; ++m) a[m] = *(const bf16x8*)&As[(wr * 64 + m * 16 + fr) * 40 + fq * 8];
#pragma unroll
        for (int n = 0; n < 4; ++n) b[n] = *(const bf16x8*)&Bs[(wc * 64 + n * 16 + fr) * 40 + fq * 8];
#pragma unroll
        for (int m = 0; m < 4; ++m)
#pragma unroll
            for (int n = 0; n < 4; ++n) acc[m][n] = __builtin_amdgcn_mfma_f32_16x16x32_bf16(a[m], b[n], acc[m][n], 0, 0, 0);
    }
}
__device__ __forceinline__ void zero_acc(f32x4 (&acc)[4][4]) {
#pragma unroll
    for (int m = 0; m < 4; ++m)
#pragma unroll
        for (int n = 0; n < 4; ++n) acc[m][n] = (f32x4){0.f, 0.f, 0.f, 0.f};
}
__device__ __forceinline__ void phase_merge(const Params& p, int l, char* smem) {
    const bf16_t* WG = p.wts + (size_t)l * WL_ELEMS + W_GATE; const bf16_t* WB = p.wts + (size_t)l * WL_ELEMS + W_BR;
    const int tid = otid(), lane = tid & 63, wid = tid >> 6, wr = wid >> 1, wc = wid & 1, fr = lane & 15, fq = lane >> 4;
    for (int tile = blockIdx.x; tile < 128 * 8; tile += gridDim.x) {
        const int pm = tile / 8, pn = tile % 8;
        f32x4 accM[4][4]; zero_acc(accM);
#pragma unroll 1
        for (int br = 0; br < 4; ++br) {
            const int koff = br == 0 ? 0 : 128 + (br - 1) * 256, kb = br == 0 ? 128 : 256;
            f32x4 accG[4][4]; zero_acc(accG);
            gemm_mainloop(accG, p.ubuf + (size_t)pm * 256 * 1024, 1024, WG + (size_t)(br * 1024 + pn * 128) * 1024, 1024, 1024, smem);
            const float* bg = p.mix_b_gate + (size_t)l * 4096 + br * 1024;
#pragma unroll
            for (int n = 0; n < 4; ++n) {
                const float bv = bg[pn * 128 + wc * 64 + n * 16 + fr];
#pragma unroll
                for (int m = 0; m < 4; ++m)
#pragma unroll
                    for (int j = 0; j < 4; ++j) accG[m][n][j] = 1.f / (1.f + expf(-(accG[m][n][j] + bv)));
            }
            unsigned* gst = (unsigned*)(smem + 32768) + tid;
#pragma unroll
            for (int m = 0; m < 4; ++m)
#pragma unroll
                for (int n = 0; n < 4; ++n) {
                    gst[((m * 4 + n) * 2 + 0) * NTHR] = (unsigned)f2bf(accG[m][n][0]) | ((unsigned)f2bf(accG[m][n][1]) << 16);
                    gst[((m * 4 + n) * 2 + 1) * NTHR] = (unsigned)f2bf(accG[m][n][2]) | ((unsigned)f2bf(accG[m][n][3]) << 16);
                }
            zero_acc(accG);
            gemm_mainloop(accG, p.ybuf + (size_t)pm * 256 * 896 + koff, 896, WB + (size_t)pn * 128 * 896 + koff, 896, kb, smem);
#pragma unroll
            for (int m = 0; m < 4; ++m)
#pragma unroll
                for (int n = 0; n < 4; ++n) {
                    const unsigned g01 = gst[((m * 4 + n) * 2 + 0) * NTHR], g23 = gst[((m * 4 + n) * 2 + 1) * NTHR];
                    accM[m][n][0] += blo(g01) * accG[m][n][0]; accM[m][n][1] += bhi(g01) * accG[m][n][1];
                    accM[m][n][2] += blo(g23) * accG[m][n][2]; accM[m][n][3] += bhi(g23) * accG[m][n][3];
                }
        }
#pragma unroll
        for (int m = 0; m < 4; ++m)
#pragma unroll
            for (int n = 0; n < 4; ++n)
#pragma unroll
                for (int j = 0; j < 4; ++j)
                    p.merged[(size_t)(pm * 256 + wr * 64 + m * 16 + fq * 4 + j) * 1024 + pn * 128 + wc * 64 + n * 16 + fr] = f2bf(accM[m][n][j]);
    }
}

__device__ __forceinline__ void phase_ln(const Params& p, int l, int s, bool has_next) {
    const int tid_ = otid(), lane = tid_ & 63, wid = tid_ >> 6;
    const float* g = p.ln_g + (size_t)(l * 3 + s) * 1024; const float* bb = p.ln_b + (size_t)(l * 3 + s) * 1024;
    const int nl = s < 2 ? l : l + 1, ns = s < 2 ? s + 1 : 0;
    for (int row = blockIdx.x * NWV + wid; row < NTOK; row += gridDim.x * NWV) {
        float* xr = p.out + (size_t)row * 1024;
        float4 v[4]; float sum = 0.f;
#pragma unroll
        for (int i = 0; i < 4; ++i) { v[i] = *(const float4*)(xr + lane * 4 + 256 * i); sum += (v[i].x + v[i].y) + (v[i].z + v[i].w); }
#pragma unroll
        for (int o = 32; o > 0; o >>= 1) sum += __shfl_xor(sum, o);
        const float mu = sum * (1.f / 1024.f); float q = 0.f;
#pragma unroll
        for (int i = 0; i < 4; ++i) { const float a = v[i].x - mu, b2 = v[i].y - mu, c = v[i].z - mu, d = v[i].w - mu; q += (a * a + b2 * b2) + (c * c + d * d); }
#pragma unroll
        for (int o = 32; o > 0; o >>= 1) q += __shfl_xor(q, o);
        const float rstd = 1.0f / sqrtf(q * (1.f / 1024.f) + 1e-5f);
        const int b = row >> 13;
        const float* md = p.mod + (size_t)(nl * 4 + b) * 9216 + ns * 3072;
#pragma unroll
        for (int i = 0; i < 4; ++i) {
            const int c4 = lane * 4 + 256 * i;
            const float4 gg = *(const float4*)(g + c4), be = *(const float4*)(bb + c4);
            float4 o; o.x = (v[i].x - mu) * rstd * gg.x + be.x; o.y = (v[i].y - mu) * rstd * gg.y + be.y; o.z = (v[i].z - mu) * rstd * gg.z + be.z; o.w = (v[i].w - mu) * rstd * gg.w + be.w;
            *(float4*)(xr + c4) = o;
            if (has_next) {
                const float4 sh = *(const float4*)(md + c4), sc = *(const float4*)(md + 1024 + c4);
                ushort4 u; u.x = f2bf(o.x * (1.f + sc.x) + sh.x); u.y = f2bf(o.y * (1.f + sc.y) + sh.y); u.z = f2bf(o.z * (1.f + sc.z) + sh.z); u.w = f2bf(o.w * (1.f + sc.w) + sh.w);
                *(ushort4*)(p.ubuf + (size_t)row * 1024 + c4) = u;
            }
        }
    }
}

__device__ __forceinline__ void load_row32(float (&q)[32], const bf16_t* row) {
    const uint4* r = (const uint4*)row;
#pragma unroll
    for (int c = 0; c < 4; ++c) { const uint4 v = r[c];
        q[c * 8 + 0] = blo(v.x); q[c * 8 + 1] = bhi(v.x); q[c * 8 + 2] = blo(v.y); q[c * 8 + 3] = bhi(v.y);
        q[c * 8 + 4] = blo(v.z); q[c * 8 + 5] = bhi(v.z); q[c * 8 + 6] = blo(v.w); q[c * 8 + 7] = bhi(v.w); }
}
__device__ __forceinline__ float dot32(const float (&q)[32], const bf16_t* row) {
    const uint4* r = (const uint4*)row; float a = 0.f;
#pragma unroll
    for (int c = 0; c < 4; ++c) { const uint4 v = r[c];
        a = fmaf(q[c * 8 + 0], blo(v.x), a); a = fmaf(q[c * 8 + 1], bhi(v.x), a); a = fmaf(q[c * 8 + 2], blo(v.y), a); a = fmaf(q[c * 8 + 3], bhi(v.y), a);
        a = fmaf(q[c * 8 + 4], blo(v.z), a); a = fmaf(q[c * 8 + 5], bhi(v.z), a); a = fmaf(q[c * 8 + 6], blo(v.w), a); a = fmaf(q[c * 8 + 7], bhi(v.w), a); }
    return a + __shfl_xor(a, 1);
}
__device__ __forceinline__ void axpy32(float (&o)[32], float sc, float pw, const bf16_t* row) {
    const uint4* r = (const uint4*)row;
#pragma unroll
    for (int c = 0; c < 4; ++c) { const uint4 v = r[c];
        o[c * 8 + 0] = fmaf(pw, blo(v.x), o[c * 8 + 0] * sc); o[c * 8 + 1] = fmaf(pw, bhi(v.x), o[c * 8 + 1] * sc);
        o[c * 8 + 2] = fmaf(pw, blo(v.y), o[c * 8 + 2] * sc); o[c * 8 + 3] = fmaf(pw, bhi(v.y), o[c * 8 + 3] * sc);
        o[c * 8 + 4] = fmaf(pw, blo(v.z), o[c * 8 + 4] * sc); o[c * 8 + 5] = fmaf(pw, bhi(v.z), o[c * 8 + 5] * sc);
        o[c * 8 + 6] = fmaf(pw, blo(v.w), o[c * 8 + 6] * sc); o[c * 8 + 7] = fmaf(pw, bhi(v.w), o[c * 8 + 7] * sc); }
}
__device__ __forceinline__ void store_row32(bf16_t* dst, const float (&o)[32], float sc) {
    uint4* r = (uint4*)dst;
#pragma unroll
    for (int c = 0; c < 4; ++c) { uint4 v;
        v.x = (unsigned)f2bf(o[c * 8 + 0] * sc) | ((unsigned)f2bf(o[c * 8 + 1] * sc) << 16); v.y = (unsigned)f2bf(o[c * 8 + 2] * sc) | ((unsigned)f2bf(o[c * 8 + 3] * sc) << 16);
        v.z = (unsigned)f2bf(o[c * 8 + 4] * sc) | ((unsigned)f2bf(o[c * 8 + 5] * sc) << 16); v.w = (unsigned)f2bf(o[c * 8 + 6] * sc) | ((unsigned)f2bf(o[c * 8 + 7] * sc) << 16);
        r[c] = v; }
}
__device__ __forceinline__ void zero32(float (&o)[32]) {
#pragma unroll
    for (int i = 0; i < 32; ++i) o[i] = 0.f;
}

typedef float f32x16 __attribute__((ext_vector_type(16)));
typedef short s16x4 __attribute__((ext_vector_type(4)));
constexpr int FK_PITCH = 72, FV_PITCH = 68;
__device__ __forceinline__ int crow16(int i, int hh) { return (i & 3) + 8 * (i >> 2) + 4 * hh; }
template <int KIND>
__device__ __forceinline__ void flash_unit(const Params& p, int b, int h, int qb, char* smem, int tid) {
    bf16_t* Ks = (bf16_t*)smem;
    bf16_t* Vt = Ks + 2 * 64 * FK_PITCH;
    float* ckl = (float*)(Vt + 2 * 64 * FV_PITCH);
    const int lane = tid & 63, w = tid >> 6, r = lane & 31, hh = lane >> 5;
    const int QOFF = KIND == 0 ? PD : (KIND == 1 ? PB : PC), YOFF = KIND == 0 ? 640 : (KIND == 1 ? 128 : 384);
    const int q0 = qb * 256, qw0 = q0 + 32 * w, tq = qw0 + r;
    const size_t tokb = (size_t)b * SEQ, tok = tokb + tq;
    const float L2E = 1.44269504089f, C1 = 0.125f * 1.44269504089f;
    bf16x8 qf[4];
#pragma unroll
    for (int ks = 0; ks < 4; ++ks) qf[ks] = *(const bf16x8*)(p.proj + tok * NPROJ + QOFF + h * 64 + 16 * ks + 8 * hh);
    float cql = 0.f; if (KIND == 0) cql = p.cum[tok * 4 + h] * L2E;
    const unsigned* mrow = p.maskb + tok * 256;
    f32x16 o0, o1;
#pragma unroll
    for (int i = 0; i < 16; ++i) { o0[i] = 0.f; o1[i] = 0.f; }
    float mrun = -INFINITY, lrun = 0.f;
    const int ntiles = 4 * (qb + 1);
    const int skey = tid >> 3, sch = tid & 7;
    const bf16_t* kg = p.proj + (tokb + skey) * NPROJ + QOFF + 256 + h * 64 + sch * 8;
    const int jfirst = KIND == 2 ? ntiles - 1 : 0;
    uint4 kreg = *(const uint4*)(kg + (size_t)jfirst * 64 * NPROJ), vreg = *(const uint4*)(kg + (size_t)jfirst * 64 * NPROJ + 256);
    float creg = 0.f; if (KIND == 0 && tid < 64) creg = p.cum[(tokb + tid) * 4 + h] * L2E;
    uint2 mreg = make_uint2(0u, 0u); if (KIND == 1) mreg = *(const uint2*)(mrow);
    float run = 0.f;
#pragma unroll 1
    for (int jj = 0; jj < ntiles; ++jj) {
        const int j = KIND == 2 ? ntiles - 1 - jj : jj;
        const int buf = jj & 1;
        bf16_t* ksb = Ks + buf * 64 * FK_PITCH; bf16_t* vtb = Vt + buf * 64 * FV_PITCH; float* cb = ckl + buf * 64;
        *(uint4*)&ksb[skey * FK_PITCH + sch * 8] = kreg;
        {
            bf16_t* vd = vtb + (sch * 8) * FV_PITCH + skey;
            vd[0 * FV_PITCH] = (bf16_t)(vreg.x & 0xffffu); vd[1 * FV_PITCH] = (bf16_t)(vreg.x >> 16);
            vd[2 * FV_PITCH] = (bf16_t)(vreg.y & 0xffffu); vd[3 * FV_PITCH] = (bf16_t)(vreg.y >> 16);
            vd[4 * FV_PITCH] = (bf16_t)(vreg.z & 0xffffu); vd[5 * FV_PITCH] = (bf16_t)(vreg.z >> 16);
            vd[6 * FV_PITCH] = (bf16_t)(vreg.w & 0xffffu); vd[7 * FV_PITCH] = (bf16_t)(vreg.w >> 16);
        }
        if (KIND == 0 && tid < 64) cb[tid] = creg;
        const uint2 mw = mreg;
        if (KIND == 2) { if (__syncthreads_and(run < -60.f)) break; }
        else __syncthreads();
        if (jj + 1 < ntiles) {
            const int jn = KIND == 2 ? j - 1 : j + 1;
            const bf16_t* kn = kg + (size_t)jn * 64 * NPROJ;
            kreg = *(const uint4*)kn; vreg = *(const uint4*)(kn + 256);
            if (KIND == 0 && tid < 64) creg = p.cum[(tokb + jn * 64 + tid) * 4 + h] * L2E;
            if (KIND == 1) mreg = *(const uint2*)(mrow + 2 * jn);
        }
#pragma unroll
        for (int sb = 0; sb < 2; ++sb) {
            const int sub = KIND == 2 ? 1 - sb : sb;
            const int kb = 64 * j + 32 * sub;
            if (KIND == 2 ? (kb > qw0) : (kb > qw0 + 31)) continue;
            f32x16 x;
#pragma unroll
            for (int i = 0; i < 16; ++i) x[i] = 0.f;
#pragma unroll
            for (int ks = 0; ks < 4; ++ks) {
                const bf16x8 a = *(const bf16x8*)&ksb[(32 * sub + r) * FK_PITCH + 16 * ks + 8 * hh];
                x = __builtin_amdgcn_mfma_f32_32x32x16_bf16(a, qf[ks], x, 0, 0, 0);
            }
            if (KIND == 2) {
                const bool diag = (kb == qw0);
                float lk[16], sg[4];
#pragma unroll
                for (int g = 0; g < 4; ++g) {
                    float acc = 0.f;
#pragma unroll
                    for (int e = 0; e < 4; ++e) {
                        const float z = x[4 * g + e] * 0.125f;
                        float lb = fminf(z, 0.f) - 0.69314718056f * __builtin_amdgcn_logf(1.f + __builtin_amdgcn_exp2f(-fabsf(z) * L2E));
                        float l1 = lb - z;
                        if (diag && (kb + 8 * g + 4 * hh + e >= tq)) { lb = -INFINITY; l1 = 0.f; }
                        x[4 * g + e] = lb; lk[4 * g + e] = l1; acc += l1;
                    }
                    sg[g] = acc;
                }
                float sp[4];
#pragma unroll
                for (int g = 0; g < 4; ++g) sp[g] = __shfl_xor(sg[g], 32);
                float after = 0.f;
#pragma unroll
                for (int g = 3; g >= 0; --g) {
                    const float aft = run + after + (hh == 0 ? sp[g] : 0.f);
                    float suf = 0.f;
#pragma unroll
                    for (int e = 3; e >= 0; --e) { const float lb = x[4 * g + e]; x[4 * g + e] = __builtin_amdgcn_exp2f((lb + aft + suf) * L2E); suf += lk[4 * g + e]; }
                    after += sg[g] + sp[g];
                }
                run += after;
            }
            float mt = -INFINITY;
            if (KIND == 0) {
                const bool diag = kb + 31 > qw0;
#pragma unroll
                for (int g = 0; g < 4; ++g) {
                    const f32x4 ck = *(const f32x4*)&cb[32 * sub + 8 * g + 4 * hh];
#pragma unroll
                    for (int e = 0; e < 4; ++e) {
                        float s = fmaf(x[4 * g + e], C1, cql - ck[e]);
                        if (diag && (kb + 8 * g + 4 * hh + e > tq)) s = -INFINITY;
                        x[4 * g + e] = s; mt = fmaxf(mt, s);
                    }
                }
            } else if (KIND == 1) {
                const unsigned wbits = sub == 0 ? mw.x : mw.y;
#pragma unroll
                for (int i = 0; i < 16; ++i) {
                    float s = x[i] * C1;
                    if (!((wbits >> crow16(i, hh)) & 1u)) s = -INFINITY;
                    x[i] = s; mt = fmaxf(mt, s);
                }
            }
            if (KIND != 2) {
            mt = fmaxf(mt, __shfl_xor(mt, 32));
            const float mnew = fmaxf(mrun, mt), msafe = (mnew == -INFINITY) ? 0.f : mnew;
            const float alpha = __builtin_amdgcn_exp2f(mrun - msafe);
            float ps = 0.f;
#pragma unroll
            for (int i = 0; i < 16; ++i) { const float e = __builtin_amdgcn_exp2f(x[i] - msafe); x[i] = e; ps += e; }
            lrun = lrun * alpha + ps; mrun = mnew;
#pragma unroll
            for (int i = 0; i < 16; ++i) { o0[i] *= alpha; o1[i] *= alpha; }
            }
            bf16x8 pf[2];
#pragma unroll
            for (int s = 0; s < 2; ++s) {
                unsigned pk[4];
#pragma unroll
                for (int e = 0; e < 4; ++e) pk[e] = (unsigned)f2bf(x[8 * s + 2 * e]) | ((unsigned)f2bf(x[8 * s + 2 * e + 1]) << 16);
                pf[s] = __builtin_bit_cast(bf16x8, (uint4){pk[0], pk[1], pk[2], pk[3]});
            }
#pragma unroll
            for (int s = 0; s < 2; ++s) {
#pragma unroll
                for (int dt = 0; dt < 2; ++dt) {
                    const bf16_t* vp = vtb + (32 * dt + r) * FV_PITCH + 32 * sub + 16 * s + 4 * hh;
                    const s16x4 lo = *(const s16x4*)vp, hi = *(const s16x4*)(vp + 8);
                    const bf16x8 vf = __builtin_shufflevector(lo, hi, 0, 1, 2, 3, 4, 5, 6, 7);
                    if (dt == 0) o0 = __builtin_amdgcn_mfma_f32_32x32x16_bf16(vf, pf[s], o0, 0, 0, 0);
                    else o1 = __builtin_amdgcn_mfma_f32_32x32x16_bf16(vf, pf[s], o1, 0, 0, 0);
                }
            }
        }
    }
    const float ltot = lrun + __shfl_xor(lrun, 32), inv = KIND == 2 ? 1.f : 1.f / ltot;
    bf16_t* yo = p.ybuf + tok * 896 + YOFF + h * 64;
#pragma unroll
    for (int g = 0; g < 4; ++g) {
        uint2 w0, w1;
        w0.x = (unsigned)f2bf(o0[4 * g] * inv) | ((unsigned)f2bf(o0[4 * g + 1] * inv) << 16); w0.y = (unsigned)f2bf(o0[4 * g + 2] * inv) | ((unsigned)f2bf(o0[4 * g + 3] * inv) << 16);
        w1.x = (unsigned)f2bf(o1[4 * g] * inv) | ((unsigned)f2bf(o1[4 * g + 1] * inv) << 16); w1.y = (unsigned)f2bf(o1[4 * g + 2] * inv) | ((unsigned)f2bf(o1[4 * g + 3] * inv) << 16);
        *(uint2*)(yo + 8 * g + 4 * hh) = w0; *(uint2*)(yo + 32 + 8 * g + 4 * hh) = w1;
    }
}
__device__ __forceinline__ void phase_attn_a(const Params& p, char* smem) {
    const int tid = otid(), lane = tid & 63, w = tid >> 6, r = lane & 31, hh = lane >> 5;
    bf16_t* vt = (bf16_t*)smem + w * (64 * 36);
    const float C1 = 0.125f * 1.44269504089f;
    __syncthreads();
    for (int item = blockIdx.x * NWV + w; item < 2048; item += gridDim.x * NWV) {
        const int hp = item & 1, rho = (item >> 1) & 15, m = (item >> 5) & 15, b = item >> 9;
        const size_t tokb = (size_t)b * SEQ;
        const int tq = 512 * m + rho + 16 * r;
        f32x16 o0, o1;
#pragma unroll
        for (int i = 0; i < 16; ++i) { o0[i] = 0.f; o1[i] = 0.f; }
        float mrun = -INFINITY, lrun = 0.f;
#pragma unroll 1
        for (int g = 0; g < 3; ++g) {
            const int d = g == 0 ? 1 : (g == 1 ? 4 : 16), c = 16 / d, head = 2 * g + hp, nsub = g == 0 ? 20 : (g == 1 ? 8 : 5);
            const int res = rho & (d - 1), n0 = (512 * m + rho - res) / d, nq = n0 + c * r, nmax = n0 + 31 * c, ks0 = n0 - 128;
            bf16x8 qf[4];
#pragma unroll
            for (int ks = 0; ks < 4; ++ks) qf[ks] = *(const bf16x8*)(p.proj + (tokb + tq) * NPROJ + PA + head * 64 + 16 * ks + 8 * hh);
            const bf16_t* kcol = p.proj + tokb * NPROJ + PA + 384 + head * 64;
#pragma unroll 1
            for (int st = 0; st < nsub; ++st) {
                const int kbase = ks0 + 32 * st;
                if (kbase + 31 < 0) continue;
                int kk = kbase + r; kk = kk < 0 ? 0 : (kk > nmax ? nmax : kk);
                const bf16_t* krow = kcol + (size_t)(kk * d + res) * NPROJ + 8 * hh;
                bf16x8 a[4];
#pragma unroll
                for (int ks = 0; ks < 4; ++ks) a[ks] = *(const bf16x8*)(krow + 16 * ks);
                int kv = kbase + (lane >> 1); kv = kv < 0 ? 0 : (kv > nmax ? nmax : kv);
                const uint4* vrow = (const uint4*)(kcol + (size_t)(kv * d + res) * NPROJ + 384 + (lane & 1) * 32);
                uint4 vv[4];
#pragma unroll
                for (int q = 0; q < 4; ++q) vv[q] = vrow[q];
                f32x16 x;
#pragma unroll
                for (int i = 0; i < 16; ++i) x[i] = 0.f;
#pragma unroll
                for (int ks = 0; ks < 4; ++ks) x = __builtin_amdgcn_mfma_f32_32x32x16_bf16(a[ks], qf[ks], x, 0, 0, 0);
                {
                    bf16_t* vd = vt + ((lane & 1) * 32) * 36 + (lane >> 1);
#pragma unroll
                    for (int q = 0; q < 4; ++q) {
                        vd[(8 * q + 0) * 36] = (bf16_t)(vv[q].x & 0xffffu); vd[(8 * q + 1) * 36] = (bf16_t)(vv[q].x >> 16);
                        vd[(8 * q + 2) * 36] = (bf16_t)(vv[q].y & 0xffffu); vd[(8 * q + 3) * 36] = (bf16_t)(vv[q].y >> 16);
                        vd[(8 * q + 4) * 36] = (bf16_t)(vv[q].z & 0xffffu); vd[(8 * q + 5) * 36] = (bf16_t)(vv[q].z >> 16);
                        vd[(8 * q + 6) * 36] = (bf16_t)(vv[q].w & 0xffffu); vd[(8 * q + 7) * 36] = (bf16_t)(vv[q].w >> 16);
                    }
                }
                float mt = -INFINITY;
#pragma unroll
                for (int i = 0; i < 16; ++i) {
                    const int ki = kbase + crow16(i, hh), dist = nq - ki;
                    float s = x[i] * C1;
                    if (ki < 0 || dist < 0 || dist > 128) s = -INFINITY;
                    x[i] = s; mt = fmaxf(mt, s);
                }
                mt = fmaxf(mt, __shfl_xor(mt, 32));
                const float mnew = fmaxf(mrun, mt), msafe = (mnew == -INFINITY) ? 0.f : mnew;
                const float alpha = __builtin_amdgcn_exp2f(mrun - msafe);
                float ps = 0.f;
#pragma unroll
                for (int i = 0; i < 16; ++i) { const float e = __builtin_amdgcn_exp2f(x[i] - msafe); x[i] = e; ps += e; }
                lrun = lrun * alpha + ps; mrun = mnew;
#pragma unroll
                for (int i = 0; i < 16; ++i) { o0[i] *= alpha; o1[i] *= alpha; }
                bf16x8 pf[2];
#pragma unroll
                for (int s = 0; s < 2; ++s) {
                    unsigned pk[4];
#pragma unroll
                    for (int e = 0; e < 4; ++e) pk[e] = (unsigned)f2bf(x[8 * s + 2 * e]) | ((unsigned)f2bf(x[8 * s + 2 * e + 1]) << 16);
                    pf[s] = __builtin_bit_cast(bf16x8, (uint4){pk[0], pk[1], pk[2], pk[3]});
                }
                asm volatile("s_waitcnt lgkmcnt(0)" ::: "memory");
#pragma unroll
                for (int s = 0; s < 2; ++s) {
#pragma unroll
                    for (int dt = 0; dt < 2; ++dt) {
                        const bf16_t* vp = vt + (32 * dt + r) * 36 + 16 * s + 4 * hh;
                        const s16x4 lo = *(const s16x4*)vp, hi = *(const s16x4*)(vp + 8);
                        const bf16x8 vf = __builtin_shufflevector(lo, hi, 0, 1, 2, 3, 4, 5, 6, 7);
                        if (dt == 0) o0 = __builtin_amdgcn_mfma_f32_32x32x16_bf16(vf, pf[s], o0, 0, 0, 0);
                        else o1 = __builtin_amdgcn_mfma_f32_32x32x16_bf16(vf, pf[s], o1, 0, 0, 0);
                    }
                }
                asm volatile("s_waitcnt lgkmcnt(0)" ::: "memory");
            }
        }
        const float ltot = lrun + __shfl_xor(lrun, 32), inv = 1.f / ltot;
        bf16_t* yo = p.ybuf + (tokb + tq) * 896 + hp * 64;
#pragma unroll
        for (int g = 0; g < 4; ++g) {
            uint2 w0, w1;
            w0.x = (unsigned)f2bf(o0[4 * g] * inv) | ((unsigned)f2bf(o0[4 * g + 1] * inv) << 16); w0.y = (unsigned)f2bf(o0[4 * g + 2] * inv) | ((unsigned)f2bf(o0[4 * g + 3] * inv) << 16);
            w1.x = (unsigned)f2bf(o1[4 * g] * inv) | ((unsigned)f2bf(o1[4 * g + 1] * inv) << 16); w1.y = (unsigned)f2bf(o1[4 * g + 2] * inv) | ((unsigned)f2bf(o1[4 * g + 3] * inv) << 16);
            *(uint2*)(yo + 8 * g + 4 * hh) = w0; *(uint2*)(yo + 32 + 8 * g + 4 * hh) = w1;
        }
    }
}
__device__ __forceinline__ void phase_flash(const Params& p, char* smem) {
    const int tid = otid();
    for (int it = blockIdx.x; it < 768; it += gridDim.x) {
        const int kind = it >> 8, c = it & 255, bh = c & 15, qs = c >> 4;
#pragma unroll 1
        for (int half = 0; half < 2; ++half) {
            const int qb = half ? 31 - qs : qs;
            __syncthreads();
            if (kind == 0) flash_unit<0>(p, bh >> 2, bh & 3, qb, smem, tid);
            else if (kind == 1) flash_unit<1>(p, bh >> 2, bh & 3, qb, smem, tid);
            else flash_unit<2>(p, bh >> 2, bh & 3, qb, smem, tid);
        }
    }
}
__device__ __forceinline__ void phase_scan(const Params& p, char* smem) {
    double* part = (double*)smem;
    const int tid = otid();
    for (int item = blockIdx.x; item < 16; item += gridDim.x) {
        const int b = item >> 2, h = item & 3;
        const float* lf = p.logf + ((size_t)b * SEQ + tid * 16) * 4 + h;
        double s = 0.0;
        for (int i = 0; i < 16; ++i) s += (double)lf[i * 4];
        __syncthreads();
        part[tid] = s;
        __syncthreads();
        if (tid == 0) { double r = 0.0; for (int i = 0; i < NTHR; ++i) { const double v = part[i]; part[i] = r; r += v; } }
        __syncthreads();
        double r = part[tid];
        float* cm = p.cum + ((size_t)b * SEQ + tid * 16) * 4 + h;
        for (int i = 0; i < 16; ++i) { r += (double)lf[i * 4]; cm[i * 4] = (float)r; }
    }
}
__device__ __forceinline__ unsigned f2key(float f) { const unsigned u = __float_as_uint(f); return (u & 0x80000000u) ? ~u : (u | 0x80000000u); }
constexpr int HPITCH = 1028;
template <int PASS>
__device__ __forceinline__ void idx_pass(const Params& p, size_t tokb, int t0, int ktmax, const bf16x8 (&qf)[4][4], float w0, float w1, float w2, float w3,
                                         unsigned* hist, const unsigned* qpre, unsigned* gtb, unsigned* eqb, int lane, int w) {
    const int r = lane & 31, hh = lane >> 5, tq = t0 + r;
    unsigned pre = 0u; if (PASS >= 1) pre = qpre[r];
    unsigned* hrow = hist + r * HPITCH;
    const bf16_t* kbase = p.proj + (tokb + r) * NPROJ + PIK + 8 * hh;
    uint4 an[4];
    if (w <= ktmax) {
#pragma unroll
        for (int ks = 0; ks < 4; ++ks) an[ks] = *(const uint4*)(kbase + (size_t)w * 32 * NPROJ + 16 * ks);
    }
#pragma unroll 1
    for (int kt = w; kt <= ktmax; kt += 8) {
        bf16x8 a[4];
#pragma unroll
        for (int ks = 0; ks < 4; ++ks) a[ks] = __builtin_bit_cast(bf16x8, an[ks]);
        if (kt + 8 <= ktmax) {
#pragma unroll
            for (int ks = 0; ks < 4; ++ks) an[ks] = *(const uint4*)(kbase + (size_t)(kt + 8) * 32 * NPROJ + 16 * ks);
        }
        f32x16 x0, x1, x2, x3;
#pragma unroll
        for (int i = 0; i < 16; ++i) { x0[i] = 0.f; x1[i] = 0.f; x2[i] = 0.f; x3[i] = 0.f; }
#pragma unroll
        for (int ks = 0; ks < 4; ++ks) {
            x0 = __builtin_amdgcn_mfma_f32_32x32x16_bf16(a[ks], qf[0][ks], x0, 0, 0, 0);
            x1 = __builtin_amdgcn_mfma_f32_32x32x16_bf16(a[ks], qf[1][ks], x1, 0, 0, 0);
            x2 = __builtin_amdgcn_mfma_f32_32x32x16_bf16(a[ks], qf[2][ks], x2, 0, 0, 0);
            x3 = __builtin_amdgcn_mfma_f32_32x32x16_bf16(a[ks], qf[3][ks], x3, 0, 0, 0);
        }
        const int kb = kt * 32;
        const bool diag = (kt == ktmax);
        unsigned gw = 0u, ew = 0u;
#pragma unroll
        for (int i = 0; i < 16; ++i) {
            float v = w0 * fmaxf(x0[i], 0.f);
            v = fmaf(w1, fmaxf(x1[i], 0.f), v); v = fmaf(w2, fmaxf(x2[i], 0.f), v); v = fmaf(w3, fmaxf(x3[i], 0.f), v);
            v += 0.0f;
            const unsigned key = f2key(v);
            const int kr = crow16(i, hh);
            const bool valid = !diag || (kb + kr <= tq);
            if (PASS == 0) { if (valid) { const unsigned d = key >> 21; atomicAdd(&hrow[d >> 1], (d & 1u) ? 65536u : 1u); } }
            if (PASS == 1) { if (valid && (key >> 21) == pre) { const unsigned d = (key >> 10) & 2047u; atomicAdd(&hrow[d >> 1], (d & 1u) ? 65536u : 1u); } }
            if (PASS == 2) { if (valid && (key >> 10) == pre) { const unsigned d = key & 1023u; atomicAdd(&hrow[d >> 1], (d & 1u) ? 65536u : 1u); } }
            if (PASS == 3) { gw |= ((valid && key > pre) ? 1u : 0u) << kr; ew |= ((valid && key == pre) ? 1u : 0u) << kr; }
        }
        if (PASS == 3) {
            gw |= __shfl_xor(gw, 32); ew |= __shfl_xor(ew, 32);
            if (hh == 0) { gtb[r * 256 + kt] = gw; eqb[r * 256 + kt] = ew; }
        }
    }
}
__device__ __forceinline__ void idx_search(const unsigned* hist, unsigned* qpre, unsigned* qneed, int shift, int lane, int w) {
#pragma unroll 1
    for (int qi = 0; qi < 4; ++qi) {
        const int q = 4 * w + qi;
        const unsigned need = qneed[q];
        const uint4* hr = (const uint4*)(hist + q * HPITCH + 16 * lane);
        unsigned wr[16];
#pragma unroll
        for (int c = 0; c < 4; ++c) { const uint4 v = hr[c]; wr[4 * c] = v.x; wr[4 * c + 1] = v.y; wr[4 * c + 2] = v.z; wr[4 * c + 3] = v.w; }
        unsigned mine = 0u;
#pragma unroll
        for (int c = 0; c < 16; ++c) mine += (wr[c] & 0xffffu) + (wr[c] >> 16);
        unsigned tot = mine;
#pragma unroll
        for (int o = 1; o < 64; o <<= 1) { const unsigned v = __shfl_down(tot, o); if (lane + o < 64) tot += v; }
        const unsigned excl = tot - mine;
        if (excl < need && tot >= need) {
            unsigned cum = excl, nrem = 0u; int dsel = -1;
#pragma unroll
            for (int c = 15; c >= 0; --c) {
                const unsigned hi = wr[c] >> 16, lo = wr[c] & 0xffffu;
                if (dsel < 0) { if (cum + hi >= need) { dsel = 2 * (16 * lane + c) + 1; nrem = need - cum; } else cum += hi; }
                if (dsel < 0) { if (cum + lo >= need) { dsel = 2 * (16 * lane + c); nrem = need - cum; } else cum += lo; }
            }
            qpre[q] = (qpre[q] << shift) | (unsigned)dsel; qneed[q] = nrem;
        }
    }
}
__device__ __forceinline__ void phase_topk(const Params& p, char* smem) {
    unsigned* hist = (unsigned*)smem;
    unsigned* gtb = hist;
    unsigned* eqb = hist + 32 * 256;
    unsigned* qpre = hist + 32 * HPITCH;
    unsigned* qneed = qpre + 32;
    const int tid = otid(), lane = tid & 63, w = tid >> 6;
    for (int it = blockIdx.x; it < 256; it += gridDim.x) {
#pragma unroll 1
        for (int sub = 0; sub < 4; ++sub) {
            const int u = sub == 0 ? it : (sub == 1 ? 511 - it : (sub == 2 ? 512 + it : 1023 - it));
            const int b = u & 3, blk = u >> 2, t0 = blk * 32;
            const size_t tokb = (size_t)b * SEQ;
            if (t0 + 32 <= 256) {
                for (int i = tid; i < 32 * 256; i += NTHR) {
                    const int q = i >> 8, k = i & 255, n = t0 + q + 1, lo = k * 32;
                    p.maskb[(tokb + t0 + q) * 256 + k] = (lo + 32 <= n) ? 0xffffffffu : (lo >= n ? 0u : ((1u << (n - lo)) - 1u));
                }
                continue;
            }
            const int r = lane & 31, hh = lane >> 5;
            const size_t tok = tokb + t0 + r;
            bf16x8 qf[4][4];
#pragma unroll
            for (int h = 0; h < 4; ++h)
#pragma unroll
                for (int ks = 0; ks < 4; ++ks) qf[h][ks] = *(const bf16x8*)(p.proj + tok * NPROJ + PIQ + h * 64 + 16 * ks + 8 * hh);
            const f32x4 wv = *(const f32x4*)(p.iw + tok * 4);
            const int ktmax = blk;
            __syncthreads();
            if (tid < 32) { qpre[tid] = 0u; qneed[tid] = 256u; }
#pragma unroll 1
            for (int pass = 0; pass < 3; ++pass) {
                for (int i = tid; i < 32 * HPITCH / 4; i += NTHR) ((uint4*)hist)[i] = make_uint4(0u, 0u, 0u, 0u);
                __syncthreads();
                if (pass == 0) idx_pass<0>(p, tokb, t0, ktmax, qf, wv[0], wv[1], wv[2], wv[3], hist, qpre, gtb, eqb, lane, w);
                else if (pass == 1) idx_pass<1>(p, tokb, t0, ktmax, qf, wv[0], wv[1], wv[2], wv[3], hist, qpre, gtb, eqb, lane, w);
                else idx_pass<2>(p, tokb, t0, ktmax, qf, wv[0], wv[1], wv[2], wv[3], hist, qpre, gtb, eqb, lane, w);
                __syncthreads();
                idx_search(hist, qpre, qneed, pass == 2 ? 10 : 11, lane, w);
                __syncthreads();
            }
            for (int i = tid; i < 2 * 32 * 256 / 4; i += NTHR) ((uint4*)hist)[i] = make_uint4(0u, 0u, 0u, 0u);
            __syncthreads();
            idx_pass<3>(p, tokb, t0, ktmax, qf, wv[0], wv[1], wv[2], wv[3], hist, qpre, gtb, eqb, lane, w);
            __syncthreads();
#pragma unroll 1
            for (int qi = 0; qi < 4; ++qi) {
                const int q = 4 * w + qi; const unsigned rr = qneed[q];
                const uint4 g4 = *(const uint4*)&gtb[q * 256 + 4 * lane]; const uint4 e4 = *(const uint4*)&eqb[q * 256 + 4 * lane];
                unsigned ev[4] = {e4.x, e4.y, e4.z, e4.w}, gv[4] = {g4.x, g4.y, g4.z, g4.w};
                const unsigned mine = __popc(ev[0]) + __popc(ev[1]) + __popc(ev[2]) + __popc(ev[3]);
                unsigned incl = mine;
#pragma unroll
                for (int o = 1; o < 64; o <<= 1) { const unsigned v = __shfl_up(incl, o); if (lane >= o) incl += v; }
                unsigned rank = incl - mine;
#pragma unroll
                for (int c = 0; c < 4; ++c) {
                    unsigned e = ev[c]; const unsigned pc = __popc(e);
                    if (rank + pc > rr) {
                        unsigned keep = rank < rr ? rr - rank : 0u, sel = 0u;
                        while (keep > 0u) { const unsigned low = e & (0u - e); sel |= low; e ^= low; --keep; }
                        e = sel;
                    }
                    gv[c] |= e; rank += pc;
                }
                *(uint4*)&p.maskb[(tokb + t0 + q) * 256 + 4 * lane] = make_uint4(gv[0], gv[1], gv[2], gv[3]);
            }
        }
    }
}

namespace pg8 {
#define PG8_LAS __attribute__((address_space(3)))
typedef unsigned short bf16_t;
typedef short bf16x8 __attribute__((ext_vector_type(8)));
typedef float f32x4 __attribute__((ext_vector_type(4)));
typedef unsigned u32x4 __attribute__((ext_vector_type(4)));
constexpr int BM = 256, BK = 64, HALF = 128, HTB = HALF * BK * 2  , STAGE_BYTES = 8 * HTB, NXCD = 8, WGM = 8;

__host__ __device__ __forceinline__ int lds_byte(int r, int c) { const int st = (r >> 4) * 2 + (c >> 5), rr = r & 15, cc = c & 31, ob = rr * 64 + cc * 2; return st * 1024 + (ob ^ (((ob >> 9) & 1) << 5)); }
__host__ __device__ __forceinline__ void stage_rc(int b, int& R, int& C) { const int st = b / 1024, sb = b % 1024, swz = sb ^ (((sb >> 9) & 1) << 5); R = (st >> 1) * 16 + swz / 64; C = (st & 1) * 32 + (swz % 64) / 2; }
__host__ __device__ __forceinline__ int perm32(int rho) { const int n = rho >> 4, i = rho & 15; return 8 * (i >> 2) + 4 * n + (i & 3); }

struct Unit { int pm, pn; };
struct Gemm { const bf16_t* A; const bf16_t* Bt; int M, N, K; };

struct StaticOrder {
    int nM, nN, nwg, G, c;
    __host__ __device__ void init(int M, int N, int G_, int c_) { nM = M / BM; nN = N / BM; nwg = nM * nN; G = G_; c = c_; }
    __host__ __device__ bool next(int i, Unit& u) const {
        const long L = (long)i * G + c; if (L >= nwg) return false;
        int wgid = (int)L; { const int q = nwg / NXCD, r = nwg % NXCD, xcd = wgid % NXCD, off = wgid / NXCD; wgid = (xcd < r ? xcd * (q + 1) : r * (q + 1) + (xcd - r) * q) + off; }
        const int nig = WGM * nN, gid = wgid / nig, fm = gid * WGM, gsz = (nM - fm) < WGM ? (nM - fm) : WGM;
        u.pm = fm + ((wgid % nig) % gsz); u.pn = (wgid % nig) / gsz; return true;
    }
    __device__ __forceinline__ void a_ready(const Unit&) const {}
    __device__ __forceinline__ void done(const Unit&) const {}
};

__device__ __forceinline__ unsigned cvt_pk_bf16(float lo, float hi) { unsigned r; asm volatile("v_cvt_pk_bf16_f32 %0, %1, %2" : "=v"(r) : "v"(lo), "v"(hi)); return r; }
__device__ __forceinline__ float silu_f(float g) { return g / (1.f + __expf(-g)); }
struct EpiSwiGLU {
    static constexpr bool PERM = true, AFTER_DRAIN = false;
    bf16_t* O;
    __device__ __forceinline__ void operator()(const f32x4 (&acc)[2][2][4][2], const Unit& u, int wr, int wc, int fr, int fq) const {
        const int row0 = u.pm * BM + wr * 64 + fr, col0 = u.pn * 128 + wc * 32 + 8 * fq;
#pragma unroll
        for (int ai = 0; ai < 2; ++ai)
#pragma unroll
            for (int m = 0; m < 4; ++m) {
                bf16_t* rowp = O + (size_t)(row0 + ai * HALF + m * 16) * 2816 + col0;
                const f32x4 g0 = acc[ai][0][m][0], g1 = acc[ai][0][m][1], u0 = acc[ai][1][m][0], u1 = acc[ai][1][m][1];
                u32x4 w;
                w.x = cvt_pk_bf16(silu_f(g0[0]) * u0[0], silu_f(g0[1]) * u0[1]); w.y = cvt_pk_bf16(silu_f(g0[2]) * u0[2], silu_f(g0[3]) * u0[3]);
                w.z = cvt_pk_bf16(silu_f(g1[0]) * u1[0], silu_f(g1[1]) * u1[1]); w.w = cvt_pk_bf16(silu_f(g1[2]) * u1[2], silu_f(g1[3]) * u1[3]);
                *(u32x4*)rowp = w;
            }
    }
};
struct EpiRes {
    static constexpr bool PERM = false, AFTER_DRAIN = false;
    const float* xres; float* out; const float* modl; int sub; float fac;
    __device__ __forceinline__ void operator()(const f32x4 (&acc)[2][2][4][2], const Unit& u, int wr, int wc, int fr, int fq) const {
        const int b = (u.pm * BM) >> 13;
        const float* gate = modl + (size_t)b * 9216 + sub * 3072 + 2048;
        const int col0 = u.pn * BM + wc * 32 + 4 * fq;
#pragma unroll
        for (int bj = 0; bj < 2; ++bj)
#pragma unroll
            for (int n = 0; n < 2; ++n) {
                const int col = col0 + bj * HALF + n * 16;
                f32x4 gm = *(const f32x4*)(gate + col); gm = (gm + 1.0f) * fac;
#pragma unroll
                for (int ai = 0; ai < 2; ++ai)
#pragma unroll
                    for (int m = 0; m < 4; ++m) {
                        const size_t off = (size_t)(u.pm * BM + ai * HALF + wr * 64 + m * 16 + fr) * 1024 + col;
                        const f32x4 xr = *(const f32x4*)(xres + off);
                        *(f32x4*)(out + off) = xr * 1.41421356237f + gm * acc[ai][bj][m][n];
                    }
            }
    }
};
struct EpiInproj {
    static constexpr bool PERM = true, AFTER_DRAIN = false;
    bf16_t* proj; const float* rope; float* iw; float* logf; const float* bfg;
    __device__ __forceinline__ void operator()(const f32x4 (&acc)[2][2][4][2], const Unit& u, int wr, int wc, int fr, int fq) const {
#pragma unroll
        for (int bj = 0; bj < 2; ++bj) {
            const int cb32 = u.pn * BM + bj * HALF + wc * 32;
            const bool rp = ((cb32 & 63) == 0) && (cb32 < 768 || (cb32 >= 1152 && cb32 < 1664) || (cb32 >= 1920 && cb32 < 2240));
#pragma unroll
            for (int ai = 0; ai < 2; ++ai)
#pragma unroll
                for (int m = 0; m < 4; ++m) {
                    const int row = u.pm * BM + ai * HALF + wr * 64 + m * 16 + fr;
                    f32x4 v0 = acc[ai][bj][m][0], v1 = acc[ai][bj][m][1];
                    if (rp) {
                        const int t = row & 8191;
                        const f32x4* rt = (const f32x4*)(rope + (size_t)t * 16);
                        const f32x4 r0 = rt[0], r1 = rt[1], r2 = rt[2], r3 = rt[3];
                        f32x4 p0, p1;
#pragma unroll
                        for (int j = 0; j < 4; ++j) { p0[j] = __shfl_xor(v0[j], 16); p1[j] = __shfl_xor(v1[j], 16); }
                        if (fq == 0) {
                            v0[0] = v0[0] * r0[0] - p0[0] * r0[1]; v0[1] = v0[1] * r0[2] - p0[1] * r0[3]; v0[2] = v0[2] * r1[0] - p0[2] * r1[1]; v0[3] = v0[3] * r1[2] - p0[3] * r1[3];
                            v1[0] = v1[0] * r2[0] - p1[0] * r2[1]; v1[1] = v1[1] * r2[2] - p1[1] * r2[3]; v1[2] = v1[2] * r3[0] - p1[2] * r3[1]; v1[3] = v1[3] * r3[2] - p1[3] * r3[3];
                        } else if (fq == 1) {
                            v0[0] = v0[0] * r0[0] + p0[0] * r0[1]; v0[1] = v0[1] * r0[2] + p0[1] * r0[3]; v0[2] = v0[2] * r1[0] + p0[2] * r1[1]; v0[3] = v0[3] * r1[2] + p0[3] * r1[3];
                            v1[0] = v1[0] * r2[0] + p1[0] * r2[1]; v1[1] = v1[1] * r2[2] + p1[1] * r2[3]; v1[2] = v1[2] * r3[0] + p1[2] * r3[1]; v1[3] = v1[3] * r3[2] + p1[3] * r3[3];
                        }
                    }
                    u32x4 w; w.x = cvt_pk_bf16(v0[0], v0[1]); w.y = cvt_pk_bf16(v0[2], v0[3]); w.z = cvt_pk_bf16(v1[0], v1[1]); w.w = cvt_pk_bf16(v1[2], v1[3]);
                    *(u32x4*)(proj + (size_t)row * 3840 + cb32 + 8 * fq) = w;
                    if (cb32 == 3776 && fq == 0) {
                        *(f32x4*)(iw + (size_t)row * 4) = v0;
                        f32x4 lf;
#pragma unroll
                        for (int j = 0; j < 4; ++j) { const float xx = v1[j] + bfg[j]; lf[j] = fminf(xx, 0.f) - log1pf(expf(-fabsf(xx))); }
                        *(f32x4*)(logf + (size_t)row * 4) = lf;
                    }
                }
        }
    }
};
template <class Epi, class Sched, bool ALIGN_EPI = false, bool SP2 = false>
__device__ __forceinline__ void gemm_phase(PG8_LAS unsigned char* lds, const Gemm g, const Sched& S, const Epi& E) {
    int tid_ = threadIdx.x; asm volatile("" : "+v"(tid_));
    const int tid = tid_, wid = __builtin_amdgcn_readfirstlane(tid >> 6), lane = tid & 63, wr = wid >> 2, wc = wid & 3, fr = lane & 15, fq = lane >> 4;
    const int K = g.K, nt = K / BK;
    unsigned voffA[2], voffB[2];
#pragma unroll
    for (int i = 0; i < 2; ++i) { int R, C; stage_rc(tid * 16 + i * 8192, R, C); const int Rb = Epi::PERM ? ((R & ~31) + perm32(R & 31)) : R;
        voffA[i] = (unsigned)(R * K + C) * 2u; voffB[i] = (unsigned)(Rb * K + C) * 2u; }
    const size_t kstep = (size_t)(BK * 2);
    const size_t hstep = (size_t)HALF * K * 2;
    const size_t tstep = 2 * hstep;
    const unsigned ldsw = (unsigned)wid * 1024u;
    const int aoff = lds_byte(wr * 64 + fr, fq * 8), boff = lds_byte(wc * 32 + fr, fq * 8);
#define PG8_SA(b, h) (((b) * 2 + (h)) * HTB)
#define PG8_SB(b, h) ((4 + (b) * 2 + (h)) * HTB)
#define PG8_STAGE(bufoff, gbase, voff) do { _Pragma("unroll") for (int _i = 0; _i < 2; ++_i) \
        __builtin_amdgcn_global_load_lds((const unsigned*)((const char*)(gbase) + (voff)[_i]), (PG8_LAS unsigned*)(lds + (bufoff) + ldsw + _i * 8192), 16, 0, 0); } while (0)
#define PG8_LDA(dst, b, h) do { _Pragma("unroll") for (int m = 0; m < 4; ++m) _Pragma("unroll") for (int k = 0; k < 2; ++k) dst[m][k] = *(const PG8_LAS bf16x8*)(lds + PG8_SA(b, h) + aoff + m * 2048 + k * 1024); } while (0)
#define PG8_LDB(dst, b, h) do { _Pragma("unroll") for (int n = 0; n < 2; ++n) _Pragma("unroll") for (int k = 0; k < 2; ++k) dst[n][k] = *(const PG8_LAS bf16x8*)(lds + PG8_SB(b, h) + boff + n * 2048 + k * 1024); } while (0)
#define PG8_MMA(ai, bj, At, Bt) do { __builtin_amdgcn_s_setprio(1); _Pragma("unroll") for (int m = 0; m < 4; ++m) _Pragma("unroll") for (int n = 0; n < 2; ++n) _Pragma("unroll") for (int k = 0; k < 2; ++k) \
        acc[ai][bj][m][n] = __builtin_amdgcn_mfma_f32_16x16x32_bf16(Bt[n][k], At[m][k], acc[ai][bj][m][n], 0, 0, 0); __builtin_amdgcn_s_setprio(0); } while (0)
#define PG8_WAIT_V(n) asm volatile("s_waitcnt vmcnt(" #n ")" ::: "memory")
#define PG8_WAIT_L(n) asm volatile("s_waitcnt lgkmcnt(" #n ")" ::: "memory")
#define PG8_BAR __builtin_amdgcn_s_barrier()
#define PG8_SCHED __builtin_amdgcn_sched_barrier(0)
    Unit cur, nxt; int ui = 0;
    if (!S.next(0, cur)) return;
    f32x4 acc[2][2][4][2];
#pragma unroll
    for (int a = 0; a < 2; ++a)
#pragma unroll
        for (int b = 0; b < 2; ++b)
#pragma unroll
            for (int m = 0; m < 4; ++m)
#pragma unroll
                for (int n = 0; n < 2; ++n) acc[a][b][m][n] = (f32x4){0.f, 0.f, 0.f, 0.f};
    bf16x8 At[4][2], B0[2][2], B1[2][2];
    const char* cA = (const char*)g.A + (size_t)cur.pm * tstep; const char* cB = (const char*)g.Bt + (size_t)cur.pn * tstep;
    S.a_ready(cur);
    if constexpr (SP2) {
        PG8_STAGE(PG8_SB(0, 0), cB, voffB); PG8_STAGE(PG8_SB(0, 1), cB + hstep, voffB); PG8_STAGE(PG8_SA(0, 0), cA, voffA); PG8_STAGE(PG8_SA(0, 1), cA + hstep, voffA);
        if (wr == 1) PG8_BAR;
        PG8_WAIT_V(2); PG8_BAR;
        PG8_STAGE(PG8_SB(1, 0), cB + kstep, voffB); PG8_STAGE(PG8_SA(1, 0), cA + kstep, voffA); PG8_STAGE(PG8_SB(1, 1), cB + hstep + kstep, voffB);
        PG8_WAIT_V(6); PG8_BAR;
    } else {
        PG8_STAGE(PG8_SB(0, 0), cB, voffB); PG8_STAGE(PG8_SA(0, 0), cA, voffA); PG8_STAGE(PG8_SB(0, 1), cB + hstep, voffB); PG8_STAGE(PG8_SA(0, 1), cA + hstep, voffA);
        if (wr == 1) PG8_BAR;
        PG8_WAIT_V(4); PG8_BAR;
        PG8_STAGE(PG8_SB(1, 0), cB + kstep, voffB); PG8_STAGE(PG8_SA(1, 0), cA + kstep, voffA); PG8_STAGE(PG8_SB(1, 1), cB + hstep + kstep, voffB);
        PG8_WAIT_V(6); PG8_BAR;
    }
    for (;;) {
        const bool has_next = S.next(ui + 1, nxt);
        const char* nA = has_next ? (const char*)g.A + (size_t)nxt.pm * tstep : cA; const char* nB = has_next ? (const char*)g.Bt + (size_t)nxt.pn * tstep : cB;
        for (int t = 0; t < nt; t += 2) {
            const bool last = (t == nt - 2);
            const char* a1 = cA + (size_t)(t + 1) * kstep;
            const char* a2 = last ? nA : cA + (size_t)(t + 2) * kstep; const char* b2 = last ? nB : cB + (size_t)(t + 2) * kstep;
            const char* a3 = a2 + kstep; const char* b3 = b2 + kstep;
            if (last && has_next) S.a_ready(nxt);
            if constexpr (SP2) {
            PG8_LDB(B0, 0, 0); PG8_LDB(B1, 0, 1); PG8_SCHED; PG8_LDA(At, 0, 0); PG8_STAGE(PG8_SA(1, 1), a1 + hstep, voffA);
            PG8_WAIT_V(8); PG8_WAIT_L(0); PG8_BAR; PG8_MMA(0, 0, At, B0); PG8_MMA(0, 1, At, B1); PG8_BAR; PG8_SCHED;
            PG8_LDA(At, 0, 1); PG8_STAGE(PG8_SB(0, 0), b2, voffB); PG8_STAGE(PG8_SB(0, 1), b2 + hstep, voffB); PG8_STAGE(PG8_SA(0, 0), a2, voffA);
            PG8_WAIT_V(8); PG8_WAIT_L(0); PG8_BAR; PG8_MMA(1, 0, At, B0); PG8_MMA(1, 1, At, B1); PG8_BAR; PG8_SCHED;
            PG8_LDB(B0, 1, 0); PG8_LDB(B1, 1, 1); PG8_SCHED; PG8_LDA(At, 1, 0); PG8_STAGE(PG8_SA(0, 1), a2 + hstep, voffA);
            PG8_WAIT_V(8); PG8_WAIT_L(0); PG8_BAR; PG8_MMA(0, 0, At, B0); PG8_MMA(0, 1, At, B1); PG8_BAR; PG8_SCHED;
            PG8_LDA(At, 1, 1); PG8_STAGE(PG8_SB(1, 0), b3, voffB); PG8_STAGE(PG8_SB(1, 1), b3 + hstep, voffB); PG8_STAGE(PG8_SA(1, 0), a3, voffA);
            PG8_WAIT_V(8); PG8_WAIT_L(0); PG8_BAR; PG8_MMA(1, 0, At, B0); PG8_MMA(1, 1, At, B1); PG8_BAR; PG8_SCHED;
            } else {
            PG8_LDB(B0, 0, 0); PG8_SCHED; PG8_LDA(At, 0, 0); PG8_STAGE(PG8_SA(1, 1), a1 + hstep, voffA);
            PG8_WAIT_L(8); PG8_BAR; PG8_WAIT_L(0); PG8_MMA(0, 0, At, B0); PG8_BAR; PG8_SCHED;
            PG8_LDB(B1, 0, 1); PG8_STAGE(PG8_SB(0, 0), b2, voffB);
            PG8_BAR; PG8_WAIT_L(0); PG8_MMA(0, 1, At, B1); PG8_BAR;
            PG8_LDA(At, 0, 1); PG8_STAGE(PG8_SA(0, 0), a2, voffA);
            PG8_BAR; PG8_WAIT_L(0); PG8_MMA(1, 0, At, B0); PG8_BAR; PG8_SCHED;
            PG8_STAGE(PG8_SB(0, 1), b2 + hstep, voffB);
            PG8_WAIT_V(6); PG8_BAR; PG8_MMA(1, 1, At, B1); PG8_BAR;
            PG8_LDB(B0, 1, 0); PG8_SCHED; PG8_LDA(At, 1, 0); PG8_STAGE(PG8_SA(0, 1), a2 + hstep, voffA);
            PG8_WAIT_L(8); PG8_BAR; PG8_WAIT_L(0); PG8_MMA(0, 0, At, B0); PG8_BAR; PG8_SCHED;
            PG8_LDB(B1, 1, 1); PG8_STAGE(PG8_SB(1, 0), b3, voffB);
            PG8_BAR; PG8_WAIT_L(0); PG8_MMA(0, 1, At, B1); PG8_BAR;
            PG8_LDA(At, 1, 1); PG8_STAGE(PG8_SA(1, 0), a3, voffA);
            PG8_BAR; PG8_WAIT_L(0); PG8_MMA(1, 0, At, B0); PG8_BAR; PG8_SCHED;
            PG8_STAGE(PG8_SB(1, 1), b3 + hstep, voffB);
            PG8_WAIT_V(6); PG8_BAR; PG8_MMA(1, 1, At, B1); PG8_BAR;
            }
        }
        if constexpr (ALIGN_EPI) { if (wr == 0) PG8_BAR; }
        if constexpr (!Epi::AFTER_DRAIN) { E(acc, cur, wr, wc, fr, fq); S.done(cur); }
        if (!has_next) break;
#pragma unroll
        for (int a = 0; a < 2; ++a)
#pragma unroll
            for (int b = 0; b < 2; ++b)
#pragma unroll
                for (int m = 0; m < 4; ++m)
#pragma unroll
                    for (int n = 0; n < 2; ++n) acc[a][b][m][n] = (f32x4){0.f, 0.f, 0.f, 0.f};
        cur = nxt; cA = nA; cB = nB; ++ui;
        if constexpr (ALIGN_EPI) { if (wr == 1) PG8_BAR; }
    }
    PG8_WAIT_V(0);
    if constexpr (!ALIGN_EPI) { if (wr == 0) PG8_BAR; }
    PG8_BAR;
    if constexpr (Epi::AFTER_DRAIN) { E.fused(acc, cur, wr, wc, fr, fq, lds, wid, lane); S.done(cur); }
#undef PG8_SA
#undef PG8_SB
#undef PG8_STAGE
#undef PG8_LDA
#undef PG8_LDB
#undef PG8_MMA
#undef PG8_WAIT_V
#undef PG8_WAIT_L
#undef PG8_BAR
#undef PG8_SCHED
}
}

#define XB_TMO      128
#define XB_XCNT(j)  (256  + 64 * (j))
#define XB_XSUB(j)  (1280 + 64 * (j))
#define XB_XGEN(j)  (2304 + 64 * (j))
#define XB_TOP      3328
#define XB_TOPGEN   3392
#define XCD_BAR_WORDS 3456
#define XB_SPIN_CAP (1u << 18)
#define LAS __attribute__((address_space(3)))

__device__ __forceinline__ unsigned xb_ld(unsigned* p)              { return __hip_atomic_load(p, __ATOMIC_RELAXED, __HIP_MEMORY_SCOPE_AGENT); }
__device__ __forceinline__ unsigned xb_add(unsigned* p, unsigned v) { return __hip_atomic_fetch_add(p, v, __ATOMIC_RELAXED, __HIP_MEMORY_SCOPE_AGENT); }
__device__ __forceinline__ unsigned xb_xcc_id() { return (unsigned)__builtin_amdgcn_s_getreg((3 << 11) | 20) & 0xFu; }
#define XB_SPIN(cond, bar) do { unsigned _sp = 0; while (cond) { __builtin_amdgcn_s_sleep(1); \
    if ((++_sp & 255u) == 0u) { if (xb_ld(&(bar)[XB_TMO])) break; if (_sp > XB_SPIN_CAP) { atomicAdd(&(bar)[XB_TMO], 1u); break; } } } } while (0)

struct XcdBarrier {
    unsigned* bar; unsigned x;
    volatile LAS unsigned* st;
};

__device__ __forceinline__ XcdBarrier xcd_barrier_post(unsigned* bar, volatile LAS unsigned* st) {
    XcdBarrier b; b.bar = bar; b.x = xb_xcc_id(); b.st = st;
    if (threadIdx.x == 0) (void)xb_add(&bar[XB_XCNT(b.x)], 1u);
    return b;
}
__device__ __forceinline__ void xcd_barrier_complete(unsigned* bar, unsigned x, unsigned& nloc, unsigned& nx) {
    const unsigned G = gridDim.x * gridDim.y * gridDim.z;
    unsigned sum, cnt, mine, sp = 0u;
    for (;;) {
        sum = 0u; cnt = 0u; mine = 0u;
#pragma unroll
        for (unsigned j = 0; j < 16; ++j) { const unsigned c = xb_ld(&bar[XB_XCNT(j)]); sum += c; cnt += (c > 0u) ? 1u : 0u; mine = (j == x) ? c : mine; }
        if (sum == G) break;
        __builtin_amdgcn_s_sleep(1);
        if ((++sp & 255u) == 0u) { if (xb_ld(&bar[XB_TMO])) break; if (sp > XB_SPIN_CAP) { atomicAdd(&bar[XB_TMO], 1u); break; } }
    }
    nloc = mine > 0u ? mine : 1u; nx = cnt > 0u ? cnt : 1u;
}

__device__ __forceinline__ void xcd_barrier(const XcdBarrier& b) {
    asm volatile("s_waitcnt vmcnt(0)" ::: "memory");
    __syncthreads();
    if (threadIdx.x == 0) {
        unsigned* bar = b.bar;
        __builtin_amdgcn_s_waitcnt(0);
        unsigned nloc = b.st[0], nx = b.st[1];
        if (nloc == 0u) { xcd_barrier_complete(bar, b.x, nloc, nx); b.st[0] = nloc; b.st[1] = nx; }
        const unsigned old = xb_add(&bar[XB_XSUB(b.x)], 1u);
        const unsigned gen = old / nloc;
        if (old + 1u == (gen + 1u) * nloc) {
            __builtin_amdgcn_fence(__ATOMIC_RELEASE, "agent");
            asm volatile("s_waitcnt vmcnt(0)" ::: "memory");
            const unsigned og = xb_add(&bar[XB_TOP], 1u);
            const unsigned tg = og / nx;
            if (og + 1u == (tg + 1u) * nx) xb_add(&bar[XB_TOPGEN], 1u);
            else XB_SPIN(xb_ld(&bar[XB_TOPGEN]) == tg, bar);
            __builtin_amdgcn_fence(__ATOMIC_ACQUIRE, "agent");
            xb_add(&bar[XB_XGEN(b.x)], 1u);
            asm volatile("s_waitcnt vmcnt(0)" ::: "memory");
        } else {
            XB_SPIN(xb_ld(&bar[XB_XGEN(b.x)]) == gen, bar);
            __builtin_amdgcn_fence(__ATOMIC_ACQUIRE, "agent");
            asm volatile("s_waitcnt vmcnt(0)" ::: "memory");
        }
    }
    __syncthreads();
}

template <class Epi>
__device__ __forceinline__ void run_gemm(PG8_LAS unsigned char* lds, const bf16_t* A, const bf16_t* Bt, int N, int K, const Epi& E) {
    pg8::Gemm g{A, Bt, NTOK, N, K}; pg8::StaticOrder S; S.init(NTOK, N, (int)gridDim.x, (int)blockIdx.x);
    pg8::gemm_phase<Epi, pg8::StaticOrder, true, true>(lds, g, S, E);
}

__global__ void __launch_bounds__(NTHR, 2) mega_kernel(Params p) {
    extern __shared__ __attribute__((aligned(16))) unsigned char lds_raw[];
    PG8_LAS unsigned char* lds = (PG8_LAS unsigned char*)lds_raw;
    char* smem = (char*)lds_raw;
    cg::grid_group grid = cg::this_grid();
    volatile LAS unsigned* xst = (volatile LAS unsigned*)(lds + LDS_BYTES - 16);
    if (threadIdx.x == 0) { xst[0] = 0u; xst[1] = 0u; }
    __syncthreads();
    const XcdBarrier xbar = xcd_barrier_post(p.bar, xst);
    phase_prologue(p, smem);
    grid.sync();
    phase_u0(p);
    xcd_barrier(xbar);
#define LL(v) ({ int l_ = (v); asm volatile("" : "+s"(l_)); l_; })
#define WL(v) (p.wts + (size_t)(v) * WL_ELEMS)
#define ML(v) (p.mod + (size_t)(v) * 4 * 9216)
#pragma unroll 1
    for (int l = 0; l < 2; ++l) {
        { const int k = LL(l); run_gemm(lds, p.ubuf, WL(k) + W_FIN0, 5632, 1024, pg8::EpiSwiGLU{p.act}); }
        xcd_barrier(xbar);
        { const int k = LL(l); run_gemm(lds, p.act, WL(k) + W_FOUT0, 1024, DFF, pg8::EpiRes{k == 0 ? p.x : p.out, p.out, ML(k), 0, 0.5f}); }
        xcd_barrier(xbar);
        phase_ln(p, LL(l), 0, true);
        xcd_barrier(xbar);
        { const int k = LL(l); run_gemm(lds, p.ubuf, WL(k) + W_IN, NPROJ, 1024, pg8::EpiInproj{p.proj, p.rope, p.iw, p.logf, p.mix_b_forget + k * 4}); }
        xcd_barrier(xbar);
        for (int rep = 0; rep < REP_TOPK; ++rep) phase_topk(p, smem);
        phase_scan(p, smem);
        for (int rep = 0; rep < REP_AC; ++rep) phase_attn_a(p, smem);
        xcd_barrier(xbar);
        for (int rep = 0; rep < REP_FLASH; ++rep) phase_flash(p, smem);
        xcd_barrier(xbar);
        for (int rep = 0; rep < REP_MERGE; ++rep) phase_merge(p, LL(l), smem);
        xcd_barrier(xbar);
        { const int k = LL(l); run_gemm(lds, p.merged, WL(k) + W_OUT, 1024, 1024, pg8::EpiRes{p.out, p.out, ML(k), 1, 1.0f}); }
        xcd_barrier(xbar);
        phase_ln(p, LL(l), 1, true);
        xcd_barrier(xbar);
        { const int k = LL(l); run_gemm(lds, p.ubuf, WL(k) + W_FIN1, 5632, 1024, pg8::EpiSwiGLU{p.act}); }
        xcd_barrier(xbar);
        { const int k = LL(l); run_gemm(lds, p.act, WL(k) + W_FOUT1, 1024, DFF, pg8::EpiRes{p.out, p.out, ML(k), 2, 0.5f}); }
        xcd_barrier(xbar);
        { const int k = LL(l); phase_ln(p, k, 2, k == 0); }
        if (l == 0) xcd_barrier(xbar);
    }
}

extern "C" void kernel_launch(void* const* d_in, const int* in_sizes, int n_in, void* d_out, int out_size, void* d_ws, size_t ws_size, hipStream_t stream) {
    Params p{};
    p.x = (const float*)d_in[0]; p.c = (const float*)d_in[1]; p.ada_w = (const float*)d_in[2]; p.ada_b = (const float*)d_in[3];
    p.ln_g = (const float*)d_in[4]; p.ln_b = (const float*)d_in[5]; p.ffn_w_in = (const float*)d_in[6]; p.ffn_w_out = (const float*)d_in[7];
    p.mix_w_in = (const float*)d_in[8]; p.mix_b_gate = (const float*)d_in[9]; p.mix_b_forget = (const float*)d_in[10];
    p.mix_w_branch = (const float*)d_in[11]; p.mix_w_out = (const float*)d_in[12];
    p.out = (float*)d_out;
    char* ws = (char*)d_ws; size_t off = 0;
    auto take = [&](size_t bytes) { char* r = ws + off; off += (bytes + 255) & ~(size_t)255; return r; };
    p.wts = (bf16_t*)take(2 * WL_ELEMS * 2);
    p.mod = (float*)take(2 * 4 * 9216 * 4);
    p.rope = (float*)take(SEQ * 16 * 4);
    p.ubuf = (bf16_t*)take((size_t)NTOK * 1024 * 2);
    p.act = (bf16_t*)(ws + off);
    p.proj = (bf16_t*)take((size_t)NTOK * NPROJ * 2);
    p.merged = p.proj;
    p.iw = (float*)take((size_t)NTOK * 16); p.logf = (float*)take((size_t)NTOK * 16); p.cum = (float*)take((size_t)NTOK * 16);
    p.maskb = (unsigned*)take((size_t)NTOK * 1024);
    p.ybuf = (bf16_t*)take((size_t)NTOK * 896 * 2);
    p.bar = (unsigned*)take(XCD_BAR_WORDS * 4);
    if (off > ws_size) { fprintf(stderr, "workspace too small: need %zu have %zu\n", off, ws_size); return; }
    static int grid_blocks = 0;
    if (!grid_blocks) {
        int dev = 0, cus = 0, per_cu = 0;
        (void)hipGetDevice(&dev);
        (void)hipDeviceGetAttribute(&cus, hipDeviceAttributeMultiprocessorCount, dev);
        (void)hipFuncSetAttribute((const void*)mega_kernel, hipFuncAttributeMaxDynamicSharedMemorySize, LDS_BYTES);
        (void)hipOccupancyMaxActiveBlocksPerMultiprocessor(&per_cu, mega_kernel, NTHR, LDS_BYTES);
        if (per_cu < 1) per_cu = 1;
        if (per_cu > 1) per_cu = 1;
        grid_blocks = cus * per_cu;
    }
    (void)hipMemsetAsync(p.bar, 0, XCD_BAR_WORDS * 4, stream);
    void* args[] = {&p};
    hipError_t e = hipLaunchCooperativeKernel((void*)mega_kernel, dim3(grid_blocks), dim3(NTHR), args, LDS_BYTES, stream);
    if (e != hipSuccess) fprintf(stderr, "cooperative launch failed: %s (grid %d)\n", hipGetErrorString(e), grid_blocks);
}
```

```cpp
#include <hip/hip_runtime.h>
#include <hip/hip_cooperative_groups.h>
#include <cstdio>
#include <cstdint>
namespace cg = cooperative_groups;

#define REP_TOPK 1
#define REP_AC 1
#define REP_FLASH 1
#define REP_MERGE 1
constexpr int NTHR = 512, NWV = 8;
constexpr int DM = 1024, SEQ = 8192, NTOK = 4 * 8192, DFF = 2816;
constexpr int NPROJ = 3840;
constexpr int PA = 0, PB = 1152, PIQ = 1920, PIK = 2176, PC = 2240, PD = 3008, PIW = 3776;
constexpr float ALPHA = 1.41421356237f;
constexpr size_t W_FIN0 = 0, W_FIN1 = 5767168, W_FOUT0 = 11534336, W_FOUT1 = 11534336 + 2883584, W_IN = 17301504,
                 W_GATE = 21233664, W_BR = 25427968, W_OUT = 26345472, WL_ELEMS = 27394048;
constexpr int LDS_BYTES = 144 * 1024;


typedef unsigned short bf16_t;
typedef short bf16x8 __attribute__((ext_vector_type(8)));
typedef float f32x4 __attribute__((ext_vector_type(4)));

struct Params {
    const float *x, *c, *ada_w, *ada_b, *ln_g, *ln_b, *ffn_w_in, *ffn_w_out, *mix_w_in, *mix_b_gate, *mix_b_forget, *mix_w_branch, *mix_w_out;
    float* out;
    bf16_t* wts; float* mod; float* rope; bf16_t* ubuf; bf16_t* act; bf16_t* proj; bf16_t* merged;
    float* iw; float* logf; float* cum; unsigned* maskb; bf16_t* ybuf;
    unsigned* bar; float* kmax;
};

__device__ __forceinline__ bf16_t f2bf(float f) { unsigned u = __float_as_uint(f); u += 0x7FFFu + ((u >> 16) & 1u); return (bf16_t)(u >> 16); }
__device__ __forceinline__ float bf2f(bf16_t h) { return __uint_as_float(((unsigned)h) << 16); }
__device__ __forceinline__ float blo(unsigned u) { return __uint_as_float(u << 16); }
__device__ __forceinline__ float bhi(unsigned u) { return __uint_as_float(u & 0xffff0000u); }
__device__ __forceinline__ int otid() { int t = threadIdx.x; asm volatile("" : "+v"(t)); return t; }
__device__ __forceinline__ unsigned pk_bf16(float lo, float hi) { unsigned r; asm volatile("v_cvt_pk_bf16_f32 %0, %1, %2" : "=v"(r) : "v"(lo), "v"(hi)); return r; }
__device__ __forceinline__ float log_sigmoid(float x) { return fminf(x, 0.f) - log1pf(expf(-fabsf(x))); }

__device__ __forceinline__ int colmap(int mode, int n) {
    if (mode == 0) return n;
    if (mode == 1) { int q = n >> 8, r = n & 255; return r < 128 ? 128 * q + r : 2816 + 128 * q + (r - 128); }
    if (mode == 2) { if (n < 2240) return n; if (n < 3776) return n + 4; if (n < 3780) return 2240 + (n - 3776); if (n < 3784) return n; return -1; }
    return 3784 + n;
}
__device__ __forceinline__ void convert_job(const float* __restrict__ src, int K, int Nsrc, bf16_t* __restrict__ dst, int Ndst, int mode, char* smem) {
    float (*t)[33] = (float (*)[33])smem;
    const int tid = threadIdx.x, tx = tid & 31, ty = tid >> 5;
    const int kt_n = K / 64, ntiles = kt_n * (Ndst / 32);
    for (int tile = blockIdx.x; tile < ntiles; tile += gridDim.x) {
        const int k0 = (tile % kt_n) * 64, n0 = (tile / kt_n) * 32;
        const int sc = colmap(mode, n0 + tx);
        __syncthreads();
#pragma unroll
        for (int i = 0; i < 4; ++i) { const int k = ty + 16 * i; t[k][tx] = sc >= 0 ? src[(size_t)(k0 + k) * Nsrc + sc] : 0.f; }
        __syncthreads();
        const int kk = tid & 63, nb = tid >> 6;
#pragma unroll
        for (int i = 0; i < 4; ++i) { const int n = nb + 8 * i; dst[(size_t)(n0 + n) * K + k0 + kk] = f2bf(t[kk][n]); }
    }
}

__device__ __forceinline__ void phase_prologue(const Params& p, char* smem) {
    for (int l = 0; l < 2; ++l) {
        bf16_t* w = p.wts + (size_t)l * WL_ELEMS;
        convert_job(p.ffn_w_in + (size_t)(l * 2 + 0) * 1024 * 5632, 1024, 5632, w + W_FIN0, 5632, 1, smem);
        convert_job(p.ffn_w_in + (size_t)(l * 2 + 1) * 1024 * 5632, 1024, 5632, w + W_FIN1, 5632, 1, smem);
        convert_job(p.ffn_w_out + (size_t)(l * 2 + 0) * 2816 * 1024, 2816, 1024, w + W_FOUT0, 1024, 0, smem);
        convert_job(p.ffn_w_out + (size_t)(l * 2 + 1) * 2816 * 1024, 2816, 1024, w + W_FOUT1, 1024, 0, smem);
        convert_job(p.mix_w_in + (size_t)l * 1024 * 7880, 1024, 7880, w + W_IN, 3840, 2, smem);
        convert_job(p.mix_w_in + (size_t)l * 1024 * 7880, 1024, 7880, w + W_GATE, 4096, 3, smem);
        convert_job(p.mix_w_branch + (size_t)l * 896 * 1024, 896, 1024, w + W_BR, 1024, 0, smem);
        convert_job(p.mix_w_out + (size_t)l * 1024 * 1024, 1024, 1024, w + W_OUT, 1024, 0, smem);
    }
    for (int idx = blockIdx.x * NTHR + threadIdx.x; idx < SEQ * 8; idx += gridDim.x * NTHR) {
        const int t = idx >> 3, i = idx & 7;
        const float invf = powf(500000.0f, -(float)i * 0.125f);
        const float ang = (float)t * invf;
        p.rope[idx * 2 + 0] = cosf(ang);
        p.rope[idx * 2 + 1] = sinf(ang);
    }
    __syncthreads();
    float* scs = (float*)smem;
    float* red = scs + 4096;
    for (int i = threadIdx.x; i < 4096; i += NTHR) { const float v = p.c[i]; scs[i] = v / (1.f + expf(-v)); }
    __syncthreads();
    const int tid = threadIdx.x, cl = tid & 63, kq = tid >> 6;
    for (int item = blockIdx.x; item < 288; item += gridDim.x) {
        const int l = item / 144, col = (item % 144) * 64 + cl;
        float a0 = 0.f, a1 = 0.f, a2 = 0.f, a3 = 0.f;
        const float* wp = p.ada_w + ((size_t)l * 1024 + kq * 128) * 9216 + col;
#pragma unroll 8
        for (int k = 0; k < 128; ++k) {
            const float w = wp[(size_t)k * 9216]; const int kk = kq * 128 + k;
            a0 = fmaf(scs[kk], w, a0); a1 = fmaf(scs[1024 + kk], w, a1); a2 = fmaf(scs[2048 + kk], w, a2); a3 = fmaf(scs[3072 + kk], w, a3);
        }
        red[(kq * 4 + 0) * 64 + cl] = a0; red[(kq * 4 + 1) * 64 + cl] = a1; red[(kq * 4 + 2) * 64 + cl] = a2; red[(kq * 4 + 3) * 64 + cl] = a3;
        __syncthreads();
        if (kq < 4) {
            const int b = kq; float s = 0.f;
#pragma unroll
            for (int q = 0; q < 8; ++q) s += red[(q * 4 + b) * 64 + cl];
            p.mod[(size_t)(l * 4 + b) * 9216 + col] = s + p.ada_b[(size_t)l * 9216 + col];
        }
        __syncthreads();
    }
}

__device__ __forceinline__ void phase_u0(const Params& p) {
    const size_t n4 = (size_t)NTOK * 256;
    for (size_t i = (size_t)blockIdx.x * NTHR + threadIdx.x; i < n4; i += (size_t)gridDim.x * NTHR) {
        const size_t row = i >> 8; const int c4 = (int)(i & 255) * 4; const int b = (int)(row >> 13);
        const float4 v = *(const float4*)(p.x + row * 1024 + c4);
        const float* md = p.mod + (size_t)(0 * 4 + b) * 9216;
        const float4 sh = *(const float4*)(md + c4), sc = *(const float4*)(md + 1024 + c4);
        ushort4 o; o.x = f2bf(v.x * (1.f + sc.x) + sh.x); o.y = f2bf(v.y * (1.f + sc.y) + sh.y); o.z = f2bf(v.z * (1.f + sc.z) + sh.z); o.w = f2bf(v.w * (1.f + sc.w) + sh.w);
        *(ushort4*)(p.ubuf + row * 1024 + c4) = o;
    }
}

__device__ __forceinline__ void gemm_mainloop(f32x4 (&acc)[4][4], const bf16_t* __restrict__ A, int lda, const bf16_t* __restrict__ Bt, int ldb, int K, char* smem) {
    bf16_t* As = (bf16_t*)smem; bf16_t* Bs = As + 256 * 40;
    int tid_ = threadIdx.x; asm volatile("" : "+v"(tid_));
    const int tid = tid_, lane = tid & 63, wid = tid >> 6, wr = wid >> 1, wc = wid & 1;
    const int lr = tid >> 1, lk = (tid & 1) * 16;
    const int br = (tid & 255) >> 1;
    const bool ldB = tid < 256;
    const uint4* ga = (const uint4*)(A + (size_t)lr * lda + lk);
    const uint4* gb = (const uint4*)(Bt + (size_t)br * ldb + lk);
    uint4 ra0 = ga[0], ra1 = ga[1], rb0 = make_uint4(0, 0, 0, 0), rb1 = rb0;
    if (ldB) { rb0 = gb[0]; rb1 = gb[1]; }
    const int fr = lane & 15, fq = lane >> 4;
    for (int k0 = 0; k0 < K; k0 += 32) {
        __syncthreads();
        *(uint4*)&As[lr * 40 + lk] = ra0; *(uint4*)&As[lr * 40 + lk + 8] = ra1;
        if (ldB) { *(uint4*)&Bs[br * 40 + lk] = rb0; *(uint4*)&Bs[br * 40 + lk + 8] = rb1; }
        __syncthreads();
        if (k0 + 32 < K) { ga += 4; gb += 4; ra0 = ga[0]; ra1 = ga[1]; if (ldB) { rb0 = gb[0]; rb1 = gb[1]; } }
        bf16x8 a[4], b[4];
#pragma unroll
        for (int m = 0; m < 4; ++m) a[m] = *(const bf16x8*)&As[(wr * 64 + m * 16 + fr) * 40 + fq * 8];
#pragma unroll
        for (int n = 0; n < 4; ++n) b[n] = *(const bf16x8*)&Bs[(wc * 64 + n * 16 + fr) * 40 + fq * 8];
#pragma unroll
        for (int m = 0; m < 4; ++m)
#pragma unroll
            for (int n = 0; n < 4; ++n) acc[m][n] = __builtin_amdgcn_mfma_f32_16x16x32_bf16(a[m], b[n], acc[m][n], 0, 0, 0);
    }
}
__device__ __forceinline__ void zero_acc(f32x4 (&acc)[4][4]) {
#pragma unroll
    for (int m = 0; m < 4; ++m)
#pragma unroll
        for (int n = 0; n < 4; ++n) acc[m][n] = (f32x4){0.f, 0.f, 0.f, 0.f};
}
__device__ __forceinline__ void phase_merge(const Params& p, int l, char* smem) {
    const bf16_t* WG = p.wts + (size_t)l * WL_ELEMS + W_GATE; const bf16_t* WB = p.wts + (size_t)l * WL_ELEMS + W_BR;
    const int tid = otid(), lane = tid & 63, wid = tid >> 6, wr = wid >> 1, wc = wid & 1, fr = lane & 15, fq = lane >> 4;
    for (int tile = blockIdx.x; tile < 128 * 8; tile += gridDim.x) {
        const int pm = tile / 8, pn = tile % 8;
        f32x4 accM[4][4]; zero_acc(accM);
#pragma unroll 1
        for (int br = 0; br < 4; ++br) {
            const int koff = br == 0 ? 0 : 128 + (br - 1) * 256, kb = br == 0 ? 128 : 256;
            f32x4 accG[4][4]; zero_acc(accG);
            gemm_mainloop(accG, p.ubuf + (size_t)pm * 256 * 1024, 1024, WG + (size_t)(br * 1024 + pn * 128) * 1024, 1024, 1024, smem);
            const float* bg = p.mix_b_gate + (size_t)l * 4096 + br * 1024;
#pragma unroll
            for (int n = 0; n < 4; ++n) {
                const float bv = bg[pn * 128 + wc * 64 + n * 16 + fr];
#pragma unroll
                for (int m = 0; m < 4; ++m)
#pragma unroll
                    for (int j = 0; j < 4; ++j) accG[m][n][j] = 1.f / (1.f + expf(-(accG[m][n][j] + bv)));
            }
            unsigned* gst = (unsigned*)(smem + 32768) + tid;
#pragma unroll
            for (int m = 0; m < 4; ++m)
#pragma unroll
                for (int n = 0; n < 4; ++n) {
                    gst[((m * 4 + n) * 2 + 0) * NTHR] = (unsigned)f2bf(accG[m][n][0]) | ((unsigned)f2bf(accG[m][n][1]) << 16);
                    gst[((m * 4 + n) * 2 + 1) * NTHR] = (unsigned)f2bf(accG[m][n][2]) | ((unsigned)f2bf(accG[m][n][3]) << 16);
                }
            zero_acc(accG);
            gemm_mainloop(accG, p.ybuf + (size_t)pm * 256 * 896 + koff, 896, WB + (size_t)pn * 128 * 896 + koff, 896, kb, smem);
#pragma unroll
            for (int m = 0; m < 4; ++m)
#pragma unroll
                for (int n = 0; n < 4; ++n) {
                    const unsigned g01 = gst[((m * 4 + n) * 2 + 0) * NTHR], g23 = gst[((m * 4 + n) * 2 + 1) * NTHR];
                    accM[m][n][0] += blo(g01) * accG[m][n][0]; accM[m][n][1] += bhi(g01) * accG[m][n][1];
                    accM[m][n][2] += blo(g23) * accG[m][n][2]; accM[m][n][3] += bhi(g23) * accG[m][n][3];
                }
        }
#pragma unroll
        for (int m = 0; m < 4; ++m)
#pragma unroll
            for (int n = 0; n < 4; ++n)
#pragma unroll
                for (int j = 0; j < 4; ++j)
                    p.merged[(size_t)(pm * 256 + wr * 64 + m * 16 + fq * 4 + j) * 1024 + pn * 128 + wc * 64 + n * 16 + fr] = f2bf(accM[m][n][j]);
    }
}

__device__ __forceinline__ void phase_ln(const Params& p, int l, int s, bool has_next) {
    const int tid_ = otid(), lane = tid_ & 63, wid = tid_ >> 6;
    const float* g = p.ln_g + (size_t)(l * 3 + s) * 1024; const float* bb = p.ln_b + (size_t)(l * 3 + s) * 1024;
    const int nl = s < 2 ? l : l + 1, ns = s < 2 ? s + 1 : 0;
    for (int row = blockIdx.x * NWV + wid; row < NTOK; row += gridDim.x * NWV) {
        float* xr = p.out + (size_t)row * 1024;
        float4 v[4]; float sum = 0.f;
#pragma unroll
        for (int i = 0; i < 4; ++i) { v[i] = *(const float4*)(xr + lane * 4 + 256 * i); sum += (v[i].x + v[i].y) + (v[i].z + v[i].w); }
#pragma unroll
        for (int o = 32; o > 0; o >>= 1) sum += __shfl_xor(sum, o);
        const float mu = sum * (1.f / 1024.f); float q = 0.f;
#pragma unroll
        for (int i = 0; i < 4; ++i) { const float a = v[i].x - mu, b2 = v[i].y - mu, c = v[i].z - mu, d = v[i].w - mu; q += (a * a + b2 * b2) + (c * c + d * d); }
#pragma unroll
        for (int o = 32; o > 0; o >>= 1) q += __shfl_xor(q, o);
        const float rstd = 1.0f / sqrtf(q * (1.f / 1024.f) + 1e-5f);
        const int b = row >> 13;
        const float* md = p.mod + (size_t)(nl * 4 + b) * 9216 + ns * 3072;
#pragma unroll
        for (int i = 0; i < 4; ++i) {
            const int c4 = lane * 4 + 256 * i;
            const float4 gg = *(const float4*)(g + c4), be = *(const float4*)(bb + c4);
            float4 o; o.x = (v[i].x - mu) * rstd * gg.x + be.x; o.y = (v[i].y - mu) * rstd * gg.y + be.y; o.z = (v[i].z - mu) * rstd * gg.z + be.z; o.w = (v[i].w - mu) * rstd * gg.w + be.w;
            *(float4*)(xr + c4) = o;
            if (has_next) {
                const float4 sh = *(const float4*)(md + c4), sc = *(const float4*)(md + 1024 + c4);
                ushort4 u; u.x = f2bf(o.x * (1.f + sc.x) + sh.x); u.y = f2bf(o.y * (1.f + sc.y) + sh.y); u.z = f2bf(o.z * (1.f + sc.z) + sh.z); u.w = f2bf(o.w * (1.f + sc.w) + sh.w);
                *(ushort4*)(p.ubuf + (size_t)row * 1024 + c4) = u;
            }
        }
    }
}

__device__ __forceinline__ void load_row32(float (&q)[32], const bf16_t* row) {
    const uint4* r = (const uint4*)row;
#pragma unroll
    for (int c = 0; c < 4; ++c) { const uint4 v = r[c];
        q[c * 8 + 0] = blo(v.x); q[c * 8 + 1] = bhi(v.x); q[c * 8 + 2] = blo(v.y); q[c * 8 + 3] = bhi(v.y);
        q[c * 8 + 4] = blo(v.z); q[c * 8 + 5] = bhi(v.z); q[c * 8 + 6] = blo(v.w); q[c * 8 + 7] = bhi(v.w); }
}
__device__ __forceinline__ float dot32(const float (&q)[32], const bf16_t* row) {
    const uint4* r = (const uint4*)row; float a = 0.f;
#pragma unroll
    for (int c = 0; c < 4; ++c) { const uint4 v = r[c];
        a = fmaf(q[c * 8 + 0], blo(v.x), a); a = fmaf(q[c * 8 + 1], bhi(v.x), a); a = fmaf(q[c * 8 + 2], blo(v.y), a); a = fmaf(q[c * 8 + 3], bhi(v.y), a);
        a = fmaf(q[c * 8 + 4], blo(v.z), a); a = fmaf(q[c * 8 + 5], bhi(v.z), a); a = fmaf(q[c * 8 + 6], blo(v.w), a); a = fmaf(q[c * 8 + 7], bhi(v.w), a); }
    return a + __shfl_xor(a, 1);
}
__device__ __forceinline__ void axpy32(float (&o)[32], float sc, float pw, const bf16_t* row) {
    const uint4* r = (const uint4*)row;
#pragma unroll
    for (int c = 0; c < 4; ++c) { const uint4 v = r[c];
        o[c * 8 + 0] = fmaf(pw, blo(v.x), o[c * 8 + 0] * sc); o[c * 8 + 1] = fmaf(pw, bhi(v.x), o[c * 8 + 1] * sc);
        o[c * 8 + 2] = fmaf(pw, blo(v.y), o[c * 8 + 2] * sc); o[c * 8 + 3] = fmaf(pw, bhi(v.y), o[c * 8 + 3] * sc);
        o[c * 8 + 4] = fmaf(pw, blo(v.z), o[c * 8 + 4] * sc); o[c * 8 + 5] = fmaf(pw, bhi(v.z), o[c * 8 + 5] * sc);
        o[c * 8 + 6] = fmaf(pw, blo(v.w), o[c * 8 + 6] * sc); o[c * 8 + 7] = fmaf(pw, bhi(v.w), o[c * 8 + 7] * sc); }
}
__device__ __forceinline__ void store_row32(bf16_t* dst, const float (&o)[32], float sc) {
    uint4* r = (uint4*)dst;
#pragma unroll
    for (int c = 0; c < 4; ++c) { uint4 v;
        v.x = (unsigned)f2bf(o[c * 8 + 0] * sc) | ((unsigned)f2bf(o[c * 8 + 1] * sc) << 16); v.y = (unsigned)f2bf(o[c * 8 + 2] * sc) | ((unsigned)f2bf(o[c * 8 + 3] * sc) << 16);
        v.z = (unsigned)f2bf(o[c * 8 + 4] * sc) | ((unsigned)f2bf(o[c * 8 + 5] * sc) << 16); v.w = (unsigned)f2bf(o[c * 8 + 6] * sc) | ((unsigned)f2bf(o[c * 8 + 7] * sc) << 16);
        r[c] = v; }
}
__device__ __forceinline__ void zero32(float (&o)[32]) {
#pragma unroll
    for (int i = 0; i < 32; ++i) o[i] = 0.f;
}

typedef float f32x16 __attribute__((ext_vector_type(16)));
typedef short s16x4 __attribute__((ext_vector_type(4)));
constexpr int FK_PITCH = 72, FV_PITCH = 68;
__device__ __forceinline__ int crow16(int i, int hh) { return (i & 3) + 8 * (i >> 2) + 4 * hh; }
template <int KIND>
__device__ __forceinline__ void flash_unit(const Params& p, int b, int h, int qb, char* smem, int tid) {
    bf16_t* Ks = (bf16_t*)smem;
    bf16_t* Vt = Ks + 2 * 64 * FK_PITCH;
    float* ckl = (float*)(Vt + 2 * 64 * FV_PITCH);
    const int lane = tid & 63, w = tid >> 6, r = lane & 31, hh = lane >> 5;
    const int QOFF = KIND == 0 ? PD : (KIND == 1 ? PB : PC), YOFF = KIND == 0 ? 640 : (KIND == 1 ? 128 : 384);
    const int q0 = qb * 256, qw0 = q0 + 32 * w, tq = qw0 + r;
    const size_t tokb = (size_t)b * SEQ, tok = tokb + tq;
    const float L2E = 1.44269504089f, C1 = 0.125f * 1.44269504089f;
    bf16x8 qf[4];
#pragma unroll
    for (int ks = 0; ks < 4; ++ks) qf[ks] = *(const bf16x8*)(p.proj + tok * NPROJ + QOFF + h * 64 + 16 * ks + 8 * hh);
    float cql = 0.f; if (KIND == 0) cql = p.cum[tok * 4 + h] * L2E;
    const unsigned* mrow = p.maskb + tok * 256;
    f32x16 o0, o1;
#pragma unroll
    for (int i = 0; i < 16; ++i) { o0[i] = 0.f; o1[i] = 0.f; }
    float mrun = -INFINITY, lrun = 0.f;
    const int ntiles = 4 * (qb + 1);
    const int skey = tid >> 3, sch = tid & 7;
    const bf16_t* kg = p.proj + (tokb + skey) * NPROJ + QOFF + 256 + h * 64 + sch * 8;
    constexpr bool REV = (KIND != 1);
    const int jfirst = REV ? ntiles - 1 : 0;
    uint4 kreg = *(const uint4*)(kg + (size_t)jfirst * 64 * NPROJ), vreg = *(const uint4*)(kg + (size_t)jfirst * 64 * NPROJ + 256);
    float creg = 0.f; if (KIND == 0 && tid < 64) creg = p.cum[(tokb + jfirst * 64 + tid) * 4 + h] * L2E;
    float qbound = 0.f, cend = 0.f;
    if (KIND == 0) {
        float ss = 0.f;
#pragma unroll
        for (int ks = 0; ks < 4; ++ks)
#pragma unroll
            for (int e = 0; e < 8; ++e) { const float f = bf2f((bf16_t)qf[ks][e]); ss = fmaf(f, f, ss); }
        ss += __shfl_xor(ss, 32);
        qbound = sqrtf(ss) * p.kmax[b * 4 + h] * C1 * 1.001f + cql;
        cend = p.cum[(tokb + jfirst * 64 + 63) * 4 + h] * L2E;
    }
    uint2 mreg = make_uint2(0u, 0u); if (KIND == 1) mreg = *(const uint2*)(mrow);
    float run = 0.f;
#pragma unroll 1
    for (int jj = 0; jj < ntiles; ++jj) {
        const int j = REV ? ntiles - 1 - jj : jj;
        const int buf = jj & 1;
        bf16_t* ksb = Ks + buf * 64 * FK_PITCH; bf16_t* vtb = Vt + buf * 64 * FV_PITCH; float* cb = ckl + buf * 64;
        *(uint4*)&ksb[skey * FK_PITCH + sch * 8] = kreg;
        {
            bf16_t* vd = vtb + (sch * 8) * FV_PITCH + skey;
            vd[0 * FV_PITCH] = (bf16_t)(vreg.x & 0xffffu); vd[1 * FV_PITCH] = (bf16_t)(vreg.x >> 16);
            vd[2 * FV_PITCH] = (bf16_t)(vreg.y & 0xffffu); vd[3 * FV_PITCH] = (bf16_t)(vreg.y >> 16);
            vd[4 * FV_PITCH] = (bf16_t)(vreg.z & 0xffffu); vd[5 * FV_PITCH] = (bf16_t)(vreg.z >> 16);
            vd[6 * FV_PITCH] = (bf16_t)(vreg.w & 0xffffu); vd[7 * FV_PITCH] = (bf16_t)(vreg.w >> 16);
        }
        if (KIND == 0 && tid < 64) cb[tid] = creg;
        const uint2 mw = mreg;
        if (KIND == 2) { if (__syncthreads_and(run < -60.f)) break; }
        else if (KIND == 0) { if (__syncthreads_and(qbound - cend < mrun - 51.f)) break; }
        else __syncthreads();
        if (jj + 1 < ntiles) {
            const int jn = REV ? j - 1 : j + 1;
            if (KIND == 0) cend = p.cum[(tokb + jn * 64 + 63) * 4 + h] * L2E;
            const bf16_t* kn = kg + (size_t)jn * 64 * NPROJ;
            kreg = *(const uint4*)kn; vreg = *(const uint4*)(kn + 256);
            if (KIND == 0 && tid < 64) creg = p.cum[(tokb + jn * 64 + tid) * 4 + h] * L2E;
            if (KIND == 1) mreg = *(const uint2*)(mrow + 2 * jn);
        }
#pragma unroll
        for (int sb = 0; sb < 2; ++sb) {
            const int sub = REV ? 1 - sb : sb;
            const int kb = 64 * j + 32 * sub;
            if (KIND == 2 ? (kb > qw0) : (kb > qw0 + 31)) continue;
            f32x16 x;
#pragma unroll
            for (int i = 0; i < 16; ++i) x[i] = 0.f;
#pragma unroll
            for (int ks = 0; ks < 4; ++ks) {
                const bf16x8 a = *(const bf16x8*)&ksb[(32 * sub + r) * FK_PITCH + 16 * ks + 8 * hh];
                x = __builtin_amdgcn_mfma_f32_32x32x16_bf16(a, qf[ks], x, 0, 0, 0);
            }
            if (KIND == 2) {
                const bool diag = (kb == qw0);
                float lk[16], sg[4];
#pragma unroll
                for (int g = 0; g < 4; ++g) {
                    float acc = 0.f;
#pragma unroll
                    for (int e = 0; e < 4; ++e) {
                        const float z = x[4 * g + e] * 0.125f;
                        float lb = fminf(z, 0.f) - 0.69314718056f * __builtin_amdgcn_logf(1.f + __builtin_amdgcn_exp2f(-fabsf(z) * L2E));
                        float l1 = lb - z;
                        if (diag && (kb + 8 * g + 4 * hh + e >= tq)) { lb = -INFINITY; l1 = 0.f; }
                        x[4 * g + e] = lb; lk[4 * g + e] = l1; acc += l1;
                    }
                    sg[g] = acc;
                }
                float sp[4];
#pragma unroll
                for (int g = 0; g < 4; ++g) sp[g] = __shfl_xor(sg[g], 32);
                float after = 0.f;
#pragma unroll
                for (int g = 3; g >= 0; --g) {
                    const float aft = run + after + (hh == 0 ? sp[g] : 0.f);
                    float suf = 0.f;
#pragma unroll
                    for (int e = 3; e >= 0; --e) { const float lb = x[4 * g + e]; x[4 * g + e] = __builtin_amdgcn_exp2f((lb + aft + suf) * L2E); suf += lk[4 * g + e]; }
                    after += sg[g] + sp[g];
                }
                run += after;
            }
            float mt = -INFINITY;
            if (KIND == 0) {
                const bool diag = kb + 31 > qw0;
#pragma unroll
                for (int g = 0; g < 4; ++g) {
                    const f32x4 ck = *(const f32x4*)&cb[32 * sub + 8 * g + 4 * hh];
#pragma unroll
                    for (int e = 0; e < 4; ++e) {
                        float s = fmaf(x[4 * g + e], C1, cql - ck[e]);
                        if (diag && (kb + 8 * g + 4 * hh + e > tq)) s = -INFINITY;
                        x[4 * g + e] = s; mt = fmaxf(mt, s);
                    }
                }
            } else if (KIND == 1) {
                const unsigned wbits = sub == 0 ? mw.x : mw.y;
#pragma unroll
                for (int i = 0; i < 16; ++i) {
                    float s = x[i] * C1;
                    if (!((wbits >> crow16(i, hh)) & 1u)) s = -INFINITY;
                    x[i] = s; mt = fmaxf(mt, s);
                }
            }
            if (KIND != 2) {
            mt = fmaxf(mt, __shfl_xor(mt, 32));
            const float mnew = fmaxf(mrun, mt), msafe = (mnew == -INFINITY) ? 0.f : mnew;
            const float alpha = __builtin_amdgcn_exp2f(mrun - msafe);
            float ps = 0.f;
#pragma unroll
            for (int i = 0; i < 16; ++i) { const float e = __builtin_amdgcn_exp2f(x[i] - msafe); x[i] = e; ps += e; }
            lrun = lrun * alpha + ps; mrun = mnew;
            if (__any(alpha != 1.f)) {
#pragma unroll
                for (int i = 0; i < 16; ++i) { o0[i] *= alpha; o1[i] *= alpha; }
            }
            }
            bf16x8 pf[2];
#pragma unroll
            for (int s = 0; s < 2; ++s) {
                unsigned pk[4];
#pragma unroll
                for (int e = 0; e < 4; ++e) pk[e] = pk_bf16(x[8 * s + 2 * e], x[8 * s + 2 * e + 1]);
                pf[s] = __builtin_bit_cast(bf16x8, (uint4){pk[0], pk[1], pk[2], pk[3]});
            }
#pragma unroll
            for (int s = 0; s < 2; ++s) {
#pragma unroll
                for (int dt = 0; dt < 2; ++dt) {
                    const bf16_t* vp = vtb + (32 * dt + r) * FV_PITCH + 32 * sub + 16 * s + 4 * hh;
                    const s16x4 lo = *(const s16x4*)vp, hi = *(const s16x4*)(vp + 8);
                    const bf16x8 vf = __builtin_shufflevector(lo, hi, 0, 1, 2, 3, 4, 5, 6, 7);
                    if (dt == 0) o0 = __builtin_amdgcn_mfma_f32_32x32x16_bf16(vf, pf[s], o0, 0, 0, 0);
                    else o1 = __builtin_amdgcn_mfma_f32_32x32x16_bf16(vf, pf[s], o1, 0, 0, 0);
                }
            }
        }
    }
    const float ltot = lrun + __shfl_xor(lrun, 32), inv = KIND == 2 ? 1.f : 1.f / ltot;
    bf16_t* yo = p.ybuf + tok * 896 + YOFF + h * 64;
#pragma unroll
    for (int g = 0; g < 4; ++g) {
        uint2 w0, w1;
        w0.x = (unsigned)f2bf(o0[4 * g] * inv) | ((unsigned)f2bf(o0[4 * g + 1] * inv) << 16); w0.y = (unsigned)f2bf(o0[4 * g + 2] * inv) | ((unsigned)f2bf(o0[4 * g + 3] * inv) << 16);
        w1.x = (unsigned)f2bf(o1[4 * g] * inv) | ((unsigned)f2bf(o1[4 * g + 1] * inv) << 16); w1.y = (unsigned)f2bf(o1[4 * g + 2] * inv) | ((unsigned)f2bf(o1[4 * g + 3] * inv) << 16);
        *(uint2*)(yo + 8 * g + 4 * hh) = w0; *(uint2*)(yo + 32 + 8 * g + 4 * hh) = w1;
    }
}
__device__ __forceinline__ void phase_attn_a(const Params& p, char* smem) {
    const int tid = otid(), lane = tid & 63, w = tid >> 6, r = lane & 31, hh = lane >> 5;
    bf16_t* vt = (bf16_t*)smem + w * (64 * 36);
    const float C1 = 0.125f * 1.44269504089f;
    __syncthreads();
    for (int item = blockIdx.x * NWV + w; item < 2048; item += gridDim.x * NWV) {
        const int hp = item & 1, rho = (item >> 1) & 15, m = (item >> 5) & 15, b = item >> 9;
        const size_t tokb = (size_t)b * SEQ;
        const int tq = 512 * m + rho + 16 * r;
        f32x16 o0, o1;
#pragma unroll
        for (int i = 0; i < 16; ++i) { o0[i] = 0.f; o1[i] = 0.f; }
        float mrun = -INFINITY, lrun = 0.f;
#pragma unroll 1
        for (int g = 0; g < 3; ++g) {
            const int d = g == 0 ? 1 : (g == 1 ? 4 : 16), c = 16 / d, head = 2 * g + hp, nsub = g == 0 ? 20 : (g == 1 ? 8 : 5);
            const int res = rho & (d - 1), n0 = (512 * m + rho - res) / d, nq = n0 + c * r, nmax = n0 + 31 * c, ks0 = n0 - 128;
            bf16x8 qf[4];
#pragma unroll
            for (int ks = 0; ks < 4; ++ks) qf[ks] = *(const bf16x8*)(p.proj + (tokb + tq) * NPROJ + PA + head * 64 + 16 * ks + 8 * hh);
            const bf16_t* kcol = p.proj + tokb * NPROJ + PA + 384 + head * 64;
#pragma unroll 1
            for (int st = 0; st < nsub; ++st) {
                const int kbase = ks0 + 32 * st;
                if (kbase + 31 < 0) continue;
                int kk = kbase + r; kk = kk < 0 ? 0 : (kk > nmax ? nmax : kk);
                const bf16_t* krow = kcol + (size_t)(kk * d + res) * NPROJ + 8 * hh;
                bf16x8 a[4];
#pragma unroll
                for (int ks = 0; ks < 4; ++ks) a[ks] = *(const bf16x8*)(krow + 16 * ks);
                int kv = kbase + (lane >> 1); kv = kv < 0 ? 0 : (kv > nmax ? nmax : kv);
                const uint4* vrow = (const uint4*)(kcol + (size_t)(kv * d + res) * NPROJ + 384 + (lane & 1) * 32);
                uint4 vv[4];
#pragma unroll
                for (int q = 0; q < 4; ++q) vv[q] = vrow[q];
                f32x16 x;
#pragma unroll
                for (int i = 0; i < 16; ++i) x[i] = 0.f;
#pragma unroll
                for (int ks = 0; ks < 4; ++ks) x = __builtin_amdgcn_mfma_f32_32x32x16_bf16(a[ks], qf[ks], x, 0, 0, 0);
                {
                    bf16_t* vd = vt + ((lane & 1) * 32) * 36 + (lane >> 1);
#pragma unroll
                    for (int q = 0; q < 4; ++q) {
                        vd[(8 * q + 0) * 36] = (bf16_t)(vv[q].x & 0xffffu); vd[(8 * q + 1) * 36] = (bf16_t)(vv[q].x >> 16);
                        vd[(8 * q + 2) * 36] = (bf16_t)(vv[q].y & 0xffffu); vd[(8 * q + 3) * 36] = (bf16_t)(vv[q].y >> 16);
                        vd[(8 * q + 4) * 36] = (bf16_t)(vv[q].z & 0xffffu); vd[(8 * q + 5) * 36] = (bf16_t)(vv[q].z >> 16);
                        vd[(8 * q + 6) * 36] = (bf16_t)(vv[q].w & 0xffffu); vd[(8 * q + 7) * 36] = (bf16_t)(vv[q].w >> 16);
                    }
                }
                float mt = -INFINITY;
#pragma unroll
                for (int i = 0; i < 16; ++i) {
                    const int ki = kbase + crow16(i, hh), dist = nq - ki;
                    float s = x[i] * C1;
                    if (ki < 0 || dist < 0 || dist > 128) s = -INFINITY;
                    x[i] = s; mt = fmaxf(mt, s);
                }
                mt = fmaxf(mt, __shfl_xor(mt, 32));
                const float mnew = fmaxf(mrun, mt), msafe = (mnew == -INFINITY) ? 0.f : mnew;
                const float alpha = __builtin_amdgcn_exp2f(mrun - msafe);
                float ps = 0.f;
#pragma unroll
                for (int i = 0; i < 16; ++i) { const float e = __builtin_amdgcn_exp2f(x[i] - msafe); x[i] = e; ps += e; }
                lrun = lrun * alpha + ps; mrun = mnew;
#pragma unroll
                for (int i = 0; i < 16; ++i) { o0[i] *= alpha; o1[i] *= alpha; }
                bf16x8 pf[2];
#pragma unroll
                for (int s = 0; s < 2; ++s) {
                    unsigned pk[4];
#pragma unroll
                    for (int e = 0; e < 4; ++e) pk[e] = pk_bf16(x[8 * s + 2 * e], x[8 * s + 2 * e + 1]);
                    pf[s] = __builtin_bit_cast(bf16x8, (uint4){pk[0], pk[1], pk[2], pk[3]});
                }
                asm volatile("s_waitcnt lgkmcnt(0)" ::: "memory");
#pragma unroll
                for (int s = 0; s < 2; ++s) {
#pragma unroll
                    for (int dt = 0; dt < 2; ++dt) {
                        const bf16_t* vp = vt + (32 * dt + r) * 36 + 16 * s + 4 * hh;
                        const s16x4 lo = *(const s16x4*)vp, hi = *(const s16x4*)(vp + 8);
                        const bf16x8 vf = __builtin_shufflevector(lo, hi, 0, 1, 2, 3, 4, 5, 6, 7);
                        if (dt == 0) o0 = __builtin_amdgcn_mfma_f32_32x32x16_bf16(vf, pf[s], o0, 0, 0, 0);
                        else o1 = __builtin_amdgcn_mfma_f32_32x32x16_bf16(vf, pf[s], o1, 0, 0, 0);
                    }
                }
                asm volatile("s_waitcnt lgkmcnt(0)" ::: "memory");
            }
        }
        const float ltot = lrun + __shfl_xor(lrun, 32), inv = 1.f / ltot;
        bf16_t* yo = p.ybuf + (tokb + tq) * 896 + hp * 64;
#pragma unroll
        for (int g = 0; g < 4; ++g) {
            uint2 w0, w1;
            w0.x = (unsigned)f2bf(o0[4 * g] * inv) | ((unsigned)f2bf(o0[4 * g + 1] * inv) << 16); w0.y = (unsigned)f2bf(o0[4 * g + 2] * inv) | ((unsigned)f2bf(o0[4 * g + 3] * inv) << 16);
            w1.x = (unsigned)f2bf(o1[4 * g] * inv) | ((unsigned)f2bf(o1[4 * g + 1] * inv) << 16); w1.y = (unsigned)f2bf(o1[4 * g + 2] * inv) | ((unsigned)f2bf(o1[4 * g + 3] * inv) << 16);
            *(uint2*)(yo + 8 * g + 4 * hh) = w0; *(uint2*)(yo + 32 + 8 * g + 4 * hh) = w1;
        }
    }
}
__device__ __forceinline__ void phase_flash(const Params& p, char* smem) {
    const int tid = otid();
    for (int it = blockIdx.x; it < 768; it += gridDim.x) {
        const int kind = it >> 8, c = it & 255, bh = c & 15, qs = c >> 4;
#pragma unroll 1
        for (int half = 0; half < 2; ++half) {
            const int qb = half ? 31 - qs : qs;
            __syncthreads();
            if (kind == 0) flash_unit<0>(p, bh >> 2, bh & 3, qb, smem, tid);
            else if (kind == 1) flash_unit<1>(p, bh >> 2, bh & 3, qb, smem, tid);
            else flash_unit<2>(p, bh >> 2, bh & 3, qb, smem, tid);
        }
    }
}
__device__ __forceinline__ void phase_scan(const Params& p, char* smem) {
    double* part = (double*)smem;
    float* pm = (float*)(part + NTHR);
    const int tid = otid();
    for (int item = blockIdx.x; item < 16; item += gridDim.x) {
        const int b = item >> 2, h = item & 3;
        const float* lf = p.logf + ((size_t)b * SEQ + tid * 16) * 4 + h;
        double s = 0.0;
        for (int i = 0; i < 16; ++i) s += (double)lf[i * 4];
        float kmx = 0.f;
        for (int i = 0; i < 16; ++i) {
            const uint4* kr = (const uint4*)(p.proj + ((size_t)b * SEQ + tid * 16 + i) * NPROJ + PD + 256 + h * 64);
            float ss = 0.f;
#pragma unroll
            for (int c = 0; c < 8; ++c) { const uint4 v = kr[c];
                ss = fmaf(blo(v.x), blo(v.x), ss); ss = fmaf(bhi(v.x), bhi(v.x), ss); ss = fmaf(blo(v.y), blo(v.y), ss); ss = fmaf(bhi(v.y), bhi(v.y), ss);
                ss = fmaf(blo(v.z), blo(v.z), ss); ss = fmaf(bhi(v.z), bhi(v.z), ss); ss = fmaf(blo(v.w), blo(v.w), ss); ss = fmaf(bhi(v.w), bhi(v.w), ss); }
            kmx = fmaxf(kmx, ss);
        }
        __syncthreads();
        part[tid] = s; pm[tid] = kmx;
        __syncthreads();
        if (tid == 0) { double r = 0.0; float mm = 0.f; for (int i = 0; i < NTHR; ++i) { const double v = part[i]; part[i] = r; r += v; mm = fmaxf(mm, pm[i]); } p.kmax[item] = sqrtf(mm); }
        __syncthreads();
        double r = part[tid];
        float* cm = p.cum + ((size_t)b * SEQ + tid * 16) * 4 + h;
        for (int i = 0; i < 16; ++i) { r += (double)lf[i * 4]; cm[i * 4] = (float)r; }
    }
}
__device__ __forceinline__ unsigned f2key(float f) { const unsigned u = __float_as_uint(f); return (u & 0x80000000u) ? ~u : (u | 0x80000000u); }
constexpr int HPITCH = 1028;
template <int PASS>
__device__ __forceinline__ void idx_pass(const Params& p, size_t tokb, int t0, int ktmax, const bf16x8 (&qf)[4][4], float w0, float w1, float w2, float w3,
                                         unsigned* hist, const unsigned* qpre, unsigned* gtb, unsigned* eqb, int lane, int w) {
    const int r = lane & 31, hh = lane >> 5, tq = t0 + r;
    unsigned pre = 0u; if (PASS >= 1) pre = qpre[r];
    unsigned* hrow = hist + r * HPITCH;
    const bf16_t* kbase = p.proj + (tokb + r) * NPROJ + PIK + 8 * hh;
    uint4 an[4];
    if (w <= ktmax) {
#pragma unroll
        for (int ks = 0; ks < 4; ++ks) an[ks] = *(const uint4*)(kbase + (size_t)w * 32 * NPROJ + 16 * ks);
    }
#pragma unroll 1
    for (int kt = w; kt <= ktmax; kt += 8) {
        bf16x8 a[4];
#pragma unroll
        for (int ks = 0; ks < 4; ++ks) a[ks] = __builtin_bit_cast(bf16x8, an[ks]);
        if (kt + 8 <= ktmax) {
#pragma unroll
            for (int ks = 0; ks < 4; ++ks) an[ks] = *(const uint4*)(kbase + (size_t)(kt + 8) * 32 * NPROJ + 16 * ks);
        }
        f32x16 x0, x1, x2, x3;
#pragma unroll
        for (int i = 0; i < 16; ++i) { x0[i] = 0.f; x1[i] = 0.f; x2[i] = 0.f; x3[i] = 0.f; }
#pragma unroll
        for (int ks = 0; ks < 4; ++ks) {
            x0 = __builtin_amdgcn_mfma_f32_32x32x16_bf16(a[ks], qf[0][ks], x0, 0, 0, 0);
            x1 = __builtin_amdgcn_mfma_f32_32x32x16_bf16(a[ks], qf[1][ks], x1, 0, 0, 0);
            x2 = __builtin_amdgcn_mfma_f32_32x32x16_bf16(a[ks], qf[2][ks], x2, 0, 0, 0);
            x3 = __builtin_amdgcn_mfma_f32_32x32x16_bf16(a[ks], qf[3][ks], x3, 0, 0, 0);
        }
        const int kb = kt * 32;
        const bool diag = (kt == ktmax);
        unsigned gw = 0u, ew = 0u;
#pragma unroll
        for (int i = 0; i < 16; ++i) {
            float v = w0 * fmaxf(x0[i], 0.f);
            v = fmaf(w1, fmaxf(x1[i], 0.f), v); v = fmaf(w2, fmaxf(x2[i], 0.f), v); v = fmaf(w3, fmaxf(x3[i], 0.f), v);
            v += 0.0f;
            const unsigned key = f2key(v);
            const int kr = crow16(i, hh);
            const bool valid = !diag || (kb + kr <= tq);
            if (PASS == 0) { if (valid) { const unsigned d = key >> 21; atomicAdd(&hrow[d >> 1], (d & 1u) ? 65536u : 1u); } }
            if (PASS == 1) { if (valid && (key >> 21) == pre) { const unsigned d = (key >> 10) & 2047u; atomicAdd(&hrow[d >> 1], (d & 1u) ? 65536u : 1u); } }
            if (PASS == 2) { if (valid && (key >> 10) == pre) { const unsigned d = key & 1023u; atomicAdd(&hrow[d >> 1], (d & 1u) ? 65536u : 1u); } }
            if (PASS == 3) { gw |= ((valid && key > pre) ? 1u : 0u) << kr; ew |= ((valid && key == pre) ? 1u : 0u) << kr; }
        }
        if (PASS == 3) {
            gw |= __shfl_xor(gw, 32); ew |= __shfl_xor(ew, 32);
            if (hh == 0) { gtb[r * 256 + kt] = gw; eqb[r * 256 + kt] = ew; }
        }
    }
}
__device__ __forceinline__ void idx_search(const unsigned* hist, unsigned* qpre, unsigned* qneed, int shift, int lane, int w) {
#pragma unroll 1
    for (int qi = 0; qi < 4; ++qi) {
        const int q = 4 * w + qi;
        const unsigned need = qneed[q];
        const uint4* hr = (const uint4*)(hist + q * HPITCH + 16 * lane);
        unsigned wr[16];
#pragma unroll
        for (int c = 0; c < 4; ++c) { const uint4 v = hr[c]; wr[4 * c] = v.x; wr[4 * c + 1] = v.y; wr[4 * c + 2] = v.z; wr[4 * c + 3] = v.w; }
        unsigned mine = 0u;
#pragma unroll
        for (int c = 0; c < 16; ++c) mine += (wr[c] & 0xffffu) + (wr[c] >> 16);
        unsigned tot = mine;
#pragma unroll
        for (int o = 1; o < 64; o <<= 1) { const unsigned v = __shfl_down(tot, o); if (lane + o < 64) tot += v; }
        const unsigned excl = tot - mine;
        if (excl < need && tot >= need) {
            unsigned cum = excl, nrem = 0u; int dsel = -1;
#pragma unroll
            for (int c = 15; c >= 0; --c) {
                const unsigned hi = wr[c] >> 16, lo = wr[c] & 0xffffu;
                if (dsel < 0) { if (cum + hi >= need) { dsel = 2 * (16 * lane + c) + 1; nrem = need - cum; } else cum += hi; }
                if (dsel < 0) { if (cum + lo >= need) { dsel = 2 * (16 * lane + c); nrem = need - cum; } else cum += lo; }
            }
            qpre[q] = (qpre[q] << shift) | (unsigned)dsel; qneed[q] = nrem;
        }
    }
}
__device__ __forceinline__ void phase_topk(const Params& p, char* smem) {
    unsigned* hist = (unsigned*)smem;
    unsigned* gtb = hist;
    unsigned* eqb = hist + 32 * 256;
    unsigned* qpre = hist + 32 * HPITCH;
    unsigned* qneed = qpre + 32;
    const int tid = otid(), lane = tid & 63, w = tid >> 6;
    for (int it = blockIdx.x; it < 256; it += gridDim.x) {
#pragma unroll 1
        for (int sub = 0; sub < 4; ++sub) {
            const int u = sub == 0 ? it : (sub == 1 ? 511 - it : (sub == 2 ? 512 + it : 1023 - it));
            const int b = u & 3, blk = u >> 2, t0 = blk * 32;
            const size_t tokb = (size_t)b * SEQ;
            if (t0 + 32 <= 256) {
                for (int i = tid; i < 32 * 256; i += NTHR) {
                    const int q = i >> 8, k = i & 255, n = t0 + q + 1, lo = k * 32;
                    p.maskb[(tokb + t0 + q) * 256 + k] = (lo + 32 <= n) ? 0xffffffffu : (lo >= n ? 0u : ((1u << (n - lo)) - 1u));
                }
                continue;
            }
            const int r = lane & 31, hh = lane >> 5;
            const size_t tok = tokb + t0 + r;
            bf16x8 qf[4][4];
#pragma unroll
            for (int h = 0; h < 4; ++h)
#pragma unroll
                for (int ks = 0; ks < 4; ++ks) qf[h][ks] = *(const bf16x8*)(p.proj + tok * NPROJ + PIQ + h * 64 + 16 * ks + 8 * hh);
            const f32x4 wv = *(const f32x4*)(p.iw + tok * 4);
            const int ktmax = blk;
            __syncthreads();
            if (tid < 32) { qpre[tid] = 0u; qneed[tid] = 256u; }
#pragma unroll 1
            for (int pass = 0; pass < 3; ++pass) {
                for (int i = tid; i < 32 * HPITCH / 4; i += NTHR) ((uint4*)hist)[i] = make_uint4(0u, 0u, 0u, 0u);
                __syncthreads();
                if (pass == 0) idx_pass<0>(p, tokb, t0, ktmax, qf, wv[0], wv[1], wv[2], wv[3], hist, qpre, gtb, eqb, lane, w);
                else if (pass == 1) idx_pass<1>(p, tokb, t0, ktmax, qf, wv[0], wv[1], wv[2], wv[3], hist, qpre, gtb, eqb, lane, w);
                else idx_pass<2>(p, tokb, t0, ktmax, qf, wv[0], wv[1], wv[2], wv[3], hist, qpre, gtb, eqb, lane, w);
                __syncthreads();
                idx_search(hist, qpre, qneed, pass == 2 ? 10 : 11, lane, w);
                __syncthreads();
            }
            for (int i = tid; i < 2 * 32 * 256 / 4; i += NTHR) ((uint4*)hist)[i] = make_uint4(0u, 0u, 0u, 0u);
            __syncthreads();
            idx_pass<3>(p, tokb, t0, ktmax, qf, wv[0], wv[1], wv[2], wv[3], hist, qpre, gtb, eqb, lane, w);
            __syncthreads();
#pragma unroll 1
            for (int qi = 0; qi < 4; ++qi) {
                const int q = 4 * w + qi; const unsigned rr = qneed[q];
                const uint4 g4 = *(const uint4*)&gtb[q * 256 + 4 * lane]; const uint4 e4 = *(const uint4*)&eqb[q * 256 + 4 * lane];
                unsigned ev[4] = {e4.x, e4.y, e4.z, e4.w}, gv[4] = {g4.x, g4.y, g4.z, g4.w};
                const unsigned mine = __popc(ev[0]) + __popc(ev[1]) + __popc(ev[2]) + __popc(ev[3]);
                unsigned incl = mine;
#pragma unroll
                for (int o = 1; o < 64; o <<= 1) { const unsigned v = __shfl_up(incl, o); if (lane >= o) incl += v; }
                unsigned rank = incl - mine;
#pragma unroll
                for (int c = 0; c < 4; ++c) {
                    unsigned e = ev[c]; const unsigned pc = __popc(e);
                    if (rank + pc > rr) {
                        unsigned keep = rank < rr ? rr - rank : 0u, sel = 0u;
                        while (keep > 0u) { const unsigned low = e & (0u - e); sel |= low; e ^= low; --keep; }
                        e = sel;
                    }
                    gv[c] |= e; rank += pc;
                }
                *(uint4*)&p.maskb[(tokb + t0 + q) * 256 + 4 * lane] = make_uint4(gv[0], gv[1], gv[2], gv[3]);
            }
        }
    }
}

namespace pg8 {
#define PG8_LAS __attribute__((address_space(3)))
typedef unsigned short bf16_t;
typedef short bf16x8 __attribute__((ext_vector_type(8)));
typedef float f32x4 __attribute__((ext_vector_type(4)));
typedef unsigned u32x4 __attribute__((ext_vector_type(4)));
constexpr int BM = 256, BK = 64, HALF = 128, HTB = HALF * BK * 2  , STAGE_BYTES = 8 * HTB, NXCD = 8, WGM = 8;

__host__ __device__ __forceinline__ int lds_byte(int r, int c) { const int st = (r >> 4) * 2 + (c >> 5), rr = r & 15, cc = c & 31, ob = rr * 64 + cc * 2; return st * 1024 + (ob ^ (((ob >> 9) & 1) << 5)); }
__host__ __device__ __forceinline__ void stage_rc(int b, int& R, int& C) { const int st = b / 1024, sb = b % 1024, swz = sb ^ (((sb >> 9) & 1) << 5); R = (st >> 1) * 16 + swz / 64; C = (st & 1) * 32 + (swz % 64) / 2; }
__host__ __device__ __forceinline__ int perm32(int rho) { const int n = rho >> 4, i = rho & 15; return 8 * (i >> 2) + 4 * n + (i & 3); }

struct Unit { int pm, pn; };
struct Gemm { const bf16_t* A; const bf16_t* Bt; int M, N, K; };

struct StaticOrder {
    int nM, nN, nwg, G, c;
    __host__ __device__ void init(int M, int N, int G_, int c_) { nM = M / BM; nN = N / BM; nwg = nM * nN; G = G_; c = c_; }
    __host__ __device__ bool next(int i, Unit& u) const {
        const long L = (long)i * G + c; if (L >= nwg) return false;
        int wgid = (int)L; { const int q = nwg / NXCD, r = nwg % NXCD, xcd = wgid % NXCD, off = wgid / NXCD; wgid = (xcd < r ? xcd * (q + 1) : r * (q + 1) + (xcd - r) * q) + off; }
        const int nig = WGM * nN, gid = wgid / nig, fm = gid * WGM, gsz = (nM - fm) < WGM ? (nM - fm) : WGM;
        u.pm = fm + ((wgid % nig) % gsz); u.pn = (wgid % nig) / gsz; return true;
    }
    __device__ __forceinline__ void a_ready(const Unit&) const {}
    __device__ __forceinline__ void done(const Unit&) const {}
};

__device__ __forceinline__ unsigned cvt_pk_bf16(float lo, float hi) { unsigned r; asm volatile("v_cvt_pk_bf16_f32 %0, %1, %2" : "=v"(r) : "v"(lo), "v"(hi)); return r; }
__device__ __forceinline__ float silu_f(float g) { return g / (1.f + __expf(-g)); }
struct EpiSwiGLU {
    static constexpr bool PERM = true, AFTER_DRAIN = false;
    bf16_t* O;
    __device__ __forceinline__ void operator()(const f32x4 (&acc)[2][2][4][2], const Unit& u, int wr, int wc, int fr, int fq) const {
        const int row0 = u.pm * BM + wr * 64 + fr, col0 = u.pn * 128 + wc * 32 + 8 * fq;
#pragma unroll
        for (int ai = 0; ai < 2; ++ai)
#pragma unroll
            for (int m = 0; m < 4; ++m) {
                bf16_t* rowp = O + (size_t)(row0 + ai * HALF + m * 16) * 2816 + col0;
                const f32x4 g0 = acc[ai][0][m][0], g1 = acc[ai][0][m][1], u0 = acc[ai][1][m][0], u1 = acc[ai][1][m][1];
                u32x4 w;
                w.x = cvt_pk_bf16(silu_f(g0[0]) * u0[0], silu_f(g0[1]) * u0[1]); w.y = cvt_pk_bf16(silu_f(g0[2]) * u0[2], silu_f(g0[3]) * u0[3]);
                w.z = cvt_pk_bf16(silu_f(g1[0]) * u1[0], silu_f(g1[1]) * u1[1]); w.w = cvt_pk_bf16(silu_f(g1[2]) * u1[2], silu_f(g1[3]) * u1[3]);
                *(u32x4*)rowp = w;
            }
    }
};
struct EpiRes {
    static constexpr bool PERM = false, AFTER_DRAIN = false;
    const float* xres; float* out; const float* modl; int sub; float fac;
    __device__ __forceinline__ void operator()(const f32x4 (&acc)[2][2][4][2], const Unit& u, int wr, int wc, int fr, int fq) const {
        const int b = (u.pm * BM) >> 13;
        const float* gate = modl + (size_t)b * 9216 + sub * 3072 + 2048;
        const int col0 = u.pn * BM + wc * 32 + 4 * fq;
#pragma unroll
        for (int bj = 0; bj < 2; ++bj)
#pragma unroll
            for (int n = 0; n < 2; ++n) {
                const int col = col0 + bj * HALF + n * 16;
                f32x4 gm = *(const f32x4*)(gate + col); gm = (gm + 1.0f) * fac;
#pragma unroll
                for (int ai = 0; ai < 2; ++ai)
#pragma unroll
                    for (int m = 0; m < 4; ++m) {
                        const size_t off = (size_t)(u.pm * BM + ai * HALF + wr * 64 + m * 16 + fr) * 1024 + col;
                        const f32x4 xr = *(const f32x4*)(xres + off);
                        *(f32x4*)(out + off) = xr * 1.41421356237f + gm * acc[ai][bj][m][n];
                    }
            }
    }
};
struct EpiInproj {
    static constexpr bool PERM = true, AFTER_DRAIN = false;
    bf16_t* proj; const float* rope; float* iw; float* logf; const float* bfg;
    __device__ __forceinline__ void operator()(const f32x4 (&acc)[2][2][4][2], const Unit& u, int wr, int wc, int fr, int fq) const {
#pragma unroll
        for (int bj = 0; bj < 2; ++bj) {
            const int cb32 = u.pn * BM + bj * HALF + wc * 32;
            const bool rp = ((cb32 & 63) == 0) && (cb32 < 768 || (cb32 >= 1152 && cb32 < 1664) || (cb32 >= 1920 && cb32 < 2240));
#pragma unroll
            for (int ai = 0; ai < 2; ++ai)
#pragma unroll
                for (int m = 0; m < 4; ++m) {
                    const int row = u.pm * BM + ai * HALF + wr * 64 + m * 16 + fr;
                    f32x4 v0 = acc[ai][bj][m][0], v1 = acc[ai][bj][m][1];
                    if (rp) {
                        const int t = row & 8191;
                        const f32x4* rt = (const f32x4*)(rope + (size_t)t * 16);
                        const f32x4 r0 = rt[0], r1 = rt[1], r2 = rt[2], r3 = rt[3];
                        f32x4 p0, p1;
#pragma unroll
                        for (int j = 0; j < 4; ++j) { p0[j] = __shfl_xor(v0[j], 16); p1[j] = __shfl_xor(v1[j], 16); }
                        if (fq == 0) {
                            v0[0] = v0[0] * r0[0] - p0[0] * r0[1]; v0[1] = v0[1] * r0[2] - p0[1] * r0[3]; v0[2] = v0[2] * r1[0] - p0[2] * r1[1]; v0[3] = v0[3] * r1[2] - p0[3] * r1[3];
                            v1[0] = v1[0] * r2[0] - p1[0] * r2[1]; v1[1] = v1[1] * r2[2] - p1[1] * r2[3]; v1[2] = v1[2] * r3[0] - p1[2] * r3[1]; v1[3] = v1[3] * r3[2] - p1[3] * r3[3];
                        } else if (fq == 1) {
                            v0[0] = v0[0] * r0[0] + p0[0] * r0[1]; v0[1] = v0[1] * r0[2] + p0[1] * r0[3]; v0[2] = v0[2] * r1[0] + p0[2] * r1[1]; v0[3] = v0[3] * r1[2] + p0[3] * r1[3];
                            v1[0] = v1[0] * r2[0] + p1[0] * r2[1]; v1[1] = v1[1] * r2[2] + p1[1] * r2[3]; v1[2] = v1[2] * r3[0] + p1[2] * r3[1]; v1[3] = v1[3] * r3[2] + p1[3] * r3[3];
                        }
                    }
                    u32x4 w; w.x = cvt_pk_bf16(v0[0], v0[1]); w.y = cvt_pk_bf16(v0[2], v0[3]); w.z = cvt_pk_bf16(v1[0], v1[1]); w.w = cvt_pk_bf16(v1[2], v1[3]);
                    *(u32x4*)(proj + (size_t)row * 3840 + cb32 + 8 * fq) = w;
                    if (cb32 == 3776 && fq == 0) {
                        *(f32x4*)(iw + (size_t)row * 4) = v0;
                        f32x4 lf;
#pragma unroll
                        for (int j = 0; j < 4; ++j) { const float xx = v1[j] + bfg[j]; lf[j] = fminf(xx, 0.f) - log1pf(expf(-fabsf(xx))); }
                        *(f32x4*)(logf + (size_t)row * 4) = lf;
                    }
                }
        }
    }
};
template <class Epi, class Sched, bool ALIGN_EPI = false, bool SP2 = false>
__device__ __forceinline__ void gemm_phase(PG8_LAS unsigned char* lds, const Gemm g, const Sched& S, const Epi& E) {
    int tid_ = threadIdx.x; asm volatile("" : "+v"(tid_));
    const int tid = tid_, wid = __builtin_amdgcn_readfirstlane(tid >> 6), lane = tid & 63, wr = wid >> 2, wc = wid & 3, fr = lane & 15, fq = lane >> 4;
    const int K = g.K, nt = K / BK;
    unsigned voffA[2], voffB[2];
#pragma unroll
    for (int i = 0; i < 2; ++i) { int R, C; stage_rc(tid * 16 + i * 8192, R, C); const int Rb = Epi::PERM ? ((R & ~31) + perm32(R & 31)) : R;
        voffA[i] = (unsigned)(R * K + C) * 2u; voffB[i] = (unsigned)(Rb * K + C) * 2u; }
    const size_t kstep = (size_t)(BK * 2);
    const size_t hstep = (size_t)HALF * K * 2;
    const size_t tstep = 2 * hstep;
    const unsigned ldsw = (unsigned)wid * 1024u;
    const int aoff = lds_byte(wr * 64 + fr, fq * 8), boff = lds_byte(wc * 32 + fr, fq * 8);
#define PG8_SA(b, h) (((b) * 2 + (h)) * HTB)
#define PG8_SB(b, h) ((4 + (b) * 2 + (h)) * HTB)
#define PG8_STAGE(bufoff, gbase, voff) do { _Pragma("unroll") for (int _i = 0; _i < 2; ++_i) \
        __builtin_amdgcn_global_load_lds((const unsigned*)((const char*)(gbase) + (voff)[_i]), (PG8_LAS unsigned*)(lds + (bufoff) + ldsw + _i * 8192), 16, 0, 0); } while (0)
#define PG8_LDA(dst, b, h) do { _Pragma("unroll") for (int m = 0; m < 4; ++m) _Pragma("unroll") for (int k = 0; k < 2; ++k) dst[m][k] = *(const PG8_LAS bf16x8*)(lds + PG8_SA(b, h) + aoff + m * 2048 + k * 1024); } while (0)
#define PG8_LDB(dst, b, h) do { _Pragma("unroll") for (int n = 0; n < 2; ++n) _Pragma("unroll") for (int k = 0; k < 2; ++k) dst[n][k] = *(const PG8_LAS bf16x8*)(lds + PG8_SB(b, h) + boff + n * 2048 + k * 1024); } while (0)
#define PG8_MMA(ai, bj, At, Bt) do { __builtin_amdgcn_s_setprio(1); _Pragma("unroll") for (int m = 0; m < 4; ++m) _Pragma("unroll") for (int n = 0; n < 2; ++n) _Pragma("unroll") for (int k = 0; k < 2; ++k) \
        acc[ai][bj][m][n] = __builtin_amdgcn_mfma_f32_16x16x32_bf16(Bt[n][k], At[m][k], acc[ai][bj][m][n], 0, 0, 0); __builtin_amdgcn_s_setprio(0); } while (0)
#define PG8_WAIT_V(n) asm volatile("s_waitcnt vmcnt(" #n ")" ::: "memory")
#define PG8_WAIT_L(n) asm volatile("s_waitcnt lgkmcnt(" #n ")" ::: "memory")
#define PG8_BAR __builtin_amdgcn_s_barrier()
#define PG8_SCHED __builtin_amdgcn_sched_barrier(0)
    Unit cur, nxt; int ui = 0;
    if (!S.next(0, cur)) return;
    f32x4 acc[2][2][4][2];
#pragma unroll
    for (int a = 0; a < 2; ++a)
#pragma unroll
        for (int b = 0; b < 2; ++b)
#pragma unroll
            for (int m = 0; m < 4; ++m)
#pragma unroll
                for (int n = 0; n < 2; ++n) acc[a][b][m][n] = (f32x4){0.f, 0.f, 0.f, 0.f};
    bf16x8 At[4][2], B0[2][2], B1[2][2];
    const char* cA = (const char*)g.A + (size_t)cur.pm * tstep; const char* cB = (const char*)g.Bt + (size_t)cur.pn * tstep;
    S.a_ready(cur);
    if constexpr (SP2) {
        PG8_STAGE(PG8_SB(0, 0), cB, voffB); PG8_STAGE(PG8_SB(0, 1), cB + hstep, voffB); PG8_STAGE(PG8_SA(0, 0), cA, voffA); PG8_STAGE(PG8_SA(0, 1), cA + hstep, voffA);
        if (wr == 1) PG8_BAR;
        PG8_WAIT_V(2); PG8_BAR;
        PG8_STAGE(PG8_SB(1, 0), cB + kstep, voffB); PG8_STAGE(PG8_SA(1, 0), cA + kstep, voffA); PG8_STAGE(PG8_SB(1, 1), cB + hstep + kstep, voffB);
        PG8_WAIT_V(6); PG8_BAR;
    } else {
        PG8_STAGE(PG8_SB(0, 0), cB, voffB); PG8_STAGE(PG8_SA(0, 0), cA, voffA); PG8_STAGE(PG8_SB(0, 1), cB + hstep, voffB); PG8_STAGE(PG8_SA(0, 1), cA + hstep, voffA);
        if (wr == 1) PG8_BAR;
        PG8_WAIT_V(4); PG8_BAR;
        PG8_STAGE(PG8_SB(1, 0), cB + kstep, voffB); PG8_STAGE(PG8_SA(1, 0), cA + kstep, voffA); PG8_STAGE(PG8_SB(1, 1), cB + hstep + kstep, voffB);
        PG8_WAIT_V(6); PG8_BAR;
    }
    for (;;) {
        const bool has_next = S.next(ui + 1, nxt);
        const char* nA = has_next ? (const char*)g.A + (size_t)nxt.pm * tstep : cA; const char* nB = has_next ? (const char*)g.Bt + (size_t)nxt.pn * tstep : cB;
        for (int t = 0; t < nt; t += 2) {
            const bool last = (t == nt - 2);
            const char* a1 = cA + (size_t)(t + 1) * kstep;
            const char* a2 = last ? nA : cA + (size_t)(t + 2) * kstep; const char* b2 = last ? nB : cB + (size_t)(t + 2) * kstep;
            const char* a3 = a2 + kstep; const char* b3 = b2 + kstep;
            if (last && has_next) S.a_ready(nxt);
            if constexpr (SP2) {
            PG8_LDB(B0, 0, 0); PG8_LDB(B1, 0, 1); PG8_SCHED; PG8_LDA(At, 0, 0); PG8_STAGE(PG8_SA(1, 1), a1 + hstep, voffA);
            PG8_WAIT_V(8); PG8_WAIT_L(0); PG8_BAR; PG8_MMA(0, 0, At, B0); PG8_MMA(0, 1, At, B1); PG8_BAR; PG8_SCHED;
            PG8_LDA(At, 0, 1); PG8_STAGE(PG8_SB(0, 0), b2, voffB); PG8_STAGE(PG8_SB(0, 1), b2 + hstep, voffB); PG8_STAGE(PG8_SA(0, 0), a2, voffA);
            PG8_WAIT_V(8); PG8_WAIT_L(0); PG8_BAR; PG8_MMA(1, 0, At, B0); PG8_MMA(1, 1, At, B1); PG8_BAR; PG8_SCHED;
            PG8_LDB(B0, 1, 0); PG8_LDB(B1, 1, 1); PG8_SCHED; PG8_LDA(At, 1, 0); PG8_STAGE(PG8_SA(0, 1), a2 + hstep, voffA);
            PG8_WAIT_V(8); PG8_WAIT_L(0); PG8_BAR; PG8_MMA(0, 0, At, B0); PG8_MMA(0, 1, At, B1); PG8_BAR; PG8_SCHED;
            PG8_LDA(At, 1, 1); PG8_STAGE(PG8_SB(1, 0), b3, voffB); PG8_STAGE(PG8_SB(1, 1), b3 + hstep, voffB); PG8_STAGE(PG8_SA(1, 0), a3, voffA);
            PG8_WAIT_V(8); PG8_WAIT_L(0); PG8_BAR; PG8_MMA(1, 0, At, B0); PG8_MMA(1, 1, At, B1); PG8_BAR; PG8_SCHED;
            } else {
            PG8_LDB(B0, 0, 0); PG8_SCHED; PG8_LDA(At, 0, 0); PG8_STAGE(PG8_SA(1, 1), a1 + hstep, voffA);
            PG8_WAIT_L(8); PG8_BAR; PG8_WAIT_L(0); PG8_MMA(0, 0, At, B0); PG8_BAR; PG8_SCHED;
            PG8_LDB(B1, 0, 1); PG8_STAGE(PG8_SB(0, 0), b2, voffB);
            PG8_BAR; PG8_WAIT_L(0); PG8_MMA(0, 1, At, B1); PG8_BAR;
            PG8_LDA(At, 0, 1); PG8_STAGE(PG8_SA(0, 0), a2, voffA);
            PG8_BAR; PG8_WAIT_L(0); PG8_MMA(1, 0, At, B0); PG8_BAR; PG8_SCHED;
            PG8_STAGE(PG8_SB(0, 1), b2 + hstep, voffB);
            PG8_WAIT_V(6); PG8_BAR; PG8_MMA(1, 1, At, B1); PG8_BAR;
            PG8_LDB(B0, 1, 0); PG8_SCHED; PG8_LDA(At, 1, 0); PG8_STAGE(PG8_SA(0, 1), a2 + hstep, voffA);
            PG8_WAIT_L(8); PG8_BAR; PG8_WAIT_L(0); PG8_MMA(0, 0, At, B0); PG8_BAR; PG8_SCHED;
            PG8_LDB(B1, 1, 1); PG8_STAGE(PG8_SB(1, 0), b3, voffB);
            PG8_BAR; PG8_WAIT_L(0); PG8_MMA(0, 1, At, B1); PG8_BAR;
            PG8_LDA(At, 1, 1); PG8_STAGE(PG8_SA(1, 0), a3, voffA);
            PG8_BAR; PG8_WAIT_L(0); PG8_MMA(1, 0, At, B0); PG8_BAR; PG8_SCHED;
            PG8_STAGE(PG8_SB(1, 1), b3 + hstep, voffB);
            PG8_WAIT_V(6); PG8_BAR; PG8_MMA(1, 1, At, B1); PG8_BAR;
            }
        }
        if constexpr (ALIGN_EPI) { if (wr == 0) PG8_BAR; }
        if constexpr (!Epi::AFTER_DRAIN) { E(acc, cur, wr, wc, fr, fq); S.done(cur); }
        if (!has_next) break;
#pragma unroll
        for (int a = 0; a < 2; ++a)
#pragma unroll
            for (int b = 0; b < 2; ++b)
#pragma unroll
                for (int m = 0; m < 4; ++m)
#pragma unroll
                    for (int n = 0; n < 2; ++n) acc[a][b][m][n] = (f32x4){0.f, 0.f, 0.f, 0.f};
        cur = nxt; cA = nA; cB = nB; ++ui;
        if constexpr (ALIGN_EPI) { if (wr == 1) PG8_BAR; }
    }
    PG8_WAIT_V(0);
    if constexpr (!ALIGN_EPI) { if (wr == 0) PG8_BAR; }
    PG8_BAR;
    if constexpr (Epi::AFTER_DRAIN) { E.fused(acc, cur, wr, wc, fr, fq, lds, wid, lane); S.done(cur); }
#undef PG8_SA
#undef PG8_SB
#undef PG8_STAGE
#undef PG8_LDA
#undef PG8_LDB
#undef PG8_MMA
#undef PG8_WAIT_V
#undef PG8_WAIT_L
#undef PG8_BAR
#undef PG8_SCHED
}
}

#define XB_TMO      128
#define XB_XCNT(j)  (256  + 64 * (j))
#define XB_XSUB(j)  (1280 + 64 * (j))
#define XB_XGEN(j)  (2304 + 64 * (j))
#define XB_TOP      3328
#define XB_TOPGEN   3392
#define XCD_BAR_WORDS 3456
#define XB_SPIN_CAP (1u << 18)
#define LAS __attribute__((address_space(3)))

__device__ __forceinline__ unsigned xb_ld(unsigned* p)              { return __hip_atomic_load(p, __ATOMIC_RELAXED, __HIP_MEMORY_SCOPE_AGENT); }
__device__ __forceinline__ unsigned xb_add(unsigned* p, unsigned v) { return __hip_atomic_fetch_add(p, v, __ATOMIC_RELAXED, __HIP_MEMORY_SCOPE_AGENT); }
__device__ __forceinline__ unsigned xb_xcc_id() { return (unsigned)__builtin_amdgcn_s_getreg((3 << 11) | 20) & 0xFu; }
#define XB_SPIN(cond, bar) do { unsigned _sp = 0; while (cond) { __builtin_amdgcn_s_sleep(1); \
    if ((++_sp & 255u) == 0u) { if (xb_ld(&(bar)[XB_TMO])) break; if (_sp > XB_SPIN_CAP) { atomicAdd(&(bar)[XB_TMO], 1u); break; } } } } while (0)

struct XcdBarrier {
    unsigned* bar; unsigned x;
    volatile LAS unsigned* st;
};

__device__ __forceinline__ XcdBarrier xcd_barrier_post(unsigned* bar, volatile LAS unsigned* st) {
    XcdBarrier b; b.bar = bar; b.x = xb_xcc_id(); b.st = st;
    if (threadIdx.x == 0) (void)xb_add(&bar[XB_XCNT(b.x)], 1u);
    return b;
}
__device__ __forceinline__ void xcd_barrier_complete(unsigned* bar, unsigned x, unsigned& nloc, unsigned& nx) {
    const unsigned G = gridDim.x * gridDim.y * gridDim.z;
    unsigned sum, cnt, mine, sp = 0u;
    for (;;) {
        sum = 0u; cnt = 0u; mine = 0u;
#pragma unroll
        for (unsigned j = 0; j < 16; ++j) { const unsigned c = xb_ld(&bar[XB_XCNT(j)]); sum += c; cnt += (c > 0u) ? 1u : 0u; mine = (j == x) ? c : mine; }
        if (sum == G) break;
        __builtin_amdgcn_s_sleep(1);
        if ((++sp & 255u) == 0u) { if (xb_ld(&bar[XB_TMO])) break; if (sp > XB_SPIN_CAP) { atomicAdd(&bar[XB_TMO], 1u); break; } }
    }
    nloc = mine > 0u ? mine : 1u; nx = cnt > 0u ? cnt : 1u;
}

__device__ __forceinline__ void xcd_barrier(const XcdBarrier& b) {
    asm volatile("s_waitcnt vmcnt(0)" ::: "memory");
    __syncthreads();
    if (threadIdx.x == 0) {
        unsigned* bar = b.bar;
        __builtin_amdgcn_s_waitcnt(0);
        unsigned nloc = b.st[0], nx = b.st[1];
        if (nloc == 0u) { xcd_barrier_complete(bar, b.x, nloc, nx); b.st[0] = nloc; b.st[1] = nx; }
        const unsigned old = xb_add(&bar[XB_XSUB(b.x)], 1u);
        const unsigned gen = old / nloc;
        if (old + 1u == (gen + 1u) * nloc) {
            __builtin_amdgcn_fence(__ATOMIC_RELEASE, "agent");
            asm volatile("s_waitcnt vmcnt(0)" ::: "memory");
            const unsigned og = xb_add(&bar[XB_TOP], 1u);
            const unsigned tg = og / nx;
            if (og + 1u == (tg + 1u) * nx) xb_add(&bar[XB_TOPGEN], 1u);
            else XB_SPIN(xb_ld(&bar[XB_TOPGEN]) == tg, bar);
            __builtin_amdgcn_fence(__ATOMIC_ACQUIRE, "agent");
            xb_add(&bar[XB_XGEN(b.x)], 1u);
            asm volatile("s_waitcnt vmcnt(0)" ::: "memory");
        } else {
            XB_SPIN(xb_ld(&bar[XB_XGEN(b.x)]) == gen, bar);
            __builtin_amdgcn_fence(__ATOMIC_ACQUIRE, "agent");
            asm volatile("s_waitcnt vmcnt(0)" ::: "memory");
        }
    }
    __syncthreads();
}

template <class Epi>
__device__ __forceinline__ void run_gemm(PG8_LAS unsigned char* lds, const bf16_t* A, const bf16_t* Bt, int N, int K, const Epi& E) {
    pg8::Gemm g{A, Bt, NTOK, N, K}; pg8::StaticOrder S; S.init(NTOK, N, (int)gridDim.x, (int)blockIdx.x);
    pg8::gemm_phase<Epi, pg8::StaticOrder, true, true>(lds, g, S, E);
}

__global__ void __launch_bounds__(NTHR, 2) mega_kernel(Params p) {
    extern __shared__ __attribute__((aligned(16))) unsigned char lds_raw[];
    PG8_LAS unsigned char* lds = (PG8_LAS unsigned char*)lds_raw;
    char* smem = (char*)lds_raw;
    cg::grid_group grid = cg::this_grid();
    volatile LAS unsigned* xst = (volatile LAS unsigned*)(lds + LDS_BYTES - 16);
    if (threadIdx.x == 0) { xst[0] = 0u; xst[1] = 0u; }
    __syncthreads();
    (void)xcd_barrier_post(p.bar, xst);
#define GBAR() do { XcdBarrier xb_; xb_.bar = p.bar; xb_.x = xb_xcc_id(); xb_.st = (volatile LAS unsigned*)(lds + LDS_BYTES - 16); xcd_barrier(xb_); } while (0)
    phase_prologue(p, smem);
    grid.sync();
    phase_u0(p);
    GBAR();
#define LL(v) ({ int l_ = (v); asm volatile("" : "+s"(l_)); l_; })
#define WL(v) (p.wts + (size_t)(v) * WL_ELEMS)
#define ML(v) (p.mod + (size_t)(v) * 4 * 9216)
#pragma unroll 1
    for (int l = 0; l < 2; ++l) {
        { const int k = LL(l); run_gemm(lds, p.ubuf, WL(k) + W_FIN0, 5632, 1024, pg8::EpiSwiGLU{p.act}); }
        GBAR();
        { const int k = LL(l); run_gemm(lds, p.act, WL(k) + W_FOUT0, 1024, DFF, pg8::EpiRes{k == 0 ? p.x : p.out, p.out, ML(k), 0, 0.5f}); }
        GBAR();
        phase_ln(p, LL(l), 0, true);
        GBAR();
        { const int k = LL(l); run_gemm(lds, p.ubuf, WL(k) + W_IN, NPROJ, 1024, pg8::EpiInproj{p.proj, p.rope, p.iw, p.logf, p.mix_b_forget + k * 4}); }
        GBAR();
        for (int rep = 0; rep < REP_TOPK; ++rep) phase_topk(p, smem);
        phase_scan(p, smem);
        for (int rep = 0; rep < REP_AC; ++rep) phase_attn_a(p, smem);
        GBAR();
        for (int rep = 0; rep < REP_FLASH; ++rep) phase_flash(p, smem);
        GBAR();
        for (int rep = 0; rep < REP_MERGE; ++rep) phase_merge(p, LL(l), smem);
        GBAR();
        { const int k = LL(l); run_gemm(lds, p.merged, WL(k) + W_OUT, 1024, 1024, pg8::EpiRes{p.out, p.out, ML(k), 1, 1.0f}); }
        GBAR();
        phase_ln(p, LL(l), 1, true);
        GBAR();
        { const int k = LL(l); run_gemm(lds, p.ubuf, WL(k) + W_FIN1, 5632, 1024, pg8::EpiSwiGLU{p.act}); }
        GBAR();
        { const int k = LL(l); run_gemm(lds, p.act, WL(k) + W_FOUT1, 1024, DFF, pg8::EpiRes{p.out, p.out, ML(k), 2, 0.5f}); }
        GBAR();
        { const int k = LL(l); phase_ln(p, k, 2, k == 0); }
        if (l == 0) GBAR();
    }
}

extern "C" void kernel_launch(void* const* d_in, const int* in_sizes, int n_in, void* d_out, int out_size, void* d_ws, size_t ws_size, hipStream_t stream) {
    Params p{};
    p.x = (const float*)d_in[0]; p.c = (const float*)d_in[1]; p.ada_w = (const float*)d_in[2]; p.ada_b = (const float*)d_in[3];
    p.ln_g = (const float*)d_in[4]; p.ln_b = (const float*)d_in[5]; p.ffn_w_in = (const float*)d_in[6]; p.ffn_w_out = (const float*)d_in[7];
    p.mix_w_in = (const float*)d_in[8]; p.mix_b_gate = (const float*)d_in[9]; p.mix_b_forget = (const float*)d_in[10];
    p.mix_w_branch = (const float*)d_in[11]; p.mix_w_out = (const float*)d_in[12];
    p.out = (float*)d_out;
    char* ws = (char*)d_ws; size_t off = 0;
    auto take = [&](size_t bytes) { char* r = ws + off; off += (bytes + 255) & ~(size_t)255; return r; };
    p.wts = (bf16_t*)take(2 * WL_ELEMS * 2);
    p.mod = (float*)take(2 * 4 * 9216 * 4);
    p.rope = (float*)take(SEQ * 16 * 4);
    p.ubuf = (bf16_t*)take((size_t)NTOK * 1024 * 2);
    p.act = (bf16_t*)(ws + off);
    p.proj = (bf16_t*)take((size_t)NTOK * NPROJ * 2);
    p.merged = p.proj;
    p.iw = (float*)take((size_t)NTOK * 16); p.logf = (float*)take((size_t)NTOK * 16); p.cum = (float*)take((size_t)NTOK * 16);
    p.maskb = (unsigned*)take((size_t)NTOK * 1024);
    p.ybuf = (bf16_t*)take((size_t)NTOK * 896 * 2);
    p.bar = (unsigned*)take(XCD_BAR_WORDS * 4);
    p.kmax = (float*)take(256);
    if (off > ws_size) { fprintf(stderr, "workspace too small: need %zu have %zu\n", off, ws_size); return; }
    static int grid_blocks = 0;
    if (!grid_blocks) {
        int dev = 0, cus = 0, per_cu = 0;
        (void)hipGetDevice(&dev);
        (void)hipDeviceGetAttribute(&cus, hipDeviceAttributeMultiprocessorCount, dev);
        (void)hipFuncSetAttribute((const void*)mega_kernel, hipFuncAttributeMaxDynamicSharedMemorySize, LDS_BYTES);
        (void)hipOccupancyMaxActiveBlocksPerMultiprocessor(&per_cu, mega_kernel, NTHR, LDS_BYTES);
        if (per_cu < 1) per_cu = 1;
        if (per_cu > 1) per_cu = 1;
        grid_blocks = cus * per_cu;
    }
    (void)hipMemsetAsync(p.bar, 0, XCD_BAR_WORDS * 4, stream);
    void* args[] = {&p};
    hipError_t e = hipLaunchCooperativeKernel((void*)mega_kernel, dim3(grid_blocks), dim3(NTHR), args, LDS_BYTES, stream);
    if (e != hipSuccess) fprintf(stderr, "cooperative launch failed: %s (grid %d)\n", hipGetErrorString(e), grid_blocks);
}
```

```cpp
#include <hip/hip_runtime.h>
#include <hip/hip_cooperative_groups.h>
#include <cstdio>
#include <cstdint>
namespace cg = cooperative_groups;

#define REP_TOPK 1
#define REP_AC 1
#define REP_FLASH 1
#define REP_MERGE 1
constexpr int NTHR = 512, NWV = 8;
constexpr int DM = 1024, SEQ = 8192, NTOK = 4 * 8192, DFF = 2816;
constexpr int NPROJ = 3840;
constexpr int PA = 0, PB = 1152, PIQ = 1920, PIK = 2176, PC = 2240, PD = 3008, PIW = 3776;
constexpr float ALPHA = 1.41421356237f;
constexpr size_t W_FIN0 = 0, W_FIN1 = 5767168, W_FOUT0 = 11534336, W_FOUT1 = 11534336 + 2883584, W_IN = 17301504,
                 W_GATE = 21233664, W_BR = 25427968, W_OUT = 26345472, WL_ELEMS = 27394048;
constexpr int LDS_BYTES = 144 * 1024;


typedef unsigned short bf16_t;
typedef short bf16x8 __attribute__((ext_vector_type(8)));
typedef float f32x4 __attribute__((ext_vector_type(4)));

struct Params {
    const float *x, *c, *ada_w, *ada_b, *ln_g, *ln_b, *ffn_w_in, *ffn_w_out, *mix_w_in, *mix_b_gate, *mix_b_forget, *mix_w_branch, *mix_w_out;
    float* out;
    bf16_t* wts; float* mod; float* rope; bf16_t* ubuf; bf16_t* act; bf16_t* proj; bf16_t* merged;
    float* iw; float* logf; float* cum; unsigned* maskb; bf16_t* ybuf;
    unsigned* bar; float* kmax;
};

__device__ __forceinline__ bf16_t f2bf(float f) { unsigned u = __float_as_uint(f); u += 0x7FFFu + ((u >> 16) & 1u); return (bf16_t)(u >> 16); }
__device__ __forceinline__ float bf2f(bf16_t h) { return __uint_as_float(((unsigned)h) << 16); }
__device__ __forceinline__ float blo(unsigned u) { return __uint_as_float(u << 16); }
__device__ __forceinline__ float bhi(unsigned u) { return __uint_as_float(u & 0xffff0000u); }
__device__ __forceinline__ int otid() { int t = threadIdx.x; asm volatile("" : "+v"(t)); return t; }
__device__ __forceinline__ unsigned pk_bf16(float lo, float hi) { unsigned r; asm volatile("v_cvt_pk_bf16_f32 %0, %1, %2" : "=v"(r) : "v"(lo), "v"(hi)); return r; }
__device__ __forceinline__ float log_sigmoid(float x) { return fminf(x, 0.f) - log1pf(expf(-fabsf(x))); }

__device__ __forceinline__ int colmap(int mode, int n) {
    if (mode == 0) return n;
    if (mode == 1) { int q = n >> 8, r = n & 255; return r < 128 ? 128 * q + r : 2816 + 128 * q + (r - 128); }
    if (mode == 2) { if (n < 2240) return n; if (n < 3776) return n + 4; if (n < 3780) return 2240 + (n - 3776); if (n < 3784) return n; return -1; }
    return 3784 + n;
}
__device__ __forceinline__ void convert_job(const float* __restrict__ src, int K, int Nsrc, bf16_t* __restrict__ dst, int Ndst, int mode, char* smem) {
    float (*t)[33] = (float (*)[33])smem;
    const int tid = threadIdx.x, tx = tid & 31, ty = tid >> 5;
    const int kt_n = K / 64, ntiles = kt_n * (Ndst / 32);
    for (int tile = blockIdx.x; tile < ntiles; tile += gridDim.x) {
        const int k0 = (tile % kt_n) * 64, n0 = (tile / kt_n) * 32;
        const int sc = colmap(mode, n0 + tx);
        __syncthreads();
#pragma unroll
        for (int i = 0; i < 4; ++i) { const int k = ty + 16 * i; t[k][tx] = sc >= 0 ? src[(size_t)(k0 + k) * Nsrc + sc] : 0.f; }
        __syncthreads();
        const int kk = tid & 63, nb = tid >> 6;
#pragma unroll
        for (int i = 0; i < 4; ++i) { const int n = nb + 8 * i; dst[(size_t)(n0 + n) * K + k0 + kk] = f2bf(t[kk][n]); }
    }
}

__device__ __forceinline__ void phase_prologue(const Params& p, char* smem) {
    for (int l = 0; l < 2; ++l) {
        bf16_t* w = p.wts + (size_t)l * WL_ELEMS;
        convert_job(p.ffn_w_in + (size_t)(l * 2 + 0) * 1024 * 5632, 1024, 5632, w + W_FIN0, 5632, 1, smem);
        convert_job(p.ffn_w_in + (size_t)(l * 2 + 1) * 1024 * 5632, 1024, 5632, w + W_FIN1, 5632, 1, smem);
        convert_job(p.ffn_w_out + (size_t)(l * 2 + 0) * 2816 * 1024, 2816, 1024, w + W_FOUT0, 1024, 0, smem);
        convert_job(p.ffn_w_out + (size_t)(l * 2 + 1) * 2816 * 1024, 2816, 1024, w + W_FOUT1, 1024, 0, smem);
        convert_job(p.mix_w_in + (size_t)l * 1024 * 7880, 1024, 7880, w + W_IN, 3840, 2, smem);
        convert_job(p.mix_w_in + (size_t)l * 1024 * 7880, 1024, 7880, w + W_GATE, 4096, 3, smem);
        convert_job(p.mix_w_branch + (size_t)l * 896 * 1024, 896, 1024, w + W_BR, 1024, 0, smem);
        convert_job(p.mix_w_out + (size_t)l * 1024 * 1024, 1024, 1024, w + W_OUT, 1024, 0, smem);
    }
    for (int idx = blockIdx.x * NTHR + threadIdx.x; idx < SEQ * 8; idx += gridDim.x * NTHR) {
        const int t = idx >> 3, i = idx & 7;
        const float invf = powf(500000.0f, -(float)i * 0.125f);
        const float ang = (float)t * invf;
        p.rope[idx * 2 + 0] = cosf(ang);
        p.rope[idx * 2 + 1] = sinf(ang);
    }
    __syncthreads();
    float* scs = (float*)smem;
    float* red = scs + 4096;
    for (int i = threadIdx.x; i < 4096; i += NTHR) { const float v = p.c[i]; scs[i] = v / (1.f + expf(-v)); }
    __syncthreads();
    const int tid = threadIdx.x, cl = tid & 63, kq = tid >> 6;
    for (int item = blockIdx.x; item < 288; item += gridDim.x) {
        const int l = item / 144, col = (item % 144) * 64 + cl;
        float a0 = 0.f, a1 = 0.f, a2 = 0.f, a3 = 0.f;
        const float* wp = p.ada_w + ((size_t)l * 1024 + kq * 128) * 9216 + col;
#pragma unroll 8
        for (int k = 0; k < 128; ++k) {
            const float w = wp[(size_t)k * 9216]; const int kk = kq * 128 + k;
            a0 = fmaf(scs[kk], w, a0); a1 = fmaf(scs[1024 + kk], w, a1); a2 = fmaf(scs[2048 + kk], w, a2); a3 = fmaf(scs[3072 + kk], w, a3);
        }
        red[(kq * 4 + 0) * 64 + cl] = a0; red[(kq * 4 + 1) * 64 + cl] = a1; red[(kq * 4 + 2) * 64 + cl] = a2; red[(kq * 4 + 3) * 64 + cl] = a3;
        __syncthreads();
        if (kq < 4) {
            const int b = kq; float s = 0.f;
#pragma unroll
            for (int q = 0; q < 8; ++q) s += red[(q * 4 + b) * 64 + cl];
            p.mod[(size_t)(l * 4 + b) * 9216 + col] = s + p.ada_b[(size_t)l * 9216 + col];
        }
        __syncthreads();
    }
}

__device__ __forceinline__ void phase_u0(const Params& p) {
    const size_t n4 = (size_t)NTOK * 256;
    for (size_t i = (size_t)blockIdx.x * NTHR + threadIdx.x; i < n4; i += (size_t)gridDim.x * NTHR) {
        const size_t row = i >> 8; const int c4 = (int)(i & 255) * 4; const int b = (int)(row >> 13);
        const float4 v = *(const float4*)(p.x + row * 1024 + c4);
        const float* md = p.mod + (size_t)(0 * 4 + b) * 9216;
        const float4 sh = *(const float4*)(md + c4), sc = *(const float4*)(md + 1024 + c4);
        ushort4 o; o.x = f2bf(v.x * (1.f + sc.x) + sh.x); o.y = f2bf(v.y * (1.f + sc.y) + sh.y); o.z = f2bf(v.z * (1.f + sc.z) + sh.z); o.w = f2bf(v.w * (1.f + sc.w) + sh.w);
        *(ushort4*)(p.ubuf + row * 1024 + c4) = o;
    }
}

constexpr int MP = 72;
__device__ __forceinline__ void gemm_mainloop(f32x4 (&acc)[4][4], const bf16_t* __restrict__ A, int lda, const bf16_t* __restrict__ Bt, int ldb, int K, char* smem) {
    bf16_t* As = (bf16_t*)smem; bf16_t* Bs = As + 256 * MP;
    int tid_ = threadIdx.x; asm volatile("" : "+v"(tid_));
    const int tid = tid_, lane = tid & 63, wid = tid >> 6, wr = wid >> 1, wc = wid & 1;
    const int ar = tid >> 1, ak = (tid & 1) * 32;
    const int br = tid >> 2, bk = (tid & 3) * 16;
    const uint4* ga = (const uint4*)(A + (size_t)ar * lda + ak);
    const uint4* gb = (const uint4*)(Bt + (size_t)br * ldb + bk);
    uint4 ra0 = ga[0], ra1 = ga[1], ra2 = ga[2], ra3 = ga[3], rb0 = gb[0], rb1 = gb[1];
    const int fr = lane & 15, fq = lane >> 4;
    for (int k0 = 0; k0 < K; k0 += 64) {
        __syncthreads();
        *(uint4*)&As[ar * MP + ak] = ra0; *(uint4*)&As[ar * MP + ak + 8] = ra1; *(uint4*)&As[ar * MP + ak + 16] = ra2; *(uint4*)&As[ar * MP + ak + 24] = ra3;
        *(uint4*)&Bs[br * MP + bk] = rb0; *(uint4*)&Bs[br * MP + bk + 8] = rb1;
        __syncthreads();
        if (k0 + 64 < K) { ga += 8; gb += 8; ra0 = ga[0]; ra1 = ga[1]; ra2 = ga[2]; ra3 = ga[3]; rb0 = gb[0]; rb1 = gb[1]; }
#pragma unroll
        for (int kk = 0; kk < 2; ++kk) {
            bf16x8 a[4], b[4];
#pragma unroll
            for (int m = 0; m < 4; ++m) a[m] = *(const bf16x8*)&As[(wr * 64 + m * 16 + fr) * MP + kk * 32 + fq * 8];
#pragma unroll
            for (int n = 0; n < 4; ++n) b[n] = *(const bf16x8*)&Bs[(wc * 64 + n * 16 + fr) * MP + kk * 32 + fq * 8];
#pragma unroll
            for (int m = 0; m < 4; ++m)
#pragma unroll
                for (int n = 0; n < 4; ++n) acc[m][n] = __builtin_amdgcn_mfma_f32_16x16x32_bf16(a[m], b[n], acc[m][n], 0, 0, 0);
        }
    }
}
__device__ __forceinline__ void zero_acc(f32x4 (&acc)[4][4]) {
#pragma unroll
    for (int m = 0; m < 4; ++m)
#pragma unroll
        for (int n = 0; n < 4; ++n) acc[m][n] = (f32x4){0.f, 0.f, 0.f, 0.f};
}
__device__ __forceinline__ void phase_merge(const Params& p, int l, char* smem) {
    const bf16_t* WG = p.wts + (size_t)l * WL_ELEMS + W_GATE; const bf16_t* WB = p.wts + (size_t)l * WL_ELEMS + W_BR;
    const int tid = otid(), lane = tid & 63, wid = tid >> 6, wr = wid >> 1, wc = wid & 1, fr = lane & 15, fq = lane >> 4;
    for (int tile = blockIdx.x; tile < 128 * 8; tile += gridDim.x) {
        const int pm = tile / 8, pn = tile % 8;
        f32x4 accM[4][4]; zero_acc(accM);
#pragma unroll 1
        for (int br = 0; br < 4; ++br) {
            const int koff = br == 0 ? 0 : 128 + (br - 1) * 256, kb = br == 0 ? 128 : 256;
            f32x4 accG[4][4]; zero_acc(accG);
            gemm_mainloop(accG, p.ubuf + (size_t)pm * 256 * 1024, 1024, WG + (size_t)(br * 1024 + pn * 128) * 1024, 1024, 1024, smem);
            const float* bg = p.mix_b_gate + (size_t)l * 4096 + br * 1024;
#pragma unroll
            for (int n = 0; n < 4; ++n) {
                const float bv = bg[pn * 128 + wc * 64 + n * 16 + fr];
#pragma unroll
                for (int m = 0; m < 4; ++m)
#pragma unroll
                    for (int j = 0; j < 4; ++j) accG[m][n][j] = 1.f / (1.f + expf(-(accG[m][n][j] + bv)));
            }
            unsigned* gst = (unsigned*)(smem + 65536) + tid;
#pragma unroll
            for (int m = 0; m < 4; ++m)
#pragma unroll
                for (int n = 0; n < 4; ++n) {
                    gst[((m * 4 + n) * 2 + 0) * NTHR] = (unsigned)f2bf(accG[m][n][0]) | ((unsigned)f2bf(accG[m][n][1]) << 16);
                    gst[((m * 4 + n) * 2 + 1) * NTHR] = (unsigned)f2bf(accG[m][n][2]) | ((unsigned)f2bf(accG[m][n][3]) << 16);
                }
            zero_acc(accG);
            gemm_mainloop(accG, p.ybuf + (size_t)pm * 256 * 896 + koff, 896, WB + (size_t)pn * 128 * 896 + koff, 896, kb, smem);
#pragma unroll
            for (int m = 0; m < 4; ++m)
#pragma unroll
                for (int n = 0; n < 4; ++n) {
                    const unsigned g01 = gst[((m * 4 + n) * 2 + 0) * NTHR], g23 = gst[((m * 4 + n) * 2 + 1) * NTHR];
                    accM[m][n][0] += blo(g01) * accG[m][n][0]; accM[m][n][1] += bhi(g01) * accG[m][n][1];
                    accM[m][n][2] += blo(g23) * accG[m][n][2]; accM[m][n][3] += bhi(g23) * accG[m][n][3];
                }
        }
#pragma unroll
        for (int m = 0; m < 4; ++m)
#pragma unroll
            for (int n = 0; n < 4; ++n)
#pragma unroll
                for (int j = 0; j < 4; ++j)
                    p.merged[(size_t)(pm * 256 + wr * 64 + m * 16 + fq * 4 + j) * 1024 + pn * 128 + wc * 64 + n * 16 + fr] = f2bf(accM[m][n][j]);
    }
}

__device__ __forceinline__ void phase_ln(const Params& p, int l, int s, bool has_next) {
    const int tid_ = otid(), lane = tid_ & 63, wid = tid_ >> 6;
    const float* g = p.ln_g + (size_t)(l * 3 + s) * 1024; const float* bb = p.ln_b + (size_t)(l * 3 + s) * 1024;
    const int nl = s < 2 ? l : l + 1, ns = s < 2 ? s + 1 : 0;
    for (int row = blockIdx.x * NWV + wid; row < NTOK; row += gridDim.x * NWV) {
        float* xr = p.out + (size_t)row * 1024;
        float4 v[4]; float sum = 0.f;
#pragma unroll
        for (int i = 0; i < 4; ++i) { v[i] = *(const float4*)(xr + lane * 4 + 256 * i); sum += (v[i].x + v[i].y) + (v[i].z + v[i].w); }
#pragma unroll
        for (int o = 32; o > 0; o >>= 1) sum += __shfl_xor(sum, o);
        const float mu = sum * (1.f / 1024.f); float q = 0.f;
#pragma unroll
        for (int i = 0; i < 4; ++i) { const float a = v[i].x - mu, b2 = v[i].y - mu, c = v[i].z - mu, d = v[i].w - mu; q += (a * a + b2 * b2) + (c * c + d * d); }
#pragma unroll
        for (int o = 32; o > 0; o >>= 1) q += __shfl_xor(q, o);
        const float rstd = 1.0f / sqrtf(q * (1.f / 1024.f) + 1e-5f);
        const int b = row >> 13;
        const float* md = p.mod + (size_t)(nl * 4 + b) * 9216 + ns * 3072;
#pragma unroll
        for (int i = 0; i < 4; ++i) {
            const int c4 = lane * 4 + 256 * i;
            const float4 gg = *(const float4*)(g + c4), be = *(const float4*)(bb + c4);
            float4 o; o.x = (v[i].x - mu) * rstd * gg.x + be.x; o.y = (v[i].y - mu) * rstd * gg.y + be.y; o.z = (v[i].z - mu) * rstd * gg.z + be.z; o.w = (v[i].w - mu) * rstd * gg.w + be.w;
            *(float4*)(xr + c4) = o;
            if (has_next) {
                const float4 sh = *(const float4*)(md + c4), sc = *(const float4*)(md + 1024 + c4);
                ushort4 u; u.x = f2bf(o.x * (1.f + sc.x) + sh.x); u.y = f2bf(o.y * (1.f + sc.y) + sh.y); u.z = f2bf(o.z * (1.f + sc.z) + sh.z); u.w = f2bf(o.w * (1.f + sc.w) + sh.w);
                *(ushort4*)(p.ubuf + (size_t)row * 1024 + c4) = u;
            }
        }
    }
}

__device__ __forceinline__ void load_row32(float (&q)[32], const bf16_t* row) {
    const uint4* r = (const uint4*)row;
#pragma unroll
    for (int c = 0; c < 4; ++c) { const uint4 v = r[c];
        q[c * 8 + 0] = blo(v.x); q[c * 8 + 1] = bhi(v.x); q[c * 8 + 2] = blo(v.y); q[c * 8 + 3] = bhi(v.y);
        q[c * 8 + 4] = blo(v.z); q[c * 8 + 5] = bhi(v.z); q[c * 8 + 6] = blo(v.w); q[c * 8 + 7] = bhi(v.w); }
}
__device__ __forceinline__ float dot32(const float (&q)[32], const bf16_t* row) {
    const uint4* r = (const uint4*)row; float a = 0.f;
#pragma unroll
    for (int c = 0; c < 4; ++c) { const uint4 v = r[c];
        a = fmaf(q[c * 8 + 0], blo(v.x), a); a = fmaf(q[c * 8 + 1], bhi(v.x), a); a = fmaf(q[c * 8 + 2], blo(v.y), a); a = fmaf(q[c * 8 + 3], bhi(v.y), a);
        a = fmaf(q[c * 8 + 4], blo(v.z), a); a = fmaf(q[c * 8 + 5], bhi(v.z), a); a = fmaf(q[c * 8 + 6], blo(v.w), a); a = fmaf(q[c * 8 + 7], bhi(v.w), a); }
    return a + __shfl_xor(a, 1);
}
__device__ __forceinline__ void axpy32(float (&o)[32], float sc, float pw, const bf16_t* row) {
    const uint4* r = (const uint4*)row;
#pragma unroll
    for (int c = 0; c < 4; ++c) { const uint4 v = r[c];
        o[c * 8 + 0] = fmaf(pw, blo(v.x), o[c * 8 + 0] * sc); o[c * 8 + 1] = fmaf(pw, bhi(v.x), o[c * 8 + 1] * sc);
        o[c * 8 + 2] = fmaf(pw, blo(v.y), o[c * 8 + 2] * sc); o[c * 8 + 3] = fmaf(pw, bhi(v.y), o[c * 8 + 3] * sc);
        o[c * 8 + 4] = fmaf(pw, blo(v.z), o[c * 8 + 4] * sc); o[c * 8 + 5] = fmaf(pw, bhi(v.z), o[c * 8 + 5] * sc);
        o[c * 8 + 6] = fmaf(pw, blo(v.w), o[c * 8 + 6] * sc); o[c * 8 + 7] = fmaf(pw, bhi(v.w), o[c * 8 + 7] * sc); }
}
__device__ __forceinline__ void store_row32(bf16_t* dst, const float (&o)[32], float sc) {
    uint4* r = (uint4*)dst;
#pragma unroll
    for (int c = 0; c < 4; ++c) { uint4 v;
        v.x = (unsigned)f2bf(o[c * 8 + 0] * sc) | ((unsigned)f2bf(o[c * 8 + 1] * sc) << 16); v.y = (unsigned)f2bf(o[c * 8 + 2] * sc) | ((unsigned)f2bf(o[c * 8 + 3] * sc) << 16);
        v.z = (unsigned)f2bf(o[c * 8 + 4] * sc) | ((unsigned)f2bf(o[c * 8 + 5] * sc) << 16); v.w = (unsigned)f2bf(o[c * 8 + 6] * sc) | ((unsigned)f2bf(o[c * 8 + 7] * sc) << 16);
        r[c] = v; }
}
__device__ __forceinline__ void zero32(float (&o)[32]) {
#pragma unroll
    for (int i = 0; i < 32; ++i) o[i] = 0.f;
}

typedef float f32x16 __attribute__((ext_vector_type(16)));
typedef short s16x4 __attribute__((ext_vector_type(4)));
constexpr int FK_PITCH = 72, FV_PITCH = 68;
__device__ __forceinline__ int crow16(int i, int hh) { return (i & 3) + 8 * (i >> 2) + 4 * hh; }
template <int KIND>
__device__ __forceinline__ void flash_unit(const Params& p, int b, int h, int qb, char* smem, int tid) {
    bf16_t* Ks = (bf16_t*)smem;
    bf16_t* Vt = Ks + 2 * 64 * FK_PITCH;
    float* ckl = (float*)(Vt + 2 * 64 * FV_PITCH);
    const int lane = tid & 63, w = tid >> 6, r = lane & 31, hh = lane >> 5;
    const int QOFF = KIND == 0 ? PD : (KIND == 1 ? PB : PC), YOFF = KIND == 0 ? 640 : (KIND == 1 ? 128 : 384);
    const int q0 = qb * 256, qw0 = q0 + 32 * w, tq = qw0 + r;
    const size_t tokb = (size_t)b * SEQ, tok = tokb + tq;
    const float L2E = 1.44269504089f, C1 = 0.125f * 1.44269504089f;
    bf16x8 qf[4];
#pragma unroll
    for (int ks = 0; ks < 4; ++ks) qf[ks] = *(const bf16x8*)(p.proj + tok * NPROJ + QOFF + h * 64 + 16 * ks + 8 * hh);
    float cql = 0.f; if (KIND == 0) cql = p.cum[tok * 4 + h] * L2E;
    const unsigned* mrow = p.maskb + tok * 256;
    f32x16 o0, o1;
#pragma unroll
    for (int i = 0; i < 16; ++i) { o0[i] = 0.f; o1[i] = 0.f; }
    float mrun = -INFINITY, lrun = 0.f;
    const int ntiles = 4 * (qb + 1);
    const int skey = tid >> 3, sch = tid & 7;
    const bf16_t* kg = p.proj + (tokb + skey) * NPROJ + QOFF + 256 + h * 64 + sch * 8;
    constexpr bool REV = (KIND != 1);
    const int jfirst = REV ? ntiles - 1 : 0;
    uint4 kreg = *(const uint4*)(kg + (size_t)jfirst * 64 * NPROJ), vreg = *(const uint4*)(kg + (size_t)jfirst * 64 * NPROJ + 256);
    float creg = 0.f; if (KIND == 0 && tid < 64) creg = p.cum[(tokb + jfirst * 64 + tid) * 4 + h] * L2E;
    float qbound = 0.f, cend = 0.f;
    if (KIND == 0) {
        float ss = 0.f;
#pragma unroll
        for (int ks = 0; ks < 4; ++ks)
#pragma unroll
            for (int e = 0; e < 8; ++e) { const float f = bf2f((bf16_t)qf[ks][e]); ss = fmaf(f, f, ss); }
        ss += __shfl_xor(ss, 32);
        qbound = sqrtf(ss) * p.kmax[b * 4 + h] * C1 * 1.001f + cql;
        cend = p.cum[(tokb + jfirst * 64 + 63) * 4 + h] * L2E;
    }
    uint2 mreg = make_uint2(0u, 0u); if (KIND == 1) mreg = *(const uint2*)(mrow);
    float run = 0.f;
#pragma unroll 1
    for (int jj = 0; jj < ntiles; ++jj) {
        const int j = REV ? ntiles - 1 - jj : jj;
        const int buf = jj & 1;
        bf16_t* ksb = Ks + buf * 64 * FK_PITCH; bf16_t* vtb = Vt + buf * 64 * FV_PITCH; float* cb = ckl + buf * 64;
        *(uint4*)&ksb[skey * FK_PITCH + sch * 8] = kreg;
        {
            bf16_t* vd = vtb + (sch * 8) * FV_PITCH + skey;
            vd[0 * FV_PITCH] = (bf16_t)(vreg.x & 0xffffu); vd[1 * FV_PITCH] = (bf16_t)(vreg.x >> 16);
            vd[2 * FV_PITCH] = (bf16_t)(vreg.y & 0xffffu); vd[3 * FV_PITCH] = (bf16_t)(vreg.y >> 16);
            vd[4 * FV_PITCH] = (bf16_t)(vreg.z & 0xffffu); vd[5 * FV_PITCH] = (bf16_t)(vreg.z >> 16);
            vd[6 * FV_PITCH] = (bf16_t)(vreg.w & 0xffffu); vd[7 * FV_PITCH] = (bf16_t)(vreg.w >> 16);
        }
        if (KIND == 0 && tid < 64) cb[tid] = creg;
        const uint2 mw = mreg;
        if (KIND == 2) { if (__syncthreads_and(run < -60.f)) break; }
        else if (KIND == 0) { if (__syncthreads_and(qbound - cend < mrun - 51.f)) break; }
        else __syncthreads();
        if (jj + 1 < ntiles) {
            const int jn = REV ? j - 1 : j + 1;
            if (KIND == 0) cend = p.cum[(tokb + jn * 64 + 63) * 4 + h] * L2E;
            const bf16_t* kn = kg + (size_t)jn * 64 * NPROJ;
            kreg = *(const uint4*)kn; vreg = *(const uint4*)(kn + 256);
            if (KIND == 0 && tid < 64) creg = p.cum[(tokb + jn * 64 + tid) * 4 + h] * L2E;
            if (KIND == 1) mreg = *(const uint2*)(mrow + 2 * jn);
        }
#pragma unroll
        for (int sb = 0; sb < 2; ++sb) {
            const int sub = REV ? 1 - sb : sb;
            const int kb = 64 * j + 32 * sub;
            if (KIND == 2 ? (kb > qw0) : (kb > qw0 + 31)) continue;
            f32x16 x;
#pragma unroll
            for (int i = 0; i < 16; ++i) x[i] = 0.f;
#pragma unroll
            for (int ks = 0; ks < 4; ++ks) {
                const bf16x8 a = *(const bf16x8*)&ksb[(32 * sub + r) * FK_PITCH + 16 * ks + 8 * hh];
                x = __builtin_amdgcn_mfma_f32_32x32x16_bf16(a, qf[ks], x, 0, 0, 0);
            }
            if (KIND == 2) {
                const bool diag = (kb == qw0);
                float lk[16], sg[4];
#pragma unroll
                for (int g = 0; g < 4; ++g) {
                    float acc = 0.f;
#pragma unroll
                    for (int e = 0; e < 4; ++e) {
                        const float z = x[4 * g + e] * 0.125f;
                        float lb = fminf(z, 0.f) - 0.69314718056f * __builtin_amdgcn_logf(1.f + __builtin_amdgcn_exp2f(-fabsf(z) * L2E));
                        float l1 = lb - z;
                        if (diag && (kb + 8 * g + 4 * hh + e >= tq)) { lb = -INFINITY; l1 = 0.f; }
                        x[4 * g + e] = lb; lk[4 * g + e] = l1; acc += l1;
                    }
                    sg[g] = acc;
                }
                float sp[4];
#pragma unroll
                for (int g = 0; g < 4; ++g) sp[g] = __shfl_xor(sg[g], 32);
                float after = 0.f;
#pragma unroll
                for (int g = 3; g >= 0; --g) {
                    const float aft = run + after + (hh == 0 ? sp[g] : 0.f);
                    float suf = 0.f;
#pragma unroll
                    for (int e = 3; e >= 0; --e) { const float lb = x[4 * g + e]; x[4 * g + e] = __builtin_amdgcn_exp2f((lb + aft + suf) * L2E); suf += lk[4 * g + e]; }
                    after += sg[g] + sp[g];
                }
                run += after;
            }
            float mt = -INFINITY;
            if (KIND == 0) {
                const bool diag = kb + 31 > qw0;
#pragma unroll
                for (int g = 0; g < 4; ++g) {
                    const f32x4 ck = *(const f32x4*)&cb[32 * sub + 8 * g + 4 * hh];
#pragma unroll
                    for (int e = 0; e < 4; ++e) {
                        float s = fmaf(x[4 * g + e], C1, cql - ck[e]);
                        if (diag && (kb + 8 * g + 4 * hh + e > tq)) s = -INFINITY;
                        x[4 * g + e] = s; mt = fmaxf(mt, s);
                    }
                }
            } else if (KIND == 1) {
                const unsigned wbits = sub == 0 ? mw.x : mw.y;
#pragma unroll
                for (int i = 0; i < 16; ++i) {
                    float s = x[i] * C1;
                    if (!((wbits >> crow16(i, hh)) & 1u)) s = -INFINITY;
                    x[i] = s; mt = fmaxf(mt, s);
                }
            }
            if (KIND != 2) {
            mt = fmaxf(mt, __shfl_xor(mt, 32));
            const float mnew = fmaxf(mrun, mt), msafe = (mnew == -INFINITY) ? 0.f : mnew;
            const float alpha = __builtin_amdgcn_exp2f(mrun - msafe);
            float ps = 0.f;
#pragma unroll
            for (int i = 0; i < 16; ++i) { const float e = __builtin_amdgcn_exp2f(x[i] - msafe); x[i] = e; ps += e; }
            lrun = lrun * alpha + ps; mrun = mnew;
            if (__any(alpha != 1.f)) {
#pragma unroll
                for (int i = 0; i < 16; ++i) { o0[i] *= alpha; o1[i] *= alpha; }
            }
            }
            bf16x8 pf[2];
#pragma unroll
            for (int s = 0; s < 2; ++s) {
                unsigned pk[4];
#pragma unroll
                for (int e = 0; e < 4; ++e) pk[e] = pk_bf16(x[8 * s + 2 * e], x[8 * s + 2 * e + 1]);
                pf[s] = __builtin_bit_cast(bf16x8, (uint4){pk[0], pk[1], pk[2], pk[3]});
            }
#pragma unroll
            for (int s = 0; s < 2; ++s) {
#pragma unroll
                for (int dt = 0; dt < 2; ++dt) {
                    const bf16_t* vp = vtb + (32 * dt + r) * FV_PITCH + 32 * sub + 16 * s + 4 * hh;
                    const s16x4 lo = *(const s16x4*)vp, hi = *(const s16x4*)(vp + 8);
                    const bf16x8 vf = __builtin_shufflevector(lo, hi, 0, 1, 2, 3, 4, 5, 6, 7);
                    if (dt == 0) o0 = __builtin_amdgcn_mfma_f32_32x32x16_bf16(vf, pf[s], o0, 0, 0, 0);
                    else o1 = __builtin_amdgcn_mfma_f32_32x32x16_bf16(vf, pf[s], o1, 0, 0, 0);
                }
            }
        }
    }
    const float ltot = lrun + __shfl_xor(lrun, 32), inv = KIND == 2 ? 1.f : 1.f / ltot;
    bf16_t* yo = p.ybuf + tok * 896 + YOFF + h * 64;
#pragma unroll
    for (int g = 0; g < 4; ++g) {
        uint2 w0, w1;
        w0.x = (unsigned)f2bf(o0[4 * g] * inv) | ((unsigned)f2bf(o0[4 * g + 1] * inv) << 16); w0.y = (unsigned)f2bf(o0[4 * g + 2] * inv) | ((unsigned)f2bf(o0[4 * g + 3] * inv) << 16);
        w1.x = (unsigned)f2bf(o1[4 * g] * inv) | ((unsigned)f2bf(o1[4 * g + 1] * inv) << 16); w1.y = (unsigned)f2bf(o1[4 * g + 2] * inv) | ((unsigned)f2bf(o1[4 * g + 3] * inv) << 16);
        *(uint2*)(yo + 8 * g + 4 * hh) = w0; *(uint2*)(yo + 32 + 8 * g + 4 * hh) = w1;
    }
}
__device__ __forceinline__ void phase_attn_a(const Params& p, char* smem) {
    const int tid = otid(), lane = tid & 63, w = tid >> 6, r = lane & 31, hh = lane >> 5;
    bf16_t* vt = (bf16_t*)smem + w * (64 * 36);
    const float C1 = 0.125f * 1.44269504089f;
    __syncthreads();
    for (int item = blockIdx.x * NWV + w; item < 2048; item += gridDim.x * NWV) {
        const int hp = item & 1, rho = (item >> 1) & 15, m = (item >> 5) & 15, b = item >> 9;
        const size_t tokb = (size_t)b * SEQ;
        const int tq = 512 * m + rho + 16 * r;
        f32x16 o0, o1;
#pragma unroll
        for (int i = 0; i < 16; ++i) { o0[i] = 0.f; o1[i] = 0.f; }
        float mrun = -INFINITY, lrun = 0.f;
#pragma unroll 1
        for (int g = 0; g < 3; ++g) {
            const int d = g == 0 ? 1 : (g == 1 ? 4 : 16), c = 16 / d, head = 2 * g + hp, nsub = g == 0 ? 20 : (g == 1 ? 8 : 5);
            const int res = rho & (d - 1), n0 = (512 * m + rho - res) / d, nq = n0 + c * r, nmax = n0 + 31 * c, ks0 = n0 - 128;
            bf16x8 qf[4];
#pragma unroll
            for (int ks = 0; ks < 4; ++ks) qf[ks] = *(const bf16x8*)(p.proj + (tokb + tq) * NPROJ + PA + head * 64 + 16 * ks + 8 * hh);
            const bf16_t* kcol = p.proj + tokb * NPROJ + PA + 384 + head * 64;
#pragma unroll 1
            for (int st = 0; st < nsub; ++st) {
                const int kbase = ks0 + 32 * st;
                if (kbase + 31 < 0) continue;
                int kk = kbase + r; kk = kk < 0 ? 0 : (kk > nmax ? nmax : kk);
                const bf16_t* krow = kcol + (size_t)(kk * d + res) * NPROJ + 8 * hh;
                bf16x8 a[4];
#pragma unroll
                for (int ks = 0; ks < 4; ++ks) a[ks] = *(const bf16x8*)(krow + 16 * ks);
                int kv = kbase + (lane >> 1); kv = kv < 0 ? 0 : (kv > nmax ? nmax : kv);
                const uint4* vrow = (const uint4*)(kcol + (size_t)(kv * d + res) * NPROJ + 384 + (lane & 1) * 32);
                uint4 vv[4];
#pragma unroll
                for (int q = 0; q < 4; ++q) vv[q] = vrow[q];
                f32x16 x;
#pragma unroll
                for (int i = 0; i < 16; ++i) x[i] = 0.f;
#pragma unroll
                for (int ks = 0; ks < 4; ++ks) x = __builtin_amdgcn_mfma_f32_32x32x16_bf16(a[ks], qf[ks], x, 0, 0, 0);
                {
                    bf16_t* vd = vt + ((lane & 1) * 32) * 36 + (lane >> 1);
#pragma unroll
                    for (int q = 0; q < 4; ++q) {
                        vd[(8 * q + 0) * 36] = (bf16_t)(vv[q].x & 0xffffu); vd[(8 * q + 1) * 36] = (bf16_t)(vv[q].x >> 16);
                        vd[(8 * q + 2) * 36] = (bf16_t)(vv[q].y & 0xffffu); vd[(8 * q + 3) * 36] = (bf16_t)(vv[q].y >> 16);
                        vd[(8 * q + 4) * 36] = (bf16_t)(vv[q].z & 0xffffu); vd[(8 * q + 5) * 36] = (bf16_t)(vv[q].z >> 16);
                        vd[(8 * q + 6) * 36] = (bf16_t)(vv[q].w & 0xffffu); vd[(8 * q + 7) * 36] = (bf16_t)(vv[q].w >> 16);
                    }
                }
                float mt = -INFINITY;
#pragma unroll
                for (int i = 0; i < 16; ++i) {
                    const int ki = kbase + crow16(i, hh), dist = nq - ki;
                    float s = x[i] * C1;
                    if (ki < 0 || dist < 0 || dist > 128) s = -INFINITY;
                    x[i] = s; mt = fmaxf(mt, s);
                }
                mt = fmaxf(mt, __shfl_xor(mt, 32));
                const float mnew = fmaxf(mrun, mt), msafe = (mnew == -INFINITY) ? 0.f : mnew;
                const float alpha = __builtin_amdgcn_exp2f(mrun - msafe);
                float ps = 0.f;
#pragma unroll
                for (int i = 0; i < 16; ++i) { const float e = __builtin_amdgcn_exp2f(x[i] - msafe); x[i] = e; ps += e; }
                lrun = lrun * alpha + ps; mrun = mnew;
#pragma unroll
                for (int i = 0; i < 16; ++i) { o0[i] *= alpha; o1[i] *= alpha; }
                bf16x8 pf[2];
#pragma unroll
                for (int s = 0; s < 2; ++s) {
                    unsigned pk[4];
#pragma unroll
                    for (int e = 0; e < 4; ++e) pk[e] = pk_bf16(x[8 * s + 2 * e], x[8 * s + 2 * e + 1]);
                    pf[s] = __builtin_bit_cast(bf16x8, (uint4){pk[0], pk[1], pk[2], pk[3]});
                }
                asm volatile("s_waitcnt lgkmcnt(0)" ::: "memory");
#pragma unroll
                for (int s = 0; s < 2; ++s) {
#pragma unroll
                    for (int dt = 0; dt < 2; ++dt) {
                        const bf16_t* vp = vt + (32 * dt + r) * 36 + 16 * s + 4 * hh;
                        const s16x4 lo = *(const s16x4*)vp, hi = *(const s16x4*)(vp + 8);
                        const bf16x8 vf = __builtin_shufflevector(lo, hi, 0, 1, 2, 3, 4, 5, 6, 7);
                        if (dt == 0) o0 = __builtin_amdgcn_mfma_f32_32x32x16_bf16(vf, pf[s], o0, 0, 0, 0);
                        else o1 = __builtin_amdgcn_mfma_f32_32x32x16_bf16(vf, pf[s], o1, 0, 0, 0);
                    }
                }
                asm volatile("s_waitcnt lgkmcnt(0)" ::: "memory");
            }
        }
        const float ltot = lrun + __shfl_xor(lrun, 32), inv = 1.f / ltot;
        bf16_t* yo = p.ybuf + (tokb + tq) * 896 + hp * 64;
#pragma unroll
        for (int g = 0; g < 4; ++g) {
            uint2 w0, w1;
            w0.x = (unsigned)f2bf(o0[4 * g] * inv) | ((unsigned)f2bf(o0[4 * g + 1] * inv) << 16); w0.y = (unsigned)f2bf(o0[4 * g + 2] * inv) | ((unsigned)f2bf(o0[4 * g + 3] * inv) << 16);
            w1.x = (unsigned)f2bf(o1[4 * g] * inv) | ((unsigned)f2bf(o1[4 * g + 1] * inv) << 16); w1.y = (unsigned)f2bf(o1[4 * g + 2] * inv) | ((unsigned)f2bf(o1[4 * g + 3] * inv) << 16);
            *(uint2*)(yo + 8 * g + 4 * hh) = w0; *(uint2*)(yo + 32 + 8 * g + 4 * hh) = w1;
        }
    }
}
__device__ __forceinline__ void phase_flash(const Params& p, char* smem) {
    const int tid = otid();
    for (int it = blockIdx.x; it < 768; it += gridDim.x) {
        const int kind = it >> 8, c = it & 255, bh = c & 15, qs = c >> 4;
#pragma unroll 1
        for (int half = 0; half < 2; ++half) {
            const int qb = half ? 31 - qs : qs;
            __syncthreads();
            if (kind == 0) flash_unit<0>(p, bh >> 2, bh & 3, qb, smem, tid);
            else if (kind == 1) flash_unit<1>(p, bh >> 2, bh & 3, qb, smem, tid);
            else flash_unit<2>(p, bh >> 2, bh & 3, qb, smem, tid);
        }
    }
}
__device__ __forceinline__ void phase_scan(const Params& p, char* smem) {
    double* part = (double*)smem;
    float* pm = (float*)(part + NTHR);
    const int tid = otid();
    for (int item = blockIdx.x; item < 16; item += gridDim.x) {
        const int b = item >> 2, h = item & 3;
        const float* lf = p.logf + ((size_t)b * SEQ + tid * 16) * 4 + h;
        double s = 0.0;
        for (int i = 0; i < 16; ++i) s += (double)lf[i * 4];
        float kmx = 0.f;
        for (int i = 0; i < 16; ++i) {
            const uint4* kr = (const uint4*)(p.proj + ((size_t)b * SEQ + tid * 16 + i) * NPROJ + PD + 256 + h * 64);
            float ss = 0.f;
#pragma unroll
            for (int c = 0; c < 8; ++c) { const uint4 v = kr[c];
                ss = fmaf(blo(v.x), blo(v.x), ss); ss = fmaf(bhi(v.x), bhi(v.x), ss); ss = fmaf(blo(v.y), blo(v.y), ss); ss = fmaf(bhi(v.y), bhi(v.y), ss);
                ss = fmaf(blo(v.z), blo(v.z), ss); ss = fmaf(bhi(v.z), bhi(v.z), ss); ss = fmaf(blo(v.w), blo(v.w), ss); ss = fmaf(bhi(v.w), bhi(v.w), ss); }
            kmx = fmaxf(kmx, ss);
        }
        __syncthreads();
        part[tid] = s; pm[tid] = kmx;
        __syncthreads();
        if (tid == 0) { double r = 0.0; float mm = 0.f; for (int i = 0; i < NTHR; ++i) { const double v = part[i]; part[i] = r; r += v; mm = fmaxf(mm, pm[i]); } p.kmax[item] = sqrtf(mm); }
        __syncthreads();
        double r = part[tid];
        float* cm = p.cum + ((size_t)b * SEQ + tid * 16) * 4 + h;
        for (int i = 0; i < 16; ++i) { r += (double)lf[i * 4]; cm[i * 4] = (float)r; }
    }
}
__device__ __forceinline__ unsigned f2key(float f) { const unsigned u = __float_as_uint(f); return (u & 0x80000000u) ? ~u : (u | 0x80000000u); }
constexpr int HPITCH = 1028;
template <int PASS>
__device__ __forceinline__ void idx_pass(const Params& p, size_t tokb, int t0, int ktmax, const bf16x8 (&qf)[4][4], float w0, float w1, float w2, float w3,
                                         unsigned* hist, const unsigned* qpre, unsigned* gtb, unsigned* eqb, int lane, int w) {
    const int r = lane & 31, hh = lane >> 5, tq = t0 + r;
    unsigned pre = 0u; if (PASS >= 1) pre = qpre[r];
    unsigned* hrow = hist + r * HPITCH;
    const bf16_t* kbase = p.proj + (tokb + r) * NPROJ + PIK + 8 * hh;
    uint4 an[4];
    if (w <= ktmax) {
#pragma unroll
        for (int ks = 0; ks < 4; ++ks) an[ks] = *(const uint4*)(kbase + (size_t)w * 32 * NPROJ + 16 * ks);
    }
#pragma unroll 1
    for (int kt = w; kt <= ktmax; kt += 8) {
        bf16x8 a[4];
#pragma unroll
        for (int ks = 0; ks < 4; ++ks) a[ks] = __builtin_bit_cast(bf16x8, an[ks]);
        if (kt + 8 <= ktmax) {
#pragma unroll
            for (int ks = 0; ks < 4; ++ks) an[ks] = *(const uint4*)(kbase + (size_t)(kt + 8) * 32 * NPROJ + 16 * ks);
        }
        f32x16 x0, x1, x2, x3;
#pragma unroll
        for (int i = 0; i < 16; ++i) { x0[i] = 0.f; x1[i] = 0.f; x2[i] = 0.f; x3[i] = 0.f; }
#pragma unroll
        for (int ks = 0; ks < 4; ++ks) {
            x0 = __builtin_amdgcn_mfma_f32_32x32x16_bf16(a[ks], qf[0][ks], x0, 0, 0, 0);
            x1 = __builtin_amdgcn_mfma_f32_32x32x16_bf16(a[ks], qf[1][ks], x1, 0, 0, 0);
            x2 = __builtin_amdgcn_mfma_f32_32x32x16_bf16(a[ks], qf[2][ks], x2, 0, 0, 0);
            x3 = __builtin_amdgcn_mfma_f32_32x32x16_bf16(a[ks], qf[3][ks], x3, 0, 0, 0);
        }
        const int kb = kt * 32;
        const bool diag = (kt == ktmax);
        unsigned gw = 0u, ew = 0u;
#pragma unroll
        for (int i = 0; i < 16; ++i) {
            float v = w0 * fmaxf(x0[i], 0.f);
            v = fmaf(w1, fmaxf(x1[i], 0.f), v); v = fmaf(w2, fmaxf(x2[i], 0.f), v); v = fmaf(w3, fmaxf(x3[i], 0.f), v);
            v += 0.0f;
            const unsigned key = f2key(v);
            const int kr = crow16(i, hh);
            const bool valid = !diag || (kb + kr <= tq);
            if (PASS == 0) { if (valid) { const unsigned d = key >> 21; atomicAdd(&hrow[d >> 1], (d & 1u) ? 65536u : 1u); } }
            if (PASS == 1) { if (valid && (key >> 21) == pre) { const unsigned d = (key >> 10) & 2047u; atomicAdd(&hrow[d >> 1], (d & 1u) ? 65536u : 1u); } }
            if (PASS == 2) { if (valid && (key >> 10) == pre) { const unsigned d = key & 1023u; atomicAdd(&hrow[d >> 1], (d & 1u) ? 65536u : 1u); } }
            if (PASS == 3) { gw |= ((valid && key > pre) ? 1u : 0u) << kr; ew |= ((valid && key == pre) ? 1u : 0u) << kr; }
        }
        if (PASS == 3) {
            gw |= __shfl_xor(gw, 32); ew |= __shfl_xor(ew, 32);
            if (hh == 0) { gtb[r * 256 + kt] = gw; eqb[r * 256 + kt] = ew; }
        }
    }
}
__device__ __forceinline__ void idx_search(const unsigned* hist, unsigned* qpre, unsigned* qneed, int shift, int lane, int w) {
#pragma unroll 1
    for (int qi = 0; qi < 4; ++qi) {
        const int q = 4 * w + qi;
        const unsigned need = qneed[q];
        const uint4* hr = (const uint4*)(hist + q * HPITCH + 16 * lane);
        unsigned wr[16];
#pragma unroll
        for (int c = 0; c < 4; ++c) { const uint4 v = hr[c]; wr[4 * c] = v.x; wr[4 * c + 1] = v.y; wr[4 * c + 2] = v.z; wr[4 * c + 3] = v.w; }
        unsigned mine = 0u;
#pragma unroll
        for (int c = 0; c < 16; ++c) mine += (wr[c] & 0xffffu) + (wr[c] >> 16);
        unsigned tot = mine;
#pragma unroll
        for (int o = 1; o < 64; o <<= 1) { const unsigned v = __shfl_down(tot, o); if (lane + o < 64) tot += v; }
        const unsigned excl = tot - mine;
        if (excl < need && tot >= need) {
            unsigned cum = excl, nrem = 0u; int dsel = -1;
#pragma unroll
            for (int c = 15; c >= 0; --c) {
                const unsigned hi = wr[c] >> 16, lo = wr[c] & 0xffffu;
                if (dsel < 0) { if (cum + hi >= need) { dsel = 2 * (16 * lane + c) + 1; nrem = need - cum; } else cum += hi; }
                if (dsel < 0) { if (cum + lo >= need) { dsel = 2 * (16 * lane + c); nrem = need - cum; } else cum += lo; }
            }
            qpre[q] = (qpre[q] << shift) | (unsigned)dsel; qneed[q] = nrem;
        }
    }
}
__device__ __forceinline__ void phase_topk(const Params& p, char* smem) {
    unsigned* hist = (unsigned*)smem;
    unsigned* gtb = hist;
    unsigned* eqb = hist + 32 * 256;
    unsigned* qpre = hist + 32 * HPITCH;
    unsigned* qneed = qpre + 32;
    const int tid = otid(), lane = tid & 63, w = tid >> 6;
    for (int it = blockIdx.x; it < 256; it += gridDim.x) {
#pragma unroll 1
        for (int sub = 0; sub < 4; ++sub) {
            const int u = sub == 0 ? it : (sub == 1 ? 511 - it : (sub == 2 ? 512 + it : 1023 - it));
            const int b = u & 3, blk = u >> 2, t0 = blk * 32;
            const size_t tokb = (size_t)b * SEQ;
            if (t0 + 32 <= 256) {
                for (int i = tid; i < 32 * 256; i += NTHR) {
                    const int q = i >> 8, k = i & 255, n = t0 + q + 1, lo = k * 32;
                    p.maskb[(tokb + t0 + q) * 256 + k] = (lo + 32 <= n) ? 0xffffffffu : (lo >= n ? 0u : ((1u << (n - lo)) - 1u));
                }
                continue;
            }
            const int r = lane & 31, hh = lane >> 5;
            const size_t tok = tokb + t0 + r;
            bf16x8 qf[4][4];
#pragma unroll
            for (int h = 0; h < 4; ++h)
#pragma unroll
                for (int ks = 0; ks < 4; ++ks) qf[h][ks] = *(const bf16x8*)(p.proj + tok * NPROJ + PIQ + h * 64 + 16 * ks + 8 * hh);
            const f32x4 wv = *(const f32x4*)(p.iw + tok * 4);
            const int ktmax = blk;
            __syncthreads();
            if (tid < 32) { qpre[tid] = 0u; qneed[tid] = 256u; }
#pragma unroll 1
            for (int pass = 0; pass < 3; ++pass) {
                for (int i = tid; i < 32 * HPITCH / 4; i += NTHR) ((uint4*)hist)[i] = make_uint4(0u, 0u, 0u, 0u);
                __syncthreads();
                if (pass == 0) idx_pass<0>(p, tokb, t0, ktmax, qf, wv[0], wv[1], wv[2], wv[3], hist, qpre, gtb, eqb, lane, w);
                else if (pass == 1) idx_pass<1>(p, tokb, t0, ktmax, qf, wv[0], wv[1], wv[2], wv[3], hist, qpre, gtb, eqb, lane, w);
                else idx_pass<2>(p, tokb, t0, ktmax, qf, wv[0], wv[1], wv[2], wv[3], hist, qpre, gtb, eqb, lane, w);
                __syncthreads();
                idx_search(hist, qpre, qneed, pass == 2 ? 10 : 11, lane, w);
                __syncthreads();
            }
            for (int i = tid; i < 2 * 32 * 256 / 4; i += NTHR) ((uint4*)hist)[i] = make_uint4(0u, 0u, 0u, 0u);
            __syncthreads();
            idx_pass<3>(p, tokb, t0, ktmax, qf, wv[0], wv[1], wv[2], wv[3], hist, qpre, gtb, eqb, lane, w);
            __syncthreads();
#pragma unroll 1
            for (int qi = 0; qi < 4; ++qi) {
                const int q = 4 * w + qi; const unsigned rr = qneed[q];
                const uint4 g4 = *(const uint4*)&gtb[q * 256 + 4 * lane]; const uint4 e4 = *(const uint4*)&eqb[q * 256 + 4 * lane];
                unsigned ev[4] = {e4.x, e4.y, e4.z, e4.w}, gv[4] = {g4.x, g4.y, g4.z, g4.w};
                const unsigned mine = __popc(ev[0]) + __popc(ev[1]) + __popc(ev[2]) + __popc(ev[3]);
                unsigned incl = mine;
#pragma unroll
                for (int o = 1; o < 64; o <<= 1) { const unsigned v = __shfl_up(incl, o); if (lane >= o) incl += v; }
                unsigned rank = incl - mine;
#pragma unroll
                for (int c = 0; c < 4; ++c) {
                    unsigned e = ev[c]; const unsigned pc = __popc(e);
                    if (rank + pc > rr) {
                        unsigned keep = rank < rr ? rr - rank : 0u, sel = 0u;
                        while (keep > 0u) { const unsigned low = e & (0u - e); sel |= low; e ^= low; --keep; }
                        e = sel;
                    }
                    gv[c] |= e; rank += pc;
                }
                *(uint4*)&p.maskb[(tokb + t0 + q) * 256 + 4 * lane] = make_uint4(gv[0], gv[1], gv[2], gv[3]);
            }
        }
    }
}

namespace pg8 {
#define PG8_LAS __attribute__((address_space(3)))
typedef unsigned short bf16_t;
typedef short bf16x8 __attribute__((ext_vector_type(8)));
typedef float f32x4 __attribute__((ext_vector_type(4)));
typedef unsigned u32x4 __attribute__((ext_vector_type(4)));
constexpr int BM = 256, BK = 64, HALF = 128, HTB = HALF * BK * 2  , STAGE_BYTES = 8 * HTB, NXCD = 8, WGM = 8;

__host__ __device__ __forceinline__ int lds_byte(int r, int c) { const int st = (r >> 4) * 2 + (c >> 5), rr = r & 15, cc = c & 31, ob = rr * 64 + cc * 2; return st * 1024 + (ob ^ (((ob >> 9) & 1) << 5)); }
__host__ __device__ __forceinline__ void stage_rc(int b, int& R, int& C) { const int st = b / 1024, sb = b % 1024, swz = sb ^ (((sb >> 9) & 1) << 5); R = (st >> 1) * 16 + swz / 64; C = (st & 1) * 32 + (swz % 64) / 2; }
__host__ __device__ __forceinline__ int perm32(int rho) { const int n = rho >> 4, i = rho & 15; return 8 * (i >> 2) + 4 * n + (i & 3); }

struct Unit { int pm, pn; };
struct Gemm { const bf16_t* A; const bf16_t* Bt; int M, N, K; };

struct StaticOrder {
    int nM, nN, nwg, G, c;
    __host__ __device__ void init(int M, int N, int G_, int c_) { nM = M / BM; nN = N / BM; nwg = nM * nN; G = G_; c = c_; }
    __host__ __device__ bool next(int i, Unit& u) const {
        const long L = (long)i * G + c; if (L >= nwg) return false;
        int wgid = (int)L; { const int q = nwg / NXCD, r = nwg % NXCD, xcd = wgid % NXCD, off = wgid / NXCD; wgid = (xcd < r ? xcd * (q + 1) : r * (q + 1) + (xcd - r) * q) + off; }
        const int nig = WGM * nN, gid = wgid / nig, fm = gid * WGM, gsz = (nM - fm) < WGM ? (nM - fm) : WGM;
        u.pm = fm + ((wgid % nig) % gsz); u.pn = (wgid % nig) / gsz; return true;
    }
    __device__ __forceinline__ void a_ready(const Unit&) const {}
    __device__ __forceinline__ void done(const Unit&) const {}
};

__device__ __forceinline__ unsigned cvt_pk_bf16(float lo, float hi) { unsigned r; asm volatile("v_cvt_pk_bf16_f32 %0, %1, %2" : "=v"(r) : "v"(lo), "v"(hi)); return r; }
__device__ __forceinline__ float silu_f(float g) { return g / (1.f + __expf(-g)); }
struct EpiSwiGLU {
    static constexpr bool PERM = true, AFTER_DRAIN = false;
    bf16_t* O;
    __device__ __forceinline__ void operator()(const f32x4 (&acc)[2][2][4][2], const Unit& u, int wr, int wc, int fr, int fq) const {
        const int row0 = u.pm * BM + wr * 64 + fr, col0 = u.pn * 128 + wc * 32 + 8 * fq;
#pragma unroll
        for (int ai = 0; ai < 2; ++ai)
#pragma unroll
            for (int m = 0; m < 4; ++m) {
                bf16_t* rowp = O + (size_t)(row0 + ai * HALF + m * 16) * 2816 + col0;
                const f32x4 g0 = acc[ai][0][m][0], g1 = acc[ai][0][m][1], u0 = acc[ai][1][m][0], u1 = acc[ai][1][m][1];
                u32x4 w;
                w.x = cvt_pk_bf16(silu_f(g0[0]) * u0[0], silu_f(g0[1]) * u0[1]); w.y = cvt_pk_bf16(silu_f(g0[2]) * u0[2], silu_f(g0[3]) * u0[3]);
                w.z = cvt_pk_bf16(silu_f(g1[0]) * u1[0], silu_f(g1[1]) * u1[1]); w.w = cvt_pk_bf16(silu_f(g1[2]) * u1[2], silu_f(g1[3]) * u1[3]);
                *(u32x4*)rowp = w;
            }
    }
};
struct EpiRes {
    static constexpr bool PERM = false, AFTER_DRAIN = false;
    const float* xres; float* out; const float* modl; int sub; float fac;
    __device__ __forceinline__ void operator()(const f32x4 (&acc)[2][2][4][2], const Unit& u, int wr, int wc, int fr, int fq) const {
        const int b = (u.pm * BM) >> 13;
        const float* gate = modl + (size_t)b * 9216 + sub * 3072 + 2048;
        const int col0 = u.pn * BM + wc * 32 + 4 * fq;
#pragma unroll
        for (int bj = 0; bj < 2; ++bj)
#pragma unroll
            for (int n = 0; n < 2; ++n) {
                const int col = col0 + bj * HALF + n * 16;
                f32x4 gm = *(const f32x4*)(gate + col); gm = (gm + 1.0f) * fac;
#pragma unroll
                for (int ai = 0; ai < 2; ++ai)
#pragma unroll
                    for (int m = 0; m < 4; ++m) {
                        const size_t off = (size_t)(u.pm * BM + ai * HALF + wr * 64 + m * 16 + fr) * 1024 + col;
                        const f32x4 xr = *(const f32x4*)(xres + off);
                        *(f32x4*)(out + off) = xr * 1.41421356237f + gm * acc[ai][bj][m][n];
                    }
            }
    }
};
struct EpiInproj {
    static constexpr bool PERM = true, AFTER_DRAIN = false;
    bf16_t* proj; const float* rope; float* iw; float* logf; const float* bfg;
    __device__ __forceinline__ void operator()(const f32x4 (&acc)[2][2][4][2], const Unit& u, int wr, int wc, int fr, int fq) const {
#pragma unroll
        for (int bj = 0; bj < 2; ++bj) {
            const int cb32 = u.pn * BM + bj * HALF + wc * 32;
            const bool rp = ((cb32 & 63) == 0) && (cb32 < 768 || (cb32 >= 1152 && cb32 < 1664) || (cb32 >= 1920 && cb32 < 2240));
#pragma unroll
            for (int ai = 0; ai < 2; ++ai)
#pragma unroll
                for (int m = 0; m < 4; ++m) {
                    const int row = u.pm * BM + ai * HALF + wr * 64 + m * 16 + fr;
                    f32x4 v0 = acc[ai][bj][m][0], v1 = acc[ai][bj][m][1];
                    if (rp) {
                        const int t = row & 8191;
                        const f32x4* rt = (const f32x4*)(rope + (size_t)t * 16);
                        const f32x4 r0 = rt[0], r1 = rt[1], r2 = rt[2], r3 = rt[3];
                        f32x4 p0, p1;
#pragma unroll
                        for (int j = 0; j < 4; ++j) { p0[j] = __shfl_xor(v0[j], 16); p1[j] = __shfl_xor(v1[j], 16); }
                        if (fq == 0) {
                            v0[0] = v0[0] * r0[0] - p0[0] * r0[1]; v0[1] = v0[1] * r0[2] - p0[1] * r0[3]; v0[2] = v0[2] * r1[0] - p0[2] * r1[1]; v0[3] = v0[3] * r1[2] - p0[3] * r1[3];
                            v1[0] = v1[0] * r2[0] - p1[0] * r2[1]; v1[1] = v1[1] * r2[2] - p1[1] * r2[3]; v1[2] = v1[2] * r3[0] - p1[2] * r3[1]; v1[3] = v1[3] * r3[2] - p1[3] * r3[3];
                        } else if (fq == 1) {
                            v0[0] = v0[0] * r0[0] + p0[0] * r0[1]; v0[1] = v0[1] * r0[2] + p0[1] * r0[3]; v0[2] = v0[2] * r1[0] + p0[2] * r1[1]; v0[3] = v0[3] * r1[2] + p0[3] * r1[3];
                            v1[0] = v1[0] * r2[0] + p1[0] * r2[1]; v1[1] = v1[1] * r2[2] + p1[1] * r2[3]; v1[2] = v1[2] * r3[0] + p1[2] * r3[1]; v1[3] = v1[3] * r3[2] + p1[3] * r3[3];
                        }
                    }
                    u32x4 w; w.x = cvt_pk_bf16(v0[0], v0[1]); w.y = cvt_pk_bf16(v0[2], v0[3]); w.z = cvt_pk_bf16(v1[0], v1[1]); w.w = cvt_pk_bf16(v1[2], v1[3]);
                    *(u32x4*)(proj + (size_t)row * 3840 + cb32 + 8 * fq) = w;
                    if (cb32 == 3776 && fq == 0) {
                        *(f32x4*)(iw + (size_t)row * 4) = v0;
                        f32x4 lf;
#pragma unroll
                        for (int j = 0; j < 4; ++j) { const float xx = v1[j] + bfg[j]; lf[j] = fminf(xx, 0.f) - log1pf(expf(-fabsf(xx))); }
                        *(f32x4*)(logf + (size_t)row * 4) = lf;
                    }
                }
        }
    }
};
template <class Epi, class Sched, bool ALIGN_EPI = false, bool SP2 = false>
__device__ __forceinline__ void gemm_phase(PG8_LAS unsigned char* lds, const Gemm g, const Sched& S, const Epi& E) {
    int tid_ = threadIdx.x; asm volatile("" : "+v"(tid_));
    const int tid = tid_, wid = __builtin_amdgcn_readfirstlane(tid >> 6), lane = tid & 63, wr = wid >> 2, wc = wid & 3, fr = lane & 15, fq = lane >> 4;
    const int K = g.K, nt = K / BK;
    unsigned voffA[2], voffB[2];
#pragma unroll
    for (int i = 0; i < 2; ++i) { int R, C; stage_rc(tid * 16 + i * 8192, R, C); const int Rb = Epi::PERM ? ((R & ~31) + perm32(R & 31)) : R;
        voffA[i] = (unsigned)(R * K + C) * 2u; voffB[i] = (unsigned)(Rb * K + C) * 2u; }
    const size_t kstep = (size_t)(BK * 2);
    const size_t hstep = (size_t)HALF * K * 2;
    const size_t tstep = 2 * hstep;
    const unsigned ldsw = (unsigned)wid * 1024u;
    const int aoff = lds_byte(wr * 64 + fr, fq * 8), boff = lds_byte(wc * 32 + fr, fq * 8);
#define PG8_SA(b, h) (((b) * 2 + (h)) * HTB)
#define PG8_SB(b, h) ((4 + (b) * 2 + (h)) * HTB)
#define PG8_STAGE(bufoff, gbase, voff) do { _Pragma("unroll") for (int _i = 0; _i < 2; ++_i) \
        __builtin_amdgcn_global_load_lds((const unsigned*)((const char*)(gbase) + (voff)[_i]), (PG8_LAS unsigned*)(lds + (bufoff) + ldsw + _i * 8192), 16, 0, 0); } while (0)
#define PG8_LDA(dst, b, h) do { _Pragma("unroll") for (int m = 0; m < 4; ++m) _Pragma("unroll") for (int k = 0; k < 2; ++k) dst[m][k] = *(const PG8_LAS bf16x8*)(lds + PG8_SA(b, h) + aoff + m * 2048 + k * 1024); } while (0)
#define PG8_LDB(dst, b, h) do { _Pragma("unroll") for (int n = 0; n < 2; ++n) _Pragma("unroll") for (int k = 0; k < 2; ++k) dst[n][k] = *(const PG8_LAS bf16x8*)(lds + PG8_SB(b, h) + boff + n * 2048 + k * 1024); } while (0)
#define PG8_MMA(ai, bj, At, Bt) do { __builtin_amdgcn_s_setprio(1); _Pragma("unroll") for (int m = 0; m < 4; ++m) _Pragma("unroll") for (int n = 0; n < 2; ++n) _Pragma("unroll") for (int k = 0; k < 2; ++k) \
        acc[ai][bj][m][n] = __builtin_amdgcn_mfma_f32_16x16x32_bf16(Bt[n][k], At[m][k], acc[ai][bj][m][n], 0, 0, 0); __builtin_amdgcn_s_setprio(0); } while (0)
#define PG8_WAIT_V(n) asm volatile("s_waitcnt vmcnt(" #n ")" ::: "memory")
#define PG8_WAIT_L(n) asm volatile("s_waitcnt lgkmcnt(" #n ")" ::: "memory")
#define PG8_BAR __builtin_amdgcn_s_barrier()
#define PG8_SCHED __builtin_amdgcn_sched_barrier(0)
    Unit cur, nxt; int ui = 0;
    if (!S.next(0, cur)) return;
    f32x4 acc[2][2][4][2];
#pragma unroll
    for (int a = 0; a < 2; ++a)
#pragma unroll
        for (int b = 0; b < 2; ++b)
#pragma unroll
            for (int m = 0; m < 4; ++m)
#pragma unroll
                for (int n = 0; n < 2; ++n) acc[a][b][m][n] = (f32x4){0.f, 0.f, 0.f, 0.f};
    bf16x8 At[4][2], B0[2][2], B1[2][2];
    const char* cA = (const char*)g.A + (size_t)cur.pm * tstep; const char* cB = (const char*)g.Bt + (size_t)cur.pn * tstep;
    S.a_ready(cur);
    if constexpr (SP2) {
        PG8_STAGE(PG8_SB(0, 0), cB, voffB); PG8_STAGE(PG8_SB(0, 1), cB + hstep, voffB); PG8_STAGE(PG8_SA(0, 0), cA, voffA); PG8_STAGE(PG8_SA(0, 1), cA + hstep, voffA);
        if (wr == 1) PG8_BAR;
        PG8_WAIT_V(2); PG8_BAR;
        PG8_STAGE(PG8_SB(1, 0), cB + kstep, voffB); PG8_STAGE(PG8_SA(1, 0), cA + kstep, voffA); PG8_STAGE(PG8_SB(1, 1), cB + hstep + kstep, voffB);
        PG8_WAIT_V(6); PG8_BAR;
    } else {
        PG8_STAGE(PG8_SB(0, 0), cB, voffB); PG8_STAGE(PG8_SA(0, 0), cA, voffA); PG8_STAGE(PG8_SB(0, 1), cB + hstep, voffB); PG8_STAGE(PG8_SA(0, 1), cA + hstep, voffA);
        if (wr == 1) PG8_BAR;
        PG8_WAIT_V(4); PG8_BAR;
        PG8_STAGE(PG8_SB(1, 0), cB + kstep, voffB); PG8_STAGE(PG8_SA(1, 0), cA + kstep, voffA); PG8_STAGE(PG8_SB(1, 1), cB + hstep + kstep, voffB);
        PG8_WAIT_V(6); PG8_BAR;
    }
    for (;;) {
        const bool has_next = S.next(ui + 1, nxt);
        const char* nA = has_next ? (const char*)g.A + (size_t)nxt.pm * tstep : cA; const char* nB = has_next ? (const char*)g.Bt + (size_t)nxt.pn * tstep : cB;
        for (int t = 0; t < nt; t += 2) {
            const bool last = (t == nt - 2);
            const char* a1 = cA + (size_t)(t + 1) * kstep;
            const char* a2 = last ? nA : cA + (size_t)(t + 2) * kstep; const char* b2 = last ? nB : cB + (size_t)(t + 2) * kstep;
            const char* a3 = a2 + kstep; const char* b3 = b2 + kstep;
            if (last && has_next) S.a_ready(nxt);
            if constexpr (SP2) {
            PG8_LDB(B0, 0, 0); PG8_LDB(B1, 0, 1); PG8_SCHED; PG8_LDA(At, 0, 0); PG8_STAGE(PG8_SA(1, 1), a1 + hstep, voffA);
            PG8_WAIT_V(8); PG8_WAIT_L(0); PG8_BAR; PG8_MMA(0, 0, At, B0); PG8_MMA(0, 1, At, B1); PG8_BAR; PG8_SCHED;
            PG8_LDA(At, 0, 1); PG8_STAGE(PG8_SB(0, 0), b2, voffB); PG8_STAGE(PG8_SB(0, 1), b2 + hstep, voffB); PG8_STAGE(PG8_SA(0, 0), a2, voffA);
            PG8_WAIT_V(8); PG8_WAIT_L(0); PG8_BAR; PG8_MMA(1, 0, At, B0); PG8_MMA(1, 1, At, B1); PG8_BAR; PG8_SCHED;
            PG8_LDB(B0, 1, 0); PG8_LDB(B1, 1, 1); PG8_SCHED; PG8_LDA(At, 1, 0); PG8_STAGE(PG8_SA(0, 1), a2 + hstep, voffA);
            PG8_WAIT_V(8); PG8_WAIT_L(0); PG8_BAR; PG8_MMA(0, 0, At, B0); PG8_MMA(0, 1, At, B1); PG8_BAR; PG8_SCHED;
            PG8_LDA(At, 1, 1); PG8_STAGE(PG8_SB(1, 0), b3, voffB); PG8_STAGE(PG8_SB(1, 1), b3 + hstep, voffB); PG8_STAGE(PG8_SA(1, 0), a3, voffA);
            PG8_WAIT_V(8); PG8_WAIT_L(0); PG8_BAR; PG8_MMA(1, 0, At, B0); PG8_MMA(1, 1, At, B1); PG8_BAR; PG8_SCHED;
            } else {
            PG8_LDB(B0, 0, 0); PG8_SCHED; PG8_LDA(At, 0, 0); PG8_STAGE(PG8_SA(1, 1), a1 + hstep, voffA);
            PG8_WAIT_L(8); PG8_BAR; PG8_WAIT_L(0); PG8_MMA(0, 0, At, B0); PG8_BAR; PG8_SCHED;
            PG8_LDB(B1, 0, 1); PG8_STAGE(PG8_SB(0, 0), b2, voffB);
            PG8_BAR; PG8_WAIT_L(0); PG8_MMA(0, 1, At, B1); PG8_BAR;
            PG8_LDA(At, 0, 1); PG8_STAGE(PG8_SA(0, 0), a2, voffA);
            PG8_BAR; PG8_WAIT_L(0); PG8_MMA(1, 0, At, B0); PG8_BAR; PG8_SCHED;
            PG8_STAGE(PG8_SB(0, 1), b2 + hstep, voffB);
            PG8_WAIT_V(6); PG8_BAR; PG8_MMA(1, 1, At, B1); PG8_BAR;
            PG8_LDB(B0, 1, 0); PG8_SCHED; PG8_LDA(At, 1, 0); PG8_STAGE(PG8_SA(0, 1), a2 + hstep, voffA);
            PG8_WAIT_L(8); PG8_BAR; PG8_WAIT_L(0); PG8_MMA(0, 0, At, B0); PG8_BAR; PG8_SCHED;
            PG8_LDB(B1, 1, 1); PG8_STAGE(PG8_SB(1, 0), b3, voffB);
            PG8_BAR; PG8_WAIT_L(0); PG8_MMA(0, 1, At, B1); PG8_BAR;
            PG8_LDA(At, 1, 1); PG8_STAGE(PG8_SA(1, 0), a3, voffA);
            PG8_BAR; PG8_WAIT_L(0); PG8_MMA(1, 0, At, B0); PG8_BAR; PG8_SCHED;
            PG8_STAGE(PG8_SB(1, 1), b3 + hstep, voffB);
            PG8_WAIT_V(6); PG8_BAR; PG8_MMA(1, 1, At, B1); PG8_BAR;
            }
        }
        if constexpr (ALIGN_EPI) { if (wr == 0) PG8_BAR; }
        if constexpr (!Epi::AFTER_DRAIN) { E(acc, cur, wr, wc, fr, fq); S.done(cur); }
        if (!has_next) break;
#pragma unroll
        for (int a = 0; a < 2; ++a)
#pragma unroll
            for (int b = 0; b < 2; ++b)
#pragma unroll
                for (int m = 0; m < 4; ++m)
#pragma unroll
                    for (int n = 0; n < 2; ++n) acc[a][b][m][n] = (f32x4){0.f, 0.f, 0.f, 0.f};
        cur = nxt; cA = nA; cB = nB; ++ui;
        if constexpr (ALIGN_EPI) { if (wr == 1) PG8_BAR; }
    }
    PG8_WAIT_V(0);
    if constexpr (!ALIGN_EPI) { if (wr == 0) PG8_BAR; }
    PG8_BAR;
    if constexpr (Epi::AFTER_DRAIN) { E.fused(acc, cur, wr, wc, fr, fq, lds, wid, lane); S.done(cur); }
#undef PG8_SA
#undef PG8_SB
#undef PG8_STAGE
#undef PG8_LDA
#undef PG8_LDB
#undef PG8_MMA
#undef PG8_WAIT_V
#undef PG8_WAIT_L
#undef PG8_BAR
#undef PG8_SCHED
}
}

#define XB_TMO      128
#define XB_XCNT(j)  (256  + 64 * (j))
#define XB_XSUB(j)  (1280 + 64 * (j))
#define XB_XGEN(j)  (2304 + 64 * (j))
#define XB_TOP      3328
#define XB_TOPGEN   3392
#define XCD_BAR_WORDS 3456
#define XB_SPIN_CAP (1u << 18)
#define LAS __attribute__((address_space(3)))

__device__ __forceinline__ unsigned xb_ld(unsigned* p)              { return __hip_atomic_load(p, __ATOMIC_RELAXED, __HIP_MEMORY_SCOPE_AGENT); }
__device__ __forceinline__ unsigned xb_add(unsigned* p, unsigned v) { return __hip_atomic_fetch_add(p, v, __ATOMIC_RELAXED, __HIP_MEMORY_SCOPE_AGENT); }
__device__ __forceinline__ unsigned xb_xcc_id() { return (unsigned)__builtin_amdgcn_s_getreg((3 << 11) | 20) & 0xFu; }
#define XB_SPIN(cond, bar) do { unsigned _sp = 0; while (cond) { __builtin_amdgcn_s_sleep(1); \
    if ((++_sp & 255u) == 0u) { if (xb_ld(&(bar)[XB_TMO])) break; if (_sp > XB_SPIN_CAP) { atomicAdd(&(bar)[XB_TMO], 1u); break; } } } } while (0)

struct XcdBarrier {
    unsigned* bar; unsigned x;
    volatile LAS unsigned* st;
};

__device__ __forceinline__ XcdBarrier xcd_barrier_post(unsigned* bar, volatile LAS unsigned* st) {
    XcdBarrier b; b.bar = bar; b.x = xb_xcc_id(); b.st = st;
    if (threadIdx.x == 0) (void)xb_add(&bar[XB_XCNT(b.x)], 1u);
    return b;
}
__device__ __forceinline__ void xcd_barrier_complete(unsigned* bar, unsigned x, unsigned& nloc, unsigned& nx) {
    const unsigned G = gridDim.x * gridDim.y * gridDim.z;
    unsigned sum, cnt, mine, sp = 0u;
    for (;;) {
        sum = 0u; cnt = 0u; mine = 0u;
#pragma unroll
        for (unsigned j = 0; j < 16; ++j) { const unsigned c = xb_ld(&bar[XB_XCNT(j)]); sum += c; cnt += (c > 0u) ? 1u : 0u; mine = (j == x) ? c : mine; }
        if (sum == G) break;
        __builtin_amdgcn_s_sleep(1);
        if ((++sp & 255u) == 0u) { if (xb_ld(&bar[XB_TMO])) break; if (sp > XB_SPIN_CAP) { atomicAdd(&bar[XB_TMO], 1u); break; } }
    }
    nloc = mine > 0u ? mine : 1u; nx = cnt > 0u ? cnt : 1u;
}

__device__ __forceinline__ void xcd_barrier(const XcdBarrier& b) {
    asm volatile("s_waitcnt vmcnt(0)" ::: "memory");
    __syncthreads();
    if (threadIdx.x == 0) {
        unsigned* bar = b.bar;
        __builtin_amdgcn_s_waitcnt(0);
        unsigned nloc = b.st[0], nx = b.st[1];
        if (nloc == 0u) { xcd_barrier_complete(bar, b.x, nloc, nx); b.st[0] = nloc; b.st[1] = nx; }
        const unsigned old = xb_add(&bar[XB_XSUB(b.x)], 1u);
        const unsigned gen = old / nloc;
        if (old + 1u == (gen + 1u) * nloc) {
            __builtin_amdgcn_fence(__ATOMIC_RELEASE, "agent");
            asm volatile("s_waitcnt vmcnt(0)" ::: "memory");
            const unsigned og = xb_add(&bar[XB_TOP], 1u);
            const unsigned tg = og / nx;
            if (og + 1u == (tg + 1u) * nx) xb_add(&bar[XB_TOPGEN], 1u);
            else XB_SPIN(xb_ld(&bar[XB_TOPGEN]) == tg, bar);
            __builtin_amdgcn_fence(__ATOMIC_ACQUIRE, "agent");
            xb_add(&bar[XB_XGEN(b.x)], 1u);
            asm volatile("s_waitcnt vmcnt(0)" ::: "memory");
        } else {
            XB_SPIN(xb_ld(&bar[XB_XGEN(b.x)]) == gen, bar);
            __builtin_amdgcn_fence(__ATOMIC_ACQUIRE, "agent");
            asm volatile("s_waitcnt vmcnt(0)" ::: "memory");
        }
    }
    __syncthreads();
}

template <class Epi>
__device__ __forceinline__ void run_gemm(PG8_LAS unsigned char* lds, const bf16_t* A, const bf16_t* Bt, int N, int K, const Epi& E) {
    pg8::Gemm g{A, Bt, NTOK, N, K}; pg8::StaticOrder S; S.init(NTOK, N, (int)gridDim.x, (int)blockIdx.x);
    pg8::gemm_phase<Epi, pg8::StaticOrder, true, true>(lds, g, S, E);
}

__global__ void __launch_bounds__(NTHR, 2) mega_kernel(Params p) {
    extern __shared__ __attribute__((aligned(16))) unsigned char lds_raw[];
    PG8_LAS unsigned char* lds = (PG8_LAS unsigned char*)lds_raw;
    char* smem = (char*)lds_raw;
    cg::grid_group grid = cg::this_grid();
    volatile LAS unsigned* xst = (volatile LAS unsigned*)(lds + LDS_BYTES - 16);
    if (threadIdx.x == 0) { xst[0] = 0u; xst[1] = 0u; }
    __syncthreads();
    (void)xcd_barrier_post(p.bar, xst);
#define GBAR() do { XcdBarrier xb_; xb_.bar = p.bar; xb_.x = xb_xcc_id(); xb_.st = (volatile LAS unsigned*)(lds + LDS_BYTES - 16); xcd_barrier(xb_); } while (0)
    phase_prologue(p, smem);
    grid.sync();
    phase_u0(p);
    GBAR();
#define LL(v) ({ int l_ = (v); asm volatile("" : "+s"(l_)); l_; })
#define WL(v) (p.wts + (size_t)(v) * WL_ELEMS)
#define ML(v) (p.mod + (size_t)(v) * 4 * 9216)
#pragma unroll 1
    for (int l = 0; l < 2; ++l) {
        { const int k = LL(l); run_gemm(lds, p.ubuf, WL(k) + W_FIN0, 5632, 1024, pg8::EpiSwiGLU{p.act}); }
        GBAR();
        { const int k = LL(l); run_gemm(lds, p.act, WL(k) + W_FOUT0, 1024, DFF, pg8::EpiRes{k == 0 ? p.x : p.out, p.out, ML(k), 0, 0.5f}); }
        GBAR();
        phase_ln(p, LL(l), 0, true);
        GBAR();
        { const int k = LL(l); run_gemm(lds, p.ubuf, WL(k) + W_IN, NPROJ, 1024, pg8::EpiInproj{p.proj, p.rope, p.iw, p.logf, p.mix_b_forget + k * 4}); }
        GBAR();
        for (int rep = 0; rep < REP_TOPK; ++rep) phase_topk(p, smem);
        phase_scan(p, smem);
        for (int rep = 0; rep < REP_AC; ++rep) phase_attn_a(p, smem);
        GBAR();
        for (int rep = 0; rep < REP_FLASH; ++rep) phase_flash(p, smem);
        GBAR();
        for (int rep = 0; rep < REP_MERGE; ++rep) phase_merge(p, LL(l), smem);
        GBAR();
        { const int k = LL(l); run_gemm(lds, p.merged, WL(k) + W_OUT, 1024, 1024, pg8::EpiRes{p.out, p.out, ML(k), 1, 1.0f}); }
        GBAR();
        phase_ln(p, LL(l), 1, true);
        GBAR();
        { const int k = LL(l); run_gemm(lds, p.ubuf, WL(k) + W_FIN1, 5632, 1024, pg8::EpiSwiGLU{p.act}); }
        GBAR();
        { const int k = LL(l); run_gemm(lds, p.act, WL(k) + W_FOUT1, 1024, DFF, pg8::EpiRes{p.out, p.out, ML(k), 2, 0.5f}); }
        GBAR();
        { const int k = LL(l); phase_ln(p, k, 2, k == 0); }
        if (l == 0) GBAR();
    }
}

extern "C" void kernel_launch(void* const* d_in, const int* in_sizes, int n_in, void* d_out, int out_size, void* d_ws, size_t ws_size, hipStream_t stream) {
    Params p{};
    p.x = (const float*)d_in[0]; p.c = (const float*)d_in[1]; p.ada_w = (const float*)d_in[2]; p.ada_b = (const float*)d_in[3];
    p.ln_g = (const float*)d_in[4]; p.ln_b = (const float*)d_in[5]; p.ffn_w_in = (const float*)d_in[6]; p.ffn_w_out = (const float*)d_in[7];
    p.mix_w_in = (const float*)d_in[8]; p.mix_b_gate = (const float*)d_in[9]; p.mix_b_forget = (const float*)d_in[10];
    p.mix_w_branch = (const float*)d_in[11]; p.mix_w_out = (const float*)d_in[12];
    p.out = (float*)d_out;
    char* ws = (char*)d_ws; size_t off = 0;
    auto take = [&](size_t bytes) { char* r = ws + off; off += (bytes + 255) & ~(size_t)255; return r; };
    p.wts = (bf16_t*)take(2 * WL_ELEMS * 2);
    p.mod = (float*)take(2 * 4 * 9216 * 4);
    p.rope = (float*)take(SEQ * 16 * 4);
    p.ubuf = (bf16_t*)take((size_t)NTOK * 1024 * 2);
    p.act = (bf16_t*)(ws + off);
    p.proj = (bf16_t*)take((size_t)NTOK * NPROJ * 2);
    p.merged = p.proj;
    p.iw = (float*)take((size_t)NTOK * 16); p.logf = (float*)take((size_t)NTOK * 16); p.cum = (float*)take((size_t)NTOK * 16);
    p.maskb = (unsigned*)take((size_t)NTOK * 1024);
    p.ybuf = (bf16_t*)take((size_t)NTOK * 896 * 2);
    p.bar = (unsigned*)take(XCD_BAR_WORDS * 4);
    p.kmax = (float*)take(256);
    if (off > ws_size) { fprintf(stderr, "workspace too small: need %zu have %zu\n", off, ws_size); return; }
    static int grid_blocks = 0;
    if (!grid_blocks) {
        int dev = 0, cus = 0, per_cu = 0;
        (void)hipGetDevice(&dev);
        (void)hipDeviceGetAttribute(&cus, hipDeviceAttributeMultiprocessorCount, dev);
        (void)hipFuncSetAttribute((const void*)mega_kernel, hipFuncAttributeMaxDynamicSharedMemorySize, LDS_BYTES);
        (void)hipOccupancyMaxActiveBlocksPerMultiprocessor(&per_cu, mega_kernel, NTHR, LDS_BYTES);
        if (per_cu < 1) per_cu = 1;
        if (per_cu > 1) per_cu = 1;
        grid_blocks = cus * per_cu;
    }
    (void)hipMemsetAsync(p.bar, 0, XCD_BAR_WORDS * 4, stream);
    void* args[] = {&p};
    hipError_t e = hipLaunchCooperativeKernel((void*)mega_kernel, dim3(grid_blocks), dim3(NTHR), args, LDS_BYTES, stream);
    if (e != hipSuccess) fprintf(stderr, "cooperative launch failed: %s (grid %d)\n", hipGetErrorString(e), grid_blocks);
}
```
